# Optimizing an MI355X kernel written in HIP

```python
import math
import jax
import jax.numpy as jnp
from jax import lax

D_MODEL = 1024
BATCH = 16
SEQ = 4096
DEPTH = 4

N_A_LAYERS = DEPTH // 2
N_B_LAYERS = DEPTH - N_A_LAYERS
HG_HEAD_DIM = 128
HG_HEADS = D_MODEL // HG_HEAD_DIM
HG_CHUNK = 64
FORGET_FLOOR = 1e-30
MLA_HEADS = D_MODEL // 128
MLA_NOPE = 128
MLA_ROPE = 64
MLA_V = 128
MLA_Q_RANK = 384
MLA_KV_RANK = 256
ROPE_THETA = 10000.0
Q_BLOCK = 128
MASK_VALUE = -1e30
N_EXPERTS = 32
TOP_K = 4
EXPERT_FF = D_MODEL
SWIGLU_LIMIT = 7.0
SWIGLU_ALPHA = 1.702
MOE_BLOCK = 256
NORM_EPS = 1e-6
POS_OFFSET_MAX = 1024
ADA_INIT = 0.5

kernel_name = 'hybrid_hgrn2_mla_yoco_moe'


def rms_norm(t, gain):
    tf = t.astype(jnp.float32)
    tf = tf * lax.rsqrt(jnp.mean(tf * tf, axis=-1, keepdims=True) + NORM_EPS)
    return (tf * gain.astype(jnp.float32)).astype(t.dtype)


def modulate(t, shift, scale):
    return t * (1.0 + scale[:, None, :]) + shift[:, None, :]


def apply_rope(t, positions):
    half = MLA_ROPE // 2
    inv_freq = jnp.power(ROPE_THETA, -jnp.arange(half, dtype=jnp.float32) * (2.0 / MLA_ROPE))
    ang = positions.astype(jnp.float32)[..., None] * inv_freq
    if t.ndim == 4:
        ang = ang[:, :, None, :]
    cos, sin = jnp.cos(ang), jnp.sin(ang)
    tf = t.astype(jnp.float32)
    t1, t2 = tf[..., :half], tf[..., half:]
    return jnp.concatenate([t1 * cos - t2 * sin, t2 * cos + t1 * sin], axis=-1).astype(t.dtype)


def hgrn2_mixer(h, w_in, lower_bound, g_out, w_out):
    bsz, seq, _ = h.shape
    n_chunks = seq // HG_CHUNK
    q, f, i, g = jnp.split(h @ w_in, 4, axis=-1)
    lb = lower_bound.astype(jnp.float32)
    f = f.astype(jnp.float32)
    q = jax.nn.silu(q.astype(jnp.float32))
    forget = lb + (1.0 - lb) * jax.nn.sigmoid(f)
    log_forget = jnp.log(jnp.maximum(forget, FORGET_FLOOR))
    key = (1.0 - lb) * jax.nn.sigmoid(-f)

    def to_chunks(t):
        return t.reshape(bsz, n_chunks, HG_CHUNK, HG_HEADS, HG_HEAD_DIM).transpose(1, 0, 3, 2, 4)

    causal = jnp.tril(jnp.ones((HG_CHUNK, HG_CHUNK), dtype=bool))[:, :, None]

    def chunk_step(state, inp):
        qc, kc, vc, lc = inp
        cum = jnp.cumsum(lc, axis=2)
        o_inter = jnp.einsum('bhtk,bhkv->bhtv', qc * jnp.exp(cum), state)
        diff = cum[:, :, :, None, :] - cum[:, :, None, :, :]
        decay = jnp.where(causal, jnp.exp(jnp.where(causal, diff, 0.0)), 0.0)
        scores = jnp.einsum('bhtsk,bhsk->bhts', qc[:, :, :, None, :] * decay, kc)
        o_intra = jnp.einsum('bhts,bhsv->bhtv', scores, vc)
        last = cum[:, :, -1, :]
        new_state = jnp.exp(last)[..., None] * state + jnp.einsum(
            'bhsk,bhsv->bhkv', kc * jnp.exp(last[:, :, None, :] - cum), vc)
        return new_state, o_inter + o_intra

    init = jnp.zeros((bsz, HG_HEADS, HG_HEAD_DIM, HG_HEAD_DIM), jnp.float32)
    _, o = lax.scan(chunk_step, init, (to_chunks(q), to_chunks(key),
                                       to_chunks(i.astype(jnp.float32)), to_chunks(log_forget)))
    o = o.transpose(1, 0, 3, 2, 4).reshape(bsz, seq, HG_HEADS, HG_HEAD_DIM)
    gate = jax.nn.silu(g.astype(jnp.float32)).reshape(bsz, seq, HG_HEADS, HG_HEAD_DIM)
    o = rms_norm(o, g_out) * gate
    return o.reshape(bsz, seq, HG_HEADS * HG_HEAD_DIM).astype(h.dtype) @ w_out


def shared_latent_kv(hk, positions, w_dkv, g_ckv, w_ukv):
    bsz, seq, _ = hk.shape
    ckr = hk @ w_dkv
    c_kv = rms_norm(ckr[..., :MLA_KV_RANK], g_ckv)
    k_rope = apply_rope(ckr[..., MLA_KV_RANK:], positions)
    kv = (c_kv @ w_ukv).reshape(bsz, seq, MLA_HEADS, MLA_NOPE + MLA_V)
    return kv[..., :MLA_NOPE], kv[..., MLA_NOPE:], k_rope


def mla_mixer(h, positions, w_dq, g_cq, w_uq, w_o, k_nope, v, k_rope):
    bsz, seq, _ = h.shape
    cq = rms_norm(h @ w_dq, g_cq)
    q = (cq @ w_uq).reshape(bsz, seq, MLA_HEADS, MLA_NOPE + MLA_ROPE)
    q_nope = q[..., :MLA_NOPE]
    q_rope = apply_rope(q[..., MLA_NOPE:], positions)
    scale = 1.0 / math.sqrt(MLA_NOPE + MLA_ROPE)
    outs = []
    for blk in range(seq // Q_BLOCK):
        lo, hi = blk * Q_BLOCK, (blk + 1) * Q_BLOCK
        s = (jnp.einsum('bqhd,bkhd->bhqk', q_nope[:, lo:hi], k_nope[:, :hi])
             + jnp.einsum('bqhr,bkr->bhqk', q_rope[:, lo:hi], k_rope[:, :hi]))
        s = s.astype(jnp.float32) * scale
        mask = jnp.arange(hi)[None, :] <= jnp.arange(lo, hi)[:, None]
        p = jax.nn.softmax(jnp.where(mask, s, MASK_VALUE), axis=-1).astype(v.dtype)
        outs.append(jnp.einsum('bhqk,bkhd->bqhd', p, v[:, :hi]))
    o = jnp.concatenate(outs, axis=1).reshape(bsz, seq, MLA_HEADS * MLA_V)
    return o @ w_o


def moe_ffn(h, w_router, b_router, w_gu, b_gu, w_dn, b_dn):
    bsz, seq, dm = h.shape
    n_tok = bsz * seq
    xf = h.reshape(n_tok, dm)
    logits = (xf @ w_router).astype(jnp.float32) + b_router.astype(jnp.float32)
    top_vals, top_idx = lax.top_k(logits, TOP_K)
    weights = jax.nn.softmax(top_vals, axis=-1)
    n_assign = n_tok * TOP_K
    flat_e = top_idx.reshape(-1)
    order = jnp.argsort(flat_e, stable=True)
    sorted_e = flat_e[order]
    counts = jnp.bincount(flat_e, length=N_EXPERTS)
    padded = (counts + MOE_BLOCK - 1) // MOE_BLOCK * MOE_BLOCK
    start = jnp.cumsum(counts) - counts
    pad_end = jnp.cumsum(padded)
    pad_start = pad_end - padded
    dest_sorted = pad_start[sorted_e] + jnp.arange(n_assign) - start[sorted_e]
    dest = jnp.zeros((n_assign,), jnp.int32).at[order].set(dest_sorted.astype(jnp.int32))
    n_rows = n_assign + N_EXPERTS * MOE_BLOCK
    n_blocks = n_rows // MOE_BLOCK
    row_tok = jnp.full((n_rows,), n_tok, jnp.int32).at[dest].set(jnp.arange(n_assign, dtype=jnp.int32) // TOP_K)
    x_pad = jnp.concatenate([xf, jnp.zeros((1, dm), xf.dtype)], axis=0)
    xs = x_pad[row_tok].reshape(n_blocks, MOE_BLOCK, dm)
    block_e = jnp.minimum(jnp.searchsorted(pad_end, jnp.arange(n_blocks) * MOE_BLOCK, side='right'),
                          N_EXPERTS - 1)

    def expert_block(args):
        xb, e = args
        gu = xb @ w_gu[e] + b_gu[e]
        gate, up = gu[:, :EXPERT_FF], gu[:, EXPERT_FF:]
        gate = jnp.minimum(gate, SWIGLU_LIMIT)
        up = jnp.clip(up, -SWIGLU_LIMIT, SWIGLU_LIMIT)
        glu = gate * jax.nn.sigmoid(SWIGLU_ALPHA * gate)
        return ((up + 1.0) * glu) @ w_dn[e] + b_dn[e]

    ys = lax.map(expert_block, (xs, block_e)).reshape(n_rows, dm)
    y = jnp.einsum('nkd,nk->nd', ys[dest].reshape(n_tok, TOP_K, dm), weights.astype(ys.dtype))
    return y.reshape(bsz, seq, dm)


def setup_inputs(seed: int = 0) -> dict:
    key = jax.random.key(seed)
    ks = jax.random.split(key, 28)
    D = D_MODEL
    f32 = jnp.float32

    def nrm(k, shape, fan_in, s=1.0):
        return jax.random.normal(k, shape, f32) * (s * fan_in ** -0.5)

    def gain(k, shape):
        return 1.0 + 0.05 * jax.random.normal(k, shape, f32)

    def bias(k, shape, s=0.02):
        return s * jax.random.normal(k, shape, f32)

    x = jax.random.normal(ks[0], (BATCH, SEQ, D), f32)
    c = jax.random.normal(ks[1], (BATCH, D), f32)
    offsets = jax.random.randint(ks[2], (BATCH, 1), 0, POS_OFFSET_MAX, dtype=jnp.int32)
    positions = offsets + jnp.arange(SEQ, dtype=jnp.int32)[None, :]
    return {
        'x': x,
        'c': c,
        'positions': positions,
        'g_mix': gain(ks[3], (DEPTH, D)),
        'g_ffn': gain(ks[4], (DEPTH, D)),
        'w_ada': nrm(ks[5], (DEPTH, D, 6 * D), D, ADA_INIT),
        'b_ada': bias(ks[6], (DEPTH, 6 * D)),
        'w_in_a': nrm(ks[7], (N_A_LAYERS, D, 4 * D), D),
        'lb_logits': jax.random.normal(ks[8], (N_A_LAYERS, D), f32),
        'g_out_a': gain(ks[9], (N_A_LAYERS, HG_HEAD_DIM)),
        'w_out_a': nrm(ks[10], (N_A_LAYERS, D, D), D),
        'g_kv': gain(ks[11], (D,)),
        'w_ada_kv': nrm(ks[12], (D, 2 * D), D, ADA_INIT),
        'b_ada_kv': bias(ks[13], (2 * D,)),
        'w_dkv': nrm(ks[14], (D, MLA_KV_RANK + MLA_ROPE), D),
        'g_ckv': gain(ks[15], (MLA_KV_RANK,)),
        'w_ukv': nrm(ks[16], (MLA_KV_RANK, MLA_HEADS * (MLA_NOPE + MLA_V)), MLA_KV_RANK),
        'w_dq': nrm(ks[17], (N_B_LAYERS, D, MLA_Q_RANK), D),
        'g_cq': gain(ks[18], (N_B_LAYERS, MLA_Q_RANK)),
        'w_uq': nrm(ks[19], (N_B_LAYERS, MLA_Q_RANK, MLA_HEADS * (MLA_NOPE + MLA_ROPE)), MLA_Q_RANK),
        'w_o_b': nrm(ks[20], (N_B_LAYERS, MLA_HEADS * MLA_V, D), MLA_HEADS * MLA_V),
        'w_router': nrm(ks[21], (DEPTH, D, N_EXPERTS), D),
        'b_router': bias(ks[22], (DEPTH, N_EXPERTS), 0.01),
        'w_gu': nrm(ks[23], (DEPTH, N_EXPERTS, D, 2 * EXPERT_FF), D),
        'b_gu': bias(ks[24], (DEPTH, N_EXPERTS, 2 * EXPERT_FF)),
        'w_dn': nrm(ks[25], (DEPTH, N_EXPERTS, EXPERT_FF, D), EXPERT_FF),
        'b_dn': bias(ks[26], (DEPTH, N_EXPERTS, D)),
        'g_final': gain(ks[27], (D,)),
    }


def reference(x, c, positions, g_mix, g_ffn, w_ada, b_ada, w_in_a, lb_logits, g_out_a, w_out_a,
              g_kv, w_ada_kv, b_ada_kv, w_dkv, g_ckv, w_ukv, w_dq, g_cq, w_uq, w_o_b,
              w_router, b_router, w_gu, b_gu, w_dn, b_dn, g_final):
    c_act = jax.nn.silu(c)
    lb_p = jax.nn.softmax(lb_logits.astype(jnp.float32), axis=0)
    lower_bounds = jnp.cumsum(lb_p, axis=0) - lb_p[0]
    shared = None
    for l in range(DEPTH):
        mod = c_act @ w_ada[l] + b_ada[l]
        sh_m, sc_m, gt_m, sh_f, sc_f, gt_f = jnp.split(mod, 6, axis=-1)
        h = modulate(rms_norm(x, g_mix[l]), sh_m, sc_m)
        if l < N_A_LAYERS:
            y = hgrn2_mixer(h, w_in_a[l], lower_bounds[l], g_out_a[l], w_out_a[l])
        else:
            j = l - N_A_LAYERS
            y = mla_mixer(h, positions, w_dq[j], g_cq[j], w_uq[j], w_o_b[j], *shared)
        x = x + gt_m[:, None, :] * y
        h = modulate(rms_norm(x, g_ffn[l]), sh_f, sc_f)
        x = x + gt_f[:, None, :] * moe_ffn(h, w_router[l], b_router[l], w_gu[l], b_gu[l], w_dn[l], b_dn[l])
        if l == N_A_LAYERS - 1:
            sh_kv, sc_kv = jnp.split(c_act @ w_ada_kv + b_ada_kv, 2, axis=-1)
            hk = modulate(rms_norm(x, g_kv), sh_kv, sc_kv)
            shared = shared_latent_kv(hk, positions, w_dkv, g_ckv, w_ukv)
    return rms_norm(x, g_final)
```

```cpp
#define MK_ONE_LAUNCH 1
#define MK_LAST_STEP 9999
#include <hip/hip_runtime.h>
#include <cstdio>
#include <cstdint>

#ifndef MK_ONE_LAUNCH
#define MK_ONE_LAUNCH 1
#endif
#ifndef MK_LAST_STEP
#define MK_LAST_STEP 9999
#endif

#define GAS __attribute__((address_space(1)))
#define LAS __attribute__((address_space(3)))
typedef unsigned short bf16_t;
typedef short bf16x8 __attribute__((ext_vector_type(8)));
typedef short s16x4 __attribute__((ext_vector_type(4)));
typedef float f32x4 __attribute__((ext_vector_type(4)));
typedef float f32x2 __attribute__((ext_vector_type(2)));
typedef float f32x16 __attribute__((ext_vector_type(16)));
typedef unsigned u32x4 __attribute__((ext_vector_type(4)));
typedef unsigned u32x2 __attribute__((ext_vector_type(2)));

constexpr int NB = 16, SEQ = 4096, D = 1024, T = NB * SEQ;
constexpr int DEPTH = 4, NA = 2;
constexpr int HGH = 8, HGD = 128, HGC = 64;
constexpr int MH = 8, NOPE = 128, ROPE = 64, VD = 128, QK = NOPE + ROPE;
constexpr int QRANK = 384, KVRANK = 256;
constexpr int NE = 32, TOPK = 4, FF = 1024, MOEB = 256;
constexpr int NASSIGN = T * TOPK;
constexpr int NROWS_MAX = NASSIGN + NE * MOEB;
constexpr int NBLK_MAX = NROWS_MAX / MOEB;
constexpr float NORM_EPS = 1e-6f;
constexpr float SWIGLU_LIMIT = 7.0f, SWIGLU_ALPHA = 1.702f;
constexpr int NWAVES = 8, NTHREADS = 512;

constexpr size_t MiB = 1u << 20;
constexpr size_t al256(size_t x) { return (x + 255) & ~(size_t)255; }
constexpr size_t WS_CTL = 0, CTL_ZERO_BYTES = 1 * MiB;
constexpr int CW_BAR = 4096;
constexpr int CW_CNT = 16384;
constexpr size_t WS_MOD   = 1 * MiB;
constexpr size_t WS_KVMOD = WS_MOD + al256((size_t)DEPTH * NB * 6 * D * 4);
constexpr size_t WS_LB    = WS_KVMOD + al256((size_t)NB * 2 * D * 4);
constexpr size_t WS_ROPE  = WS_LB + al256((size_t)NA * D * 4);
constexpr size_t WS_TKE   = WS_ROPE + al256((size_t)T * 64 * 4);
constexpr size_t WS_TKW   = WS_TKE + al256((size_t)T * 4 * 4);
constexpr size_t WS_TKR   = WS_TKW + al256((size_t)T * 4 * 4);
constexpr size_t WS_RINFO = WS_TKR + al256((size_t)T * 4 * 4);
constexpr size_t WS_RW    = WS_RINFO + al256((size_t)NROWS_MAX * 4);
constexpr size_t WS_WIN   = al256(WS_RW + (size_t)NROWS_MAX * 4 + MiB);
constexpr size_t WS_WOUT  = WS_WIN + (size_t)NA * 4096 * 1024 * 2;
constexpr size_t WS_WDKV  = WS_WOUT + (size_t)NA * 1024 * 1024 * 2;
constexpr size_t WS_WUKV  = WS_WDKV + (size_t)512 * 1024 * 2;
constexpr size_t WS_WDQ   = WS_WUKV + (size_t)2048 * 256 * 2;
constexpr size_t WS_WUQ   = WS_WDQ + (size_t)2 * 512 * 1024 * 2;
constexpr size_t WS_WO    = WS_WUQ + (size_t)2 * 1536 * 384 * 2;
constexpr size_t WS_WGU   = al256(WS_WO + (size_t)2 * 1024 * 1024 * 2);
constexpr size_t WS_WDN   = WS_WGU + (size_t)DEPTH * NE * 2048 * 1024 * 2;
constexpr size_t WS_H     = WS_WDN + (size_t)DEPTH * NE * 1024 * 1024 * 2;
constexpr size_t WS_HK    = WS_H + (size_t)T * D * 2;
constexpr size_t WS_ACT   = WS_HK + (size_t)T * D * 2;
constexpr size_t WS_YS    = WS_ACT + (size_t)NROWS_MAX * FF * 2;
constexpr size_t WS_MIX   = WS_YS + (size_t)NASSIGN * D * 2;
constexpr size_t WS_QH = WS_MIX;
constexpr size_t WS_KK = WS_QH + (size_t)T * D * 2;
constexpr size_t WS_VV = WS_KK + (size_t)T * D * 2;
constexpr size_t WS_GS = WS_VV + (size_t)T * D * 2;
constexpr size_t WS_LF = WS_GS + (size_t)T * D * 2;
constexpr size_t WS_OO = WS_LF + (size_t)T * D * 4;
constexpr size_t WS_OG = WS_OO + (size_t)T * D * 2;
constexpr size_t WS_MIX_END_A = WS_OG + (size_t)T * D * 2;
constexpr size_t WS_KB  = WS_MIX;
constexpr size_t WS_VB  = WS_KB + (size_t)T * MH * QK * 2;
constexpr size_t WS_QB  = WS_VB + (size_t)T * D * 2;
constexpr size_t WS_CKR = WS_QB + (size_t)T * MH * QK * 2;
constexpr size_t WS_CKV = WS_CKR + (size_t)T * 512 * 2;
constexpr size_t WS_CQ  = WS_CKV + (size_t)T * 256 * 2;
constexpr size_t WS_CQN = WS_CQ + (size_t)T * 512 * 2;
constexpr size_t WS_AO  = WS_CQN + (size_t)T * 384 * 2;
constexpr size_t WS_MIX_END_B = WS_AO + (size_t)T * D * 2;
constexpr size_t WS_END = (WS_MIX_END_A > WS_MIX_END_B ? WS_MIX_END_A : WS_MIX_END_B);
static_assert(WS_END < (size_t)4200 * MiB / 1 && WS_END < 4294967296ull, "workspace map must fit 4 x largest tensor");

constexpr int RING_BYTES = 131072;
constexpr int LDS_TAB = RING_BYTES;
constexpr int LDS_MISC = RING_BYTES + 512;
constexpr int LDS_BYTES = 147456;

#define RLX_AGENT __ATOMIC_RELAXED, __HIP_MEMORY_SCOPE_AGENT
#define LDS_WAIT() asm volatile("s_waitcnt lgkmcnt(0)" ::: "memory")
#define VM_WAIT() asm volatile("s_waitcnt vmcnt(0)" ::: "memory")
typedef __bf16 bf16x2_t __attribute__((ext_vector_type(2)));
__device__ __forceinline__ unsigned cvt_pk_bf16(float lo, float hi) { f32x2 v = {lo, hi}; bf16x2_t b = __builtin_convertvector(v, bf16x2_t); return __builtin_bit_cast(unsigned, b); }
__device__ __forceinline__ float bf2f(unsigned short b) { return __uint_as_float(((unsigned)b) << 16); }
__device__ __forceinline__ float bflo(unsigned w) { return __uint_as_float(w << 16); }
__device__ __forceinline__ float bfhi(unsigned w) { return __uint_as_float(w & 0xffff0000u); }
__device__ __forceinline__ unsigned short f2bf(float f) { return (unsigned short)(cvt_pk_bf16(f, 0.f) & 0xffffu); }
__device__ __forceinline__ float wave_sum(float v) {
#pragma unroll
    for (int o = 1; o < 64; o <<= 1) v += __shfl_xor(v, o);
    return v;
}
__device__ __forceinline__ void glds16s(const void* sbase, unsigned voff, unsigned lds_dst) {
    asm volatile("s_mov_b32 m0, %2\n\ts_nop 0\n\tglobal_load_lds_dwordx4 %0, %1" :: "v"(voff), "s"(sbase), "s"(lds_dst) : "memory", "m0"); }
__device__ __forceinline__ int opaque_v(int x) { asm volatile("" : "+v"(x)); return x; }
#define PHASE_IDS const int tid = opaque_v((int)threadIdx.x), lane = tid & 63, wave = __builtin_amdgcn_readfirstlane(tid >> 6); (void)lane; (void)wave
__device__ __forceinline__ float fsigmoid(float x) { return __builtin_amdgcn_rcpf(1.0f + __expf(-x)); }
__device__ __forceinline__ float fsilu(float x) { return x * __builtin_amdgcn_rcpf(1.0f + __expf(-x)); }

#define XB_TMO      128
#define XB_XCNT(j)  (256  + 64 * (j))
#define XB_XSUB(j)  (1280 + 64 * (j))
#define XB_XGEN(j)  (2304 + 64 * (j))
#define XB_TOP      3328
#define XB_TOPGEN   3392
#define XCD_BAR_WORDS 3456
#define XB_SPIN_CAP (1u << 23)
__device__ __forceinline__ unsigned xb_ld(unsigned* p)              { return __hip_atomic_load(p, __ATOMIC_RELAXED, __HIP_MEMORY_SCOPE_AGENT); }
__device__ __forceinline__ unsigned xb_add(unsigned* p, unsigned v) { return __hip_atomic_fetch_add(p, v, __ATOMIC_RELAXED, __HIP_MEMORY_SCOPE_AGENT); }
__device__ __forceinline__ unsigned xb_xcc_id() { return (unsigned)__builtin_amdgcn_s_getreg((3 << 11) | 20) & 0xFu; }
#define XB_SPIN(cond, bar) do { unsigned _sp = 0; while (cond) { __builtin_amdgcn_s_sleep(1); \
    if ((++_sp & 255u) == 0u) { if (xb_ld(&(bar)[XB_TMO])) break; if (_sp > XB_SPIN_CAP) { atomicAdd(&(bar)[XB_TMO], 1u); break; } } } } while (0)
struct XcdBarrier { unsigned* bar; unsigned x; volatile LAS unsigned* st; };
__device__ __forceinline__ XcdBarrier xcd_barrier_post(unsigned* bar, volatile LAS unsigned* st) {
    XcdBarrier b; b.bar = bar; b.x = xb_xcc_id(); b.st = st;
    if (threadIdx.x == 0) (void)xb_add(&bar[XB_XCNT(b.x)], 1u);
    return b;
}
__device__ __forceinline__ void xcd_barrier_complete(unsigned* bar, unsigned x, unsigned& nloc, unsigned& nx) {
    const unsigned G = gridDim.x * gridDim.y * gridDim.z;
    unsigned sum, cnt, mine, sp = 0u;
    for (;;) {
        sum = 0u; cnt = 0u; mine = 0u;
#pragma unroll
        for (unsigned j = 0; j < 16; ++j) { const unsigned c = xb_ld(&bar[XB_XCNT(j)]); sum += c; cnt += (c > 0u) ? 1u : 0u; mine = (j == x) ? c : mine; }
        if (sum == G) break;
        __builtin_amdgcn_s_sleep(1);
        if ((++sp & 255u) == 0u) { if (xb_ld(&bar[XB_TMO])) break; if (sp > XB_SPIN_CAP) { atomicAdd(&bar[XB_TMO], 1u); break; } }
    }
    nloc = mine > 0u ? mine : 1u; nx = cnt > 0u ? cnt : 1u;
}
__device__ __forceinline__ void xcd_barrier(const XcdBarrier& b) {
    asm volatile("s_waitcnt vmcnt(0)" ::: "memory");
    __syncthreads();
    if (threadIdx.x == 0) {
        unsigned* bar = b.bar;
        __builtin_amdgcn_s_waitcnt(0);
        unsigned nloc = b.st[0], nx = b.st[1];
        if (nloc == 0u) { xcd_barrier_complete(bar, b.x, nloc, nx); b.st[0] = nloc; b.st[1] = nx; }
        const unsigned old = xb_add(&bar[XB_XSUB(b.x)], 1u);
        const unsigned gen = old / nloc;
        if (old + 1u == (gen + 1u) * nloc) {
            __builtin_amdgcn_fence(__ATOMIC_RELEASE, "agent");
            asm volatile("s_waitcnt vmcnt(0)" ::: "memory");
            const unsigned og = xb_add(&bar[XB_TOP], 1u);
            const unsigned tg = og / nx;
            if (og + 1u == (tg + 1u) * nx) xb_add(&bar[XB_TOPGEN], 1u);
            else XB_SPIN(xb_ld(&bar[XB_TOPGEN]) == tg, bar);
            __builtin_amdgcn_fence(__ATOMIC_ACQUIRE, "agent");
            xb_add(&bar[XB_XGEN(b.x)], 1u);
            asm volatile("s_waitcnt vmcnt(0)" ::: "memory");
        } else {
            XB_SPIN(xb_ld(&bar[XB_XGEN(b.x)]) == gen, bar);
            __builtin_amdgcn_fence(__ATOMIC_ACQUIRE, "agent");
            asm volatile("s_waitcnt vmcnt(0)" ::: "memory");
        }
    }
    __syncthreads();
}
namespace pg8 {
constexpr int BM = 256, BK = 64, HALF = 128, HTB = HALF * BK * 2, STAGE_BYTES = 8 * HTB, NXCD = 8, WGM = 8;
__host__ __device__ __forceinline__ int lds_byte(int r, int c) { const int st = (r >> 4) * 2 + (c >> 5), rr = r & 15, cc = c & 31, ob = rr * 64 + cc * 2; return st * 1024 + (ob ^ (((ob >> 9) & 1) << 5)); }
__host__ __device__ __forceinline__ void stage_rc(int b, int& R, int& C) { const int st = b / 1024, sb = b % 1024, swz = sb ^ (((sb >> 9) & 1) << 5); R = (st >> 1) * 16 + swz / 64; C = (st & 1) * 32 + (swz % 64) / 2; }
__host__ __device__ __forceinline__ int perm32(int rho) { const int n = rho >> 4, i = rho & 15; return 8 * (i >> 2) + 4 * n + (i & 3); }

struct Unit { int pm, pn, e; };

struct StaticOrder {
    int nM, nN, nwg, G, c;
    __device__ void init(int M, int N, int G_, int c_) { nM = M / BM; nN = N / BM; nwg = nM * nN; G = G_; c = c_; }
    __device__ bool next(int i, Unit& u) const {
        const long L = (long)i * G + c; if (L >= nwg) return false;
        int wgid = (int)L; { const int q = nwg / NXCD, r = nwg % NXCD, xcd = wgid % NXCD, off = wgid / NXCD; wgid = (xcd < r ? xcd * (q + 1) : r * (q + 1) + (xcd - r) * q) + off; }
        const int nig = WGM * nN, gid = wgid / nig, fm = gid * WGM, gsz = (nM - fm) < WGM ? (nM - fm) : WGM;
        u.pm = fm + ((wgid % nig) % gsz); u.pn = (wgid % nig) / gsz; u.e = 0; return true;
    }
};

struct PlainSched : StaticOrder {
    static constexpr bool GATHER = false;
    const char* Bt; int K;
    __device__ __forceinline__ const char* bptr(const Unit& u) const { return Bt + (size_t)u.pn * BM * K; }
    __device__ __forceinline__ unsigned adelta(const Unit& a, const Unit& b) const { return (unsigned)((b.pm - a.pm) * BM * K); }
    __device__ __forceinline__ void aoffs(const Unit& u, unsigned (&o)[2][2]) const {
        int R0, C0, R1, C1; { const int t_ = opaque_v((int)threadIdx.x); stage_rc(t_ * 16, R0, C0); stage_rc(t_ * 16 + 8192, R1, C1); C0 *= 2; C1 *= 2; }
#pragma unroll
        for (int h = 0; h < 2; ++h) { o[h][0] = (unsigned)((u.pm * BM + h * HALF + R0) * K + C0); o[h][1] = (unsigned)((u.pm * BM + h * HALF + R1) * K + C1); }
    }
};

#define PG8_SA(b, h) (((b) * 2 + (h)) * HTB)
#define PG8_SB(b, h) ((4 + (b) * 2 + (h)) * HTB)
#define PG8_STAGE_B(bufoff, gbase) do { glds16s((gbase), voffB, lds0 + (bufoff) + ldsw); glds16s((gbase) + r64, voffB, lds0 + (bufoff) + ldsw + 8192u); } while (0)
#define PG8_STAGE_A(bufoff, gbase, h) do { if constexpr (Sched::GATHER) { glds16s((gbase), vc[h][0], lds0 + (bufoff) + ldsw); glds16s((gbase), vc[h][1], lds0 + (bufoff) + ldsw + 8192u); } \
        else { glds16s((gbase) + (h) * hstep, vc[0][0], lds0 + (bufoff) + ldsw); glds16s((gbase) + (h) * hstep + r64, vc[0][0], lds0 + (bufoff) + ldsw + 8192u); } } while (0)
#define PG8_LDA(dst, b, h) do { _Pragma("unroll") for (int m = 0; m < 4; ++m) _Pragma("unroll") for (int k = 0; k < 2; ++k) dst[m][k] = *(const LAS bf16x8*)(lds + PG8_SA(b, h) + aoff + m * 2048 + k * 1024); } while (0)
#define PG8_LDB(dst, b, h) do { _Pragma("unroll") for (int n = 0; n < 2; ++n) _Pragma("unroll") for (int k = 0; k < 2; ++k) dst[n][k] = *(const LAS bf16x8*)(lds + PG8_SB(b, h) + boff + n * 2048 + k * 1024); } while (0)
#define PG8_MMA(ai, bj, At, Bt) do { __builtin_amdgcn_s_setprio(1); _Pragma("unroll") for (int m = 0; m < 4; ++m) _Pragma("unroll") for (int n = 0; n < 2; ++n) _Pragma("unroll") for (int k = 0; k < 2; ++k) \
        acc[ai][bj][m][n] = __builtin_amdgcn_mfma_f32_16x16x32_bf16(Bt[n][k], At[m][k], acc[ai][bj][m][n], 0, 0, 0); __builtin_amdgcn_s_setprio(0); } while (0)
#define PG8_WAIT_V(n) asm volatile("s_waitcnt vmcnt(" #n ")" ::: "memory")
#define PG8_WAIT_L(n) asm volatile("s_waitcnt lgkmcnt(" #n ")" ::: "memory")
#define PG8_BAR __builtin_amdgcn_s_barrier()
#define PG8_SCHED __builtin_amdgcn_sched_barrier(0)

typedef int i32x4v __attribute__((ext_vector_type(4)));
typedef int i32x8v __attribute__((ext_vector_type(8)));
__device__ __forceinline__ i32x8v cat8(bf16x8 a, bf16x8 b) { const i32x4v x = __builtin_bit_cast(i32x4v, a), y = __builtin_bit_cast(i32x4v, b); return __builtin_shufflevector(x, y, 0, 1, 2, 3, 4, 5, 6, 7); }
#define PG8_MFMA8(accv, b8, a8) asm volatile("v_mfma_f32_16x16x128_f8f6f4 %0, %1, %2, %0" : "+v"(accv) : "v"(b8), "v"(a8))
#define PG8_MFMA_DRAIN() asm volatile("s_nop 15\n\ts_nop 15\n\ts_nop 15\n\ts_nop 15" ::: "memory")
#define PG8_MMA8(ai, bj, At, Bt) do { __builtin_amdgcn_s_setprio(1); _Pragma("unroll") for (int m = 0; m < 4; ++m) _Pragma("unroll") for (int n = 0; n < 2; ++n) \
        PG8_MFMA8(acc[ai][bj][m][n], Bt##8[n], At##8[m]); __builtin_amdgcn_s_setprio(0); } while (0)
#define PG8_MM(ai, bj, At, Bt) do { if constexpr (FP8) PG8_MMA8(ai, bj, At, Bt); else PG8_MMA(ai, bj, At, Bt); } while (0)
#define PG8_LDA8(dst, b, h) do { _Pragma("unroll") for (int m = 0; m < 4; ++m) dst##8[m] = cat8(*(const LAS bf16x8*)(lds + PG8_SA(b, h) + aoff + m * 2048), *(const LAS bf16x8*)(lds + PG8_SA(b, h) + aoff + m * 2048 + 1024)); } while (0)
#define PG8_LDB8(dst, b, h) do { _Pragma("unroll") for (int n = 0; n < 2; ++n) dst##8[n] = cat8(*(const LAS bf16x8*)(lds + PG8_SB(b, h) + boff + n * 2048), *(const LAS bf16x8*)(lds + PG8_SB(b, h) + boff + n * 2048 + 1024)); } while (0)
#define PG8_LA(dst, b, h) do { if constexpr (FP8) PG8_LDA8(dst, b, h); else PG8_LDA(dst, b, h); } while (0)
#define PG8_LB(dst, b, h) do { if constexpr (FP8) PG8_LDB8(dst, b, h); else PG8_LDB(dst, b, h); } while (0)
template <bool FP8, class Epi, class Sched>
__device__ __forceinline__ void gemm_phase(LAS unsigned char* lds, const char* A0, int K, const Sched& S, const Epi& E) {
    const int tid = opaque_v((int)threadIdx.x), wid = __builtin_amdgcn_readfirstlane(tid >> 6), lane = tid & 63, wr = wid >> 2, wc = wid & 3, fr = lane & 15, fq = lane >> 4;
    const int nt = K / (BK * 2);
    unsigned voffB;
    { int R0, C0; stage_rc(tid * 16, R0, C0); C0 *= 2;
      const int Rb0 = Epi::PERM ? ((R0 & ~31) + perm32(R0 & 31)) : R0;
      voffB = (unsigned)(Rb0 * K + C0); }
    const size_t r64 = (size_t)64 * K;
    const size_t kstep = (size_t)(BK * 2);
    const size_t hstep = (size_t)HALF * K;
    const unsigned ldsw = (unsigned)wid * 1024u, lds0 = (unsigned)(uintptr_t)lds;
    const int aoff = lds_byte(wr * 64 + fr, fq * 8), boff = lds_byte(wc * 32 + fr, fq * 8);
    Unit cur, nxt; int ui = 0;
    if (!S.next(0, cur)) return;
    f32x4 acc[2][2][4][2];
#pragma unroll
    for (int a = 0; a < 2; ++a)
#pragma unroll
        for (int b = 0; b < 2; ++b)
#pragma unroll
            for (int m = 0; m < 4; ++m)
#pragma unroll
                for (int n = 0; n < 2; ++n) acc[a][b][m][n] = (f32x4){0.f, 0.f, 0.f, 0.f};
    bf16x8 At[4][2], B0[2][2], B1[2][2];
    i32x8v At8[4], B08[2], B18[2];
    unsigned vc[2][2], vn[2][2];
    S.aoffs(cur, vc);
    const char* cB = S.bptr(cur);
    PG8_STAGE_B(PG8_SB(0, 0), cB); PG8_STAGE_B(PG8_SB(0, 1), cB + hstep); PG8_STAGE_A(PG8_SA(0, 0), A0, 0); PG8_STAGE_A(PG8_SA(0, 1), A0, 1);
    if (wr == 1) PG8_BAR;
    PG8_WAIT_V(2); PG8_BAR;
    PG8_STAGE_B(PG8_SB(1, 0), cB + kstep); PG8_STAGE_A(PG8_SA(1, 0), A0 + kstep, 0); PG8_STAGE_B(PG8_SB(1, 1), cB + hstep + kstep);
    PG8_WAIT_V(6); PG8_BAR;
#pragma unroll 1
    for (;;) {
        const bool has_next = S.next(ui + 1, nxt);
        const char* nB = cB; unsigned dlt = 0u;
        if constexpr (Sched::GATHER) {
            if (has_next) { S.aload(nxt, vn); nB = S.bptr(nxt); }
        } else { if (has_next) { dlt = S.adelta(cur, nxt); nB = S.bptr(nxt); } }
#pragma unroll 1
        for (int t = 0; t < nt; t += 2) {
            const bool last = (t == nt - 2);
            const char* a1 = A0 + (size_t)(t + 1) * kstep;
            const char* a2 = last ? A0 : A0 + (size_t)(t + 2) * kstep; const char* b2 = last ? nB : cB + (size_t)(t + 2) * kstep;
            const char* a3 = a2 + kstep; const char* b3 = b2 + kstep;
            PG8_LB(B0, 0, 0); PG8_LB(B1, 0, 1); PG8_SCHED; PG8_LA(At, 0, 0); PG8_STAGE_A(PG8_SA(1, 1), a1, 1);
            PG8_WAIT_V(8); PG8_WAIT_L(0); PG8_BAR;
            if (last) {
                if constexpr (Sched::GATHER) { if (has_next) {
#pragma unroll
                    for (int h = 0; h < 2; ++h) { vc[h][0] = (unsigned)opaque_v((int)vn[h][0]); vc[h][1] = (unsigned)opaque_v((int)vn[h][1]); }
                    S.aconv(vc); } }
                else vc[0][0] += dlt; }
            PG8_MM(0, 0, At, B0); PG8_MM(0, 1, At, B1); PG8_BAR; PG8_SCHED;
            PG8_LA(At, 0, 1); PG8_STAGE_B(PG8_SB(0, 0), b2); PG8_STAGE_B(PG8_SB(0, 1), b2 + hstep); PG8_STAGE_A(PG8_SA(0, 0), a2, 0);
            PG8_WAIT_V(8); PG8_WAIT_L(0); PG8_BAR; PG8_MM(1, 0, At, B0); PG8_MM(1, 1, At, B1); PG8_BAR; PG8_SCHED;
            PG8_LB(B0, 1, 0); PG8_LB(B1, 1, 1); PG8_SCHED; PG8_LA(At, 1, 0); PG8_STAGE_A(PG8_SA(0, 1), a2, 1);
            PG8_WAIT_V(8); PG8_WAIT_L(0); PG8_BAR; PG8_MM(0, 0, At, B0); PG8_MM(0, 1, At, B1); PG8_BAR; PG8_SCHED;
            PG8_LA(At, 1, 1); PG8_STAGE_B(PG8_SB(1, 0), b3); PG8_STAGE_B(PG8_SB(1, 1), b3 + hstep); PG8_STAGE_A(PG8_SA(1, 0), a3, 0);
            PG8_WAIT_V(8); PG8_WAIT_L(0); PG8_BAR; PG8_MM(1, 0, At, B0); PG8_MM(1, 1, At, B1); PG8_BAR; PG8_SCHED;
        }
        if (wr == 0) PG8_BAR;
        if constexpr (FP8) PG8_MFMA_DRAIN();
        { const int l_ = opaque_v((int)threadIdx.x) & 63; E(acc, cur, wr, wc, l_ & 15, l_ >> 4); }
        if (!has_next) break;
#pragma unroll
        for (int a = 0; a < 2; ++a)
#pragma unroll
            for (int b = 0; b < 2; ++b)
#pragma unroll
                for (int m = 0; m < 4; ++m)
#pragma unroll
                    for (int n = 0; n < 2; ++n) acc[a][b][m][n] = (f32x4){0.f, 0.f, 0.f, 0.f};
        cur = nxt; cB = nB; ++ui;
        if (wr == 1) PG8_BAR;
    }
    PG8_WAIT_V(0);
    PG8_BAR;
}
}
namespace pg8 {
__device__ __forceinline__ u32x2 pack8_fp8(const f32x4 a, const f32x4 b) { int w0 = 0, w1 = 0;
    w0 = __builtin_amdgcn_cvt_pk_fp8_f32(a[0], a[1], w0, false); w0 = __builtin_amdgcn_cvt_pk_fp8_f32(a[2], a[3], w0, true);
    w1 = __builtin_amdgcn_cvt_pk_fp8_f32(b[0], b[1], w1, false); w1 = __builtin_amdgcn_cvt_pk_fp8_f32(b[2], b[3], w1, true); u32x2 r; r.x = (unsigned)w0; r.y = (unsigned)w1; return r; }
__device__ __forceinline__ u32x4 pack8(const f32x4 a, const f32x4 b) { u32x4 w; w.x = cvt_pk_bf16(a[0], a[1]); w.y = cvt_pk_bf16(a[2], a[3]); w.z = cvt_pk_bf16(b[0], b[1]); w.w = cvt_pk_bf16(b[2], b[3]); return w; }

struct EpiPlainBf16 {
    static constexpr bool PERM = true;
    bf16_t* O; int ldc;
    __device__ __forceinline__ void operator()(const f32x4 (&acc)[2][2][4][2], const Unit& u, int wr, int wc, int fr, int fq) const {
        const int row0 = u.pm * BM + wr * 64 + fr, col0 = u.pn * BM + wc * 32 + 8 * fq;
#pragma unroll
        for (int ai = 0; ai < 2; ++ai)
#pragma unroll
            for (int m = 0; m < 4; ++m) { bf16_t* rowp = O + (size_t)(row0 + ai * HALF + m * 16) * ldc + col0;
#pragma unroll
                for (int bj = 0; bj < 2; ++bj) *(u32x4*)(rowp + bj * HALF) = pack8(acc[ai][bj][m][0], acc[ai][bj][m][1]); }
    }
};

struct EpiHgrnIn {
    static constexpr bool PERM = true;
    bf16_t* P; float* LF; const float* lb;
    __device__ __forceinline__ void operator()(const f32x4 (&acc)[2][2][4][2], const Unit& u, int wr, int wc, int fr, int fq) const {
        const int seg = u.pn >> 2;
        const int row0 = u.pm * BM + wr * 64 + fr, col0 = (u.pn & 3) * BM + wc * 32 + 8 * fq;
        if (seg == 1) {
            float lbv[2][8];
#pragma unroll
            for (int bj = 0; bj < 2; ++bj) { const f32x4 a = *(const f32x4*)(lb + col0 + bj * HALF), b = *(const f32x4*)(lb + col0 + bj * HALF + 4);
                lbv[bj][0] = a[0]; lbv[bj][1] = a[1]; lbv[bj][2] = a[2]; lbv[bj][3] = a[3]; lbv[bj][4] = b[0]; lbv[bj][5] = b[1]; lbv[bj][6] = b[2]; lbv[bj][7] = b[3]; }
#pragma unroll
            for (int ai = 0; ai < 2; ++ai)
#pragma unroll
                for (int m = 0; m < 4; ++m) { const size_t off = (size_t)(row0 + ai * HALF + m * 16) * D + col0;
#pragma unroll
                    for (int bj = 0; bj < 2; ++bj) { float lf[8], ky[8];
#pragma unroll
                        for (int j = 0; j < 8; ++j) { const float f = acc[ai][bj][m][j >> 2][j & 3], l = lbv[bj][j];
                            const float sg = fsigmoid(f); const float fg = l + (1.0f - l) * sg;
                            lf[j] = __logf(fmaxf(fg, 1e-30f)); ky[j] = (1.0f - l) * (1.0f - sg); }
                        *(f32x4*)(LF + off + bj * HALF) = (f32x4){lf[0], lf[1], lf[2], lf[3]}; *(f32x4*)(LF + off + bj * HALF + 4) = (f32x4){lf[4], lf[5], lf[6], lf[7]};
                        u32x4 w; w.x = cvt_pk_bf16(ky[0], ky[1]); w.y = cvt_pk_bf16(ky[2], ky[3]); w.z = cvt_pk_bf16(ky[4], ky[5]); w.w = cvt_pk_bf16(ky[6], ky[7]);
                        *(u32x4*)(P + (size_t)T * D + off + bj * HALF) = w; }
                    __builtin_amdgcn_sched_barrier(0); }
        } else {
            bf16_t* O = P + (size_t)seg * T * D;
            const bool act = (seg != 2);
#pragma unroll
            for (int ai = 0; ai < 2; ++ai)
#pragma unroll
                for (int m = 0; m < 4; ++m) { const size_t off = (size_t)(row0 + ai * HALF + m * 16) * D + col0;
#pragma unroll
                    for (int bj = 0; bj < 2; ++bj) { f32x4 a = acc[ai][bj][m][0], b = acc[ai][bj][m][1];
                        if (act) {
#pragma unroll
                            for (int j = 0; j < 4; ++j) { a[j] = fsilu(a[j]); b[j] = fsilu(b[j]); } }
                        *(u32x4*)(O + off + bj * HALF) = pack8(a, b); }
                    __builtin_amdgcn_sched_barrier(0); }
        }
    }
};

struct EpiResid {
    static constexpr bool PERM = false;
    const float* Xin; float* Xout; const float* gate;
    int gstride;
    __device__ __forceinline__ void operator()(const f32x4 (&acc)[2][2][4][2], const Unit& u, int wr, int wc, int fr, int fq) const {
        const int row0 = u.pm * BM + wr * 64 + fr, col0 = u.pn * BM + wc * 32 + 4 * fq;
        const float* g = gate + (size_t)((u.pm * BM) / SEQ) * gstride;
        f32x4 gv[2][2];
#pragma unroll
        for (int bj = 0; bj < 2; ++bj)
#pragma unroll
            for (int n = 0; n < 2; ++n) gv[bj][n] = *(const f32x4*)(g + col0 + bj * HALF + n * 16);
#pragma unroll
        for (int ai = 0; ai < 2; ++ai)
#pragma unroll
            for (int m = 0; m < 4; ++m) { const size_t off = (size_t)(row0 + ai * HALF + m * 16) * D + col0;
#pragma unroll
                for (int bj = 0; bj < 2; ++bj)
#pragma unroll
                    for (int n = 0; n < 2; ++n) { const f32x4 xi = *(const f32x4*)(Xin + off + bj * HALF + n * 16);
                        *(f32x4*)(Xout + off + bj * HALF + n * 16) = xi + gv[bj][n] * acc[ai][bj][m][n]; }
                __builtin_amdgcn_sched_barrier(0); }
    }
};

struct EpiKvUp {
    static constexpr bool PERM = true;
    bf16_t *Kb, *Vb;
    __device__ __forceinline__ void operator()(const f32x4 (&acc)[2][2][4][2], const Unit& u, int wr, int wc, int fr, int fq) const {
        const int row0 = u.pm * BM + wr * 64 + fr, c = wc * 32 + 8 * fq, h = u.pn;
#pragma unroll
        for (int ai = 0; ai < 2; ++ai)
#pragma unroll
            for (int m = 0; m < 4; ++m) { const size_t row = (size_t)(row0 + ai * HALF + m * 16);
                *(u32x4*)(Kb + row * (MH * QK) + h * QK + c) = pack8(acc[ai][0][m][0], acc[ai][0][m][1]);
                *(u32x4*)(Vb + row * D + h * VD + c) = pack8(acc[ai][1][m][0], acc[ai][1][m][1]); }
    }
};

struct EpiQUp {
    static constexpr bool PERM = true;
    bf16_t* Qb; const float* rope;
    __device__ __forceinline__ void operator()(const f32x4 (&acc)[2][2][4][2], const Unit& u, int wr, int wc, int fr, int fq) const {
        const int row0 = u.pm * BM + wr * 64 + fr, c = wc * 32 + 8 * fq;
        if (u.pn < 4) {
#pragma unroll
            for (int ai = 0; ai < 2; ++ai)
#pragma unroll
                for (int m = 0; m < 4; ++m) { const size_t row = (size_t)(row0 + ai * HALF + m * 16);
#pragma unroll
                    for (int bj = 0; bj < 2; ++bj) *(u32x4*)(Qb + row * (MH * QK) + (2 * u.pn + bj) * QK + c) = pack8(acc[ai][bj][m][0], acc[ai][bj][m][1]); }
        } else {
            const int h = 4 * (u.pn - 4) + wc, i0 = 8 * fq;
#pragma unroll
            for (int ai = 0; ai < 2; ++ai)
#pragma unroll
                for (int m = 0; m < 4; ++m) { const size_t row = (size_t)(row0 + ai * HALF + m * 16);
                    const float* rp = rope + row * 64 + i0;
                    const f32x4 c0 = *(const f32x4*)(rp), c1 = *(const f32x4*)(rp + 4), s0 = *(const f32x4*)(rp + 32), s1 = *(const f32x4*)(rp + 36);
                    const f32x4 a0 = acc[ai][0][m][0], a1 = acc[ai][0][m][1], b0 = acc[ai][1][m][0], b1 = acc[ai][1][m][1];
                    const f32x4 o10 = a0 * c0 - b0 * s0, o11 = a1 * c1 - b1 * s1, o20 = b0 * c0 + a0 * s0, o21 = b1 * c1 + a1 * s1;
                    bf16_t* qp = Qb + row * (MH * QK) + h * QK + NOPE + i0;
                    *(u32x4*)(qp) = pack8(o10, o11); *(u32x4*)(qp + 32) = pack8(o20, o21);
                    __builtin_amdgcn_sched_barrier(0); }
        }
    }
};

template <bool GATHER_> struct MoeSched {
    static constexpr bool GATHER = GATHER_;
    const LAS int* tab;
    int NT, G, c;
    const char* Bt; size_t estride; int K;
    const int* rinfo;
    __device__ __forceinline__ unsigned adelta(const Unit& a, const Unit& b) const { return (unsigned)((b.pm - a.pm) * BM * K); }
    __device__ __forceinline__ bool next(int i, Unit& u) const {
        const int L = i * G + c; const int rb = L / NT;
        if (rb >= tab[32]) return false;
        int e = 0;
#pragma unroll 1
        for (int j = 1; j < 32; ++j) e += (tab[j] <= rb) ? 1 : 0;
        u.pm = rb; u.pn = L - rb * NT; u.e = e; return true;
    }
    __device__ __forceinline__ const char* bptr(const Unit& u) const { return Bt + (size_t)u.e * estride + (size_t)u.pn * BM * K; }
    __device__ __forceinline__ void aload(const Unit& u, unsigned (&raw)[2][2]) const {
        int R0, C0, R1, C1; { const int t_ = opaque_v((int)threadIdx.x); stage_rc(t_ * 16, R0, C0); stage_rc(t_ * 16 + 8192, R1, C1); }
        const int* rp = rinfo + u.pm * BM;
#pragma unroll
        for (int h = 0; h < 2; ++h) {
            raw[h][0] = (unsigned)rp[h * HALF + R0]; raw[h][1] = (unsigned)rp[h * HALF + R1]; }
    }
    __device__ __forceinline__ void aconv(unsigned (&o)[2][2]) const {
        int R0, C0, R1, C1; { const int t_ = opaque_v((int)threadIdx.x); stage_rc(t_ * 16, R0, C0); stage_rc(t_ * 16 + 8192, R1, C1); C0 *= 2; C1 *= 2; }
#pragma unroll
        for (int h = 0; h < 2; ++h) { const int i0 = (int)o[h][0], i1 = (int)o[h][1]; const int t0 = (i0 < 0 ? 0 : i0) >> 2, t1 = (i1 < 0 ? 0 : i1) >> 2;
            o[h][0] = (unsigned)(t0 * K + C0); o[h][1] = (unsigned)(t1 * K + C1); }
    }
    __device__ __forceinline__ void aoffs(const Unit& u, unsigned (&o)[2][2]) const {
        int R0, C0, R1, C1; { const int t_ = opaque_v((int)threadIdx.x); stage_rc(t_ * 16, R0, C0); stage_rc(t_ * 16 + 8192, R1, C1); C0 *= 2; C1 *= 2; }
        if constexpr (GATHER_) { aload(u, o); asm volatile("s_waitcnt vmcnt(0)" : "+v"(o[0][0]), "+v"(o[0][1]), "+v"(o[1][0]), "+v"(o[1][1]) :: "memory"); aconv(o); }
        else {
#pragma unroll
            for (int h = 0; h < 2; ++h) { o[h][0] = (unsigned)((u.pm * BM + h * HALF + R0) * K + C0); o[h][1] = (unsigned)((u.pm * BM + h * HALF + R1) * K + C1); }
        }
    }
};

struct EpiMoeGU {
    static constexpr bool PERM = true;
    unsigned char* ACT; const float* bgu;
    __device__ __forceinline__ void operator()(const f32x4 (&acc)[2][2][4][2], const Unit& u, int wr, int wc, int fr, int fq) const {
        const int row0 = u.pm * BM + wr * 64 + fr, c = u.pn * HALF + wc * 32 + 8 * fq;
        const float* bp = bgu + (size_t)u.e * 2048 + c;
        const f32x4 bg0 = *(const f32x4*)(bp), bg1 = *(const f32x4*)(bp + 4), bu0 = *(const f32x4*)(bp + 1024), bu1 = *(const f32x4*)(bp + 1028);
#pragma unroll
        for (int ai = 0; ai < 2; ++ai)
#pragma unroll
            for (int m = 0; m < 4; ++m) { const size_t row = (size_t)(row0 + ai * HALF + m * 16);
                f32x4 g0 = acc[ai][0][m][0] * 0.015625f + bg0, g1 = acc[ai][0][m][1] * 0.015625f + bg1, u0 = acc[ai][1][m][0] * 0.015625f + bu0, u1 = acc[ai][1][m][1] * 0.015625f + bu1, r0, r1;
#pragma unroll
                for (int j = 0; j < 4; ++j) {
                    const float ga = fminf(g0[j], SWIGLU_LIMIT), gb = fminf(g1[j], SWIGLU_LIMIT);
                    const float ua = fminf(fmaxf(u0[j], -SWIGLU_LIMIT), SWIGLU_LIMIT), ub = fminf(fmaxf(u1[j], -SWIGLU_LIMIT), SWIGLU_LIMIT);
                    r0[j] = (ua + 1.0f) * ga * fsigmoid(SWIGLU_ALPHA * ga); r1[j] = (ub + 1.0f) * gb * fsigmoid(SWIGLU_ALPHA * gb); }
                *(u32x2*)(ACT + row * FF + c) = pack8_fp8(r0, r1);
                __builtin_amdgcn_sched_barrier(0); }
    }
};

struct EpiMoeDN {
    static constexpr bool PERM = true;
    bf16_t* YS; const float* bdn; const int* rinfo; const float* rw;
    __device__ __forceinline__ void operator()(const f32x4 (&acc)[2][2][4][2], const Unit& u, int wr, int wc, int fr, int fq) const {
        const int row0 = u.pm * BM + wr * 64 + fr, c = u.pn * BM + wc * 32 + 8 * fq;
        const float* bp = bdn + (size_t)u.e * 1024 + c;
#pragma unroll
        for (int ai = 0; ai < 2; ++ai)
#pragma unroll
            for (int m = 0; m < 4; ++m) { const int row = row0 + ai * HALF + m * 16; const int info = rinfo[row]; const float w = rw[row] * 0.015625f;
                if (info >= 0) { bf16_t* yp = YS + (size_t)info * D + c;
#pragma unroll
                    for (int bj = 0; bj < 2; ++bj) { const f32x4 b0 = *(const f32x4*)(bp + bj * HALF) * 64.0f, b1 = *(const f32x4*)(bp + bj * HALF + 4) * 64.0f;
                        *(u32x4*)(yp + bj * HALF) = pack8((acc[ai][bj][m][0] + b0) * w, (acc[ai][bj][m][1] + b1) * w); } }
                __builtin_amdgcn_sched_barrier(0); }
    }
};
}
struct Ctx {
    LAS unsigned char* lds;
    int G, vcu;
    const float* in[28]; float* out; unsigned char* ws;
    __device__ __forceinline__ float* MOD() const { return (float*)(ws + WS_MOD); }
    __device__ __forceinline__ unsigned* ctl() const { return (unsigned*)(ws + WS_CTL); }
};
__device__ __forceinline__ const float* modp(const Ctx& F, int l, int b, int which) { return (const float*)(F.ws + WS_MOD) + ((size_t)(l * NB + b) * 6 + which) * D; }

__device__ const double ROPE_INV_FREQ[32] = {
    1.0, 0.7498942093324559, 0.5623413251903491, 0.4216965034285822, 0.31622776601683794, 0.23713737056616552, 0.1778279410038923, 0.1333521432163324,
    0.1, 0.07498942093324559, 0.05623413251903491, 0.04216965034285822, 0.03162277660168379, 0.023713737056616554, 0.01778279410038923, 0.01333521432163324,
    0.01, 0.007498942093324559, 0.005623413251903491, 0.004216965034285822, 0.0031622776601683794, 0.0023713737056616554, 0.001778279410038923, 0.001333521432163324,
    0.001, 0.0007498942093324559, 0.0005623413251903491, 0.0004216965034285822, 0.00031622776601683794, 0.00023713737056616554, 0.0001778279410038923, 0.0001333521432163324};

__device__ __forceinline__ int map_rows(int maptype, int n0) {
    if (maptype == 1) { return n0 < 1024 ? (n0 >> 7) * 256 + (n0 & 127) : ((n0 - 1024) >> 7) * 256 + 128 + ((n0 - 1024) & 127); }
    if (maptype == 2) { const int h = n0 / QK, d = n0 - h * QK; if (d < NOPE) return h * NOPE + d; const int i = d - NOPE;
                        return 1024 + (h >> 2) * 256 + (i >> 5) * 128 + (h & 3) * 32 + (i & 31); }
    return n0;
}
struct ConvD { const float* src; unsigned char* dst; int N, Kb, f8; };
#define CONV_DEC(Wp, wstride, nmat, K_, N_, dstoff, dstride, mt, f8_) do { const int per = ((K_) / 64) * ((N_) / 32), tot = (nmat) * per; \
        if (r < tot) { const int mi = r / per, item = r - mi * per, nblk = (N_) / 32, kb = item / nblk, nb = item - kb * nblk, es = (f8_) ? 1 : 2; \
            d.src = (Wp) + (size_t)mi * (wstride) + (size_t)(64 * kb) * (N_) + 32 * nb; d.N = (N_); d.Kb = (K_) * es; d.f8 = (f8_); \
            d.dst = F.ws + (dstoff) + ((size_t)mi * (dstride) + (size_t)map_rows((mt), 32 * nb) * (K_) + 64 * kb) * es; return d; } r -= tot; } while (0)
__device__ __forceinline__ ConvD conv_decode(const Ctx& F, int it) {
    ConvD d; int r = it;
    CONV_DEC(F.in[23], (size_t)1024 * 2048, 128, 1024, 2048, WS_WGU, (size_t)2048 * 1024, 1, 1);
    CONV_DEC(F.in[25], (size_t)1024 * 1024, 128, 1024, 1024, WS_WDN, (size_t)1024 * 1024, 0, 1);
    CONV_DEC(F.in[7],  (size_t)1024 * 4096, 2, 1024, 4096, WS_WIN, (size_t)4096 * 1024, 0, 0);
    CONV_DEC(F.in[10], (size_t)1024 * 1024, 2, 1024, 1024, WS_WOUT, (size_t)1024 * 1024, 0, 0);
    CONV_DEC(F.in[14], (size_t)0, 1, 1024, 320, WS_WDKV, (size_t)0, 0, 0);
    CONV_DEC(F.in[16], (size_t)0, 1, 256, 2048, WS_WUKV, (size_t)0, 0, 0);
    CONV_DEC(F.in[17], (size_t)1024 * 384, 2, 1024, 384, WS_WDQ, (size_t)512 * 1024, 0, 0);
    CONV_DEC(F.in[19], (size_t)384 * 1536, 2, 384, 1536, WS_WUQ, (size_t)1536 * 384, 2, 0);
    CONV_DEC(F.in[20], (size_t)1024 * 1024, 2, 1024, 1024, WS_WO, (size_t)1024 * 1024, 0, 0);
    d.src = F.in[20]; d.dst = F.ws + WS_WO; d.N = 1024; d.Kb = 2048; d.f8 = 0; return d;
}
__device__ __forceinline__ void conv_load(const ConvD& d, int lane, float (&wv)[32]) {
    const float* p = d.src + (size_t)(lane >> 5) * d.N + (lane & 31);
#pragma unroll
    for (int i = 0; i < 32; ++i) wv[i] = p[(size_t)(2 * i) * d.N];
}
__device__ __forceinline__ void conv_store(const ConvD& d, int lane, LAS float* scr, const float (&wv)[32]) {
#pragma unroll
    for (int i = 0; i < 32; ++i) scr[(2 * i + (lane >> 5)) * 33 + (lane & 31)] = wv[i];
    LDS_WAIT(); asm volatile("" ::: "memory");
    const int c = lane & 7;
#pragma unroll
    for (int j = 0; j < 4; ++j) { const int n = (lane >> 3) + 8 * j; const LAS float* s = scr + (8 * c) * 33 + n;
        if (d.f8) { int w0 = 0, w1 = 0;
            w0 = __builtin_amdgcn_cvt_pk_fp8_f32(s[0 * 33] * 64.f, s[1 * 33] * 64.f, w0, false); w0 = __builtin_amdgcn_cvt_pk_fp8_f32(s[2 * 33] * 64.f, s[3 * 33] * 64.f, w0, true);
            w1 = __builtin_amdgcn_cvt_pk_fp8_f32(s[4 * 33] * 64.f, s[5 * 33] * 64.f, w1, false); w1 = __builtin_amdgcn_cvt_pk_fp8_f32(s[6 * 33] * 64.f, s[7 * 33] * 64.f, w1, true);
            u32x2 o; o.x = (unsigned)w0; o.y = (unsigned)w1; *(u32x2*)(d.dst + (size_t)n * d.Kb + 8 * c) = o; }
        else { u32x4 o; o.x = cvt_pk_bf16(s[0 * 33], s[1 * 33]); o.y = cvt_pk_bf16(s[2 * 33], s[3 * 33]); o.z = cvt_pk_bf16(s[4 * 33], s[5 * 33]); o.w = cvt_pk_bf16(s[6 * 33], s[7 * 33]);
            *(u32x4*)(d.dst + (size_t)n * d.Kb + 16 * c) = o; } }
    LDS_WAIT(); asm volatile("" ::: "memory");
}
__device__ __forceinline__ void phase_convert(const Ctx& F) {
    PHASE_IDS;
    LAS float* scr = (LAS float*)(F.lds + wave * 16384);
    const int gw = F.vcu * NWAVES + wave, NGW = F.G * NWAVES;
    constexpr int TOTAL = 2 * 16 * 128 + 2 * 16 * 32 + 16 * 10 + 4 * 64 + 2 * 16 * 12 + 2 * 6 * 48 + 2 * 16 * 32 + 128 * 16 * 64 + 128 * 16 * 32;
    float wa[32], wb[32];
    int it = gw;
    if (it < TOTAL) { ConvD da = conv_decode(F, it); conv_load(da, lane, wa);
        for (;;) {
            const int it1 = it + NGW; ConvD db = da; const bool h1 = it1 < TOTAL;
            if (h1) { db = conv_decode(F, it1); conv_load(db, lane, wb); }
            conv_store(da, lane, scr, wa);
            if (!h1) break;
            const int it2 = it1 + NGW; const bool h2 = it2 < TOTAL;
            if (h2) { da = conv_decode(F, it2); conv_load(da, lane, wa); }
            conv_store(db, lane, scr, wb);
            if (!h2) break;
            it = it2;
        } }
    const int gt = (F.vcu * NTHREADS + tid), NGT = F.G * NTHREADS;
    for (int i = gt; i < 192 * 1024 / 8; i += NGT) *((u32x4*)(F.ws + WS_WDKV + (size_t)320 * 1024 * 2) + i) = (u32x4){0u, 0u, 0u, 0u};
    for (int i = gt; i < 2 * 128 * 1024 / 8; i += NGT) { const int m = i / (128 * 1024 / 8), j = i - m * (128 * 1024 / 8);
        *((u32x4*)(F.ws + WS_WDQ + (size_t)m * 512 * 1024 * 2 + (size_t)384 * 1024 * 2) + j) = (u32x4){0u, 0u, 0u, 0u}; }
}

__device__ __forceinline__ void phase_mod(const Ctx& F) {
    PHASE_IDS;
    LAS float* cact = (LAS float*)(F.lds);
    LAS float* red = (LAS float*)(F.lds + 65536);
    const float* c = F.in[1];
    for (int i = tid; i < NB * D; i += NTHREADS) { const int b = i / D, k = i - b * D; cact[k * 16 + b] = fsilu(c[i]); }
    __syncthreads();
    constexpr int NTASK = (DEPTH * 6 * D + 2 * D) / 128;
    const int kq = tid >> 7, jj = tid & 127;
    for (int task = F.vcu; task < NTASK; task += F.G) {
        const int gcol = task * 128 + jj;
        const float* W; const float* bias; float* outp; int N, col, l = gcol / (6 * D);
        if (l < DEPTH) { col = gcol - l * 6 * D; N = 6 * D; W = F.in[5] + (size_t)l * D * N; bias = F.in[6] + (size_t)l * N; outp = (float*)(F.ws + WS_MOD) + (size_t)l * NB * N; }
        else { col = gcol - DEPTH * 6 * D; N = 2 * D; W = F.in[12]; bias = F.in[13]; outp = (float*)(F.ws + WS_KVMOD); }
        float acc[16];
#pragma unroll
        for (int b = 0; b < 16; ++b) acc[b] = 0.f;
#pragma unroll 8
        for (int k = kq * 256; k < kq * 256 + 256; ++k) {
            const float w = W[(size_t)k * N + col];
            const LAS f32x4* cp = (const LAS f32x4*)(cact + k * 16);
#pragma unroll
            for (int q = 0; q < 4; ++q) { const f32x4 cv = cp[q]; acc[4 * q] += cv[0] * w; acc[4 * q + 1] += cv[1] * w; acc[4 * q + 2] += cv[2] * w; acc[4 * q + 3] += cv[3] * w; }
        }
#pragma unroll
        for (int q = 0; q < 4; ++q) *(LAS f32x4*)(red + (kq * 128 + jj) * 16 + 4 * q) = (f32x4){acc[4 * q], acc[4 * q + 1], acc[4 * q + 2], acc[4 * q + 3]};
        __syncthreads();
#pragma unroll
        for (int q = 0; q < 4; ++q) { const int o = tid + q * NTHREADS, cj = o >> 4, b = o & 15;
            const float s = red[(0 * 128 + cj) * 16 + b] + red[(1 * 128 + cj) * 16 + b] + red[(2 * 128 + cj) * 16 + b] + red[(3 * 128 + cj) * 16 + b];
            const int oc = (task * 128 + cj) - (l < DEPTH ? l * 6 * D : DEPTH * 6 * D);
            outp[(size_t)b * N + oc] = s + bias[oc]; }
        __syncthreads();
    }
    const int gt = (F.vcu * NTHREADS + tid), NGT = F.G * NTHREADS;
    for (int i = gt; i < D; i += NGT) { const float l0 = F.in[8][i], l1 = F.in[8][D + i];
        ((float*)(F.ws + WS_LB))[i] = 0.f; ((float*)(F.ws + WS_LB))[D + i] = 1.0f / (1.0f + __expf(l0 - l1)); }
    const int* pos = (const int*)F.in[2];
    for (int i = gt; i < T * 32; i += NGT) { const int t = i >> 5, j = i & 31;
        const double rev = (double)pos[t] * ROPE_INV_FREQ[j] * 0.15915494309189535;
        const float fr = (float)(rev - floor(rev));
        float* rp = (float*)(F.ws + WS_ROPE) + (size_t)t * 64 + j;
        rp[0] = __builtin_amdgcn_cosf(fr); rp[32] = __builtin_amdgcn_sinf(fr); }
}

struct Row4 { f32x4 v[4]; };
__device__ __forceinline__ Row4 ld_row_f32(const float* p, int lane) { Row4 r; const f32x4* q = (const f32x4*)p + lane;
#pragma unroll
    for (int j = 0; j < 4; ++j) r.v[j] = q[64 * j]; return r; }
__device__ __forceinline__ void st_row_f32(float* p, int lane, const Row4& r) { f32x4* q = (f32x4*)p + lane;
#pragma unroll
    for (int j = 0; j < 4; ++j) q[64 * j] = r.v[j]; }
__device__ __forceinline__ Row4 ld_row_bf16(const bf16_t* p, int lane) { Row4 r; const u32x2* q = (const u32x2*)p + lane;
#pragma unroll
    for (int j = 0; j < 4; ++j) { const u32x2 w = q[64 * j]; r.v[j] = (f32x4){bflo(w.x), bfhi(w.x), bflo(w.y), bfhi(w.y)}; } return r; }
__device__ __forceinline__ void st_row_bf16(bf16_t* p, int lane, const Row4& r) { u32x2* q = (u32x2*)p + lane;
#pragma unroll
    for (int j = 0; j < 4; ++j) { u32x2 w; w.x = cvt_pk_bf16(r.v[j][0], r.v[j][1]); w.y = cvt_pk_bf16(r.v[j][2], r.v[j][3]); q[64 * j] = w; } }
typedef float f32x2_ __attribute__((ext_vector_type(2)));
__device__ __forceinline__ Row4 ld_row_fp8(const unsigned char* p, int lane) { Row4 r; const unsigned* q = (const unsigned*)p + lane;
#pragma unroll
    for (int j = 0; j < 4; ++j) { const int w = (int)q[64 * j]; const f32x2_ lo = __builtin_amdgcn_cvt_pk_f32_fp8(w, false), hi = __builtin_amdgcn_cvt_pk_f32_fp8(w, true); r.v[j] = (f32x4){lo[0], lo[1], hi[0], hi[1]}; } return r; }
__device__ __forceinline__ void st_row_fp8(unsigned char* p, int lane, const Row4& r) { unsigned* q = (unsigned*)p + lane;
#pragma unroll
    for (int j = 0; j < 4; ++j) { int w = 0; w = __builtin_amdgcn_cvt_pk_fp8_f32(r.v[j][0], r.v[j][1], w, false); w = __builtin_amdgcn_cvt_pk_fp8_f32(r.v[j][2], r.v[j][3], w, true); q[64 * j] = (unsigned)w; } }
__device__ __forceinline__ float row_ssq(const Row4& r) { float s = 0.f;
#pragma unroll
    for (int j = 0; j < 4; ++j) s += (r.v[j][0] * r.v[j][0] + r.v[j][1] * r.v[j][1]) + (r.v[j][2] * r.v[j][2] + r.v[j][3] * r.v[j][3]);
    return wave_sum(s); }
__device__ __forceinline__ Row4 norm_mod(const Row4& x, float rstd, const float* g, const float* sc, const float* sh, int lane) {
    const Row4 gv = ld_row_f32(g, lane), scv = ld_row_f32(sc, lane), shv = ld_row_f32(sh, lane); Row4 h;
#pragma unroll
    for (int j = 0; j < 4; ++j) h.v[j] = (x.v[j] * rstd * gv.v[j]) * (scv.v[j] + 1.0f) + shv.v[j];
    return h; }

__device__ __forceinline__ void phase_combine(const Ctx& F, int l, bool dummy = false) {
    PHASE_IDS;
    const int gw = F.vcu * NWAVES + wave, NGW = F.G * NWAVES;
    const float* Xin = (l < 0) ? F.in[0] : F.out;
    float* Xout = dummy ? (float*)(F.ws + WS_ACT) : F.out; bf16_t* Hout = (bf16_t*)(F.ws + (dummy ? WS_ACT + (size_t)T * D * 4 : WS_H));
    const bf16_t* YS = (const bf16_t*)(F.ws + WS_YS);
    for (int m = gw; m < T; m += NGW) {
        const int b = m / SEQ;
        Row4 x = ld_row_f32(Xin + (size_t)m * D, lane);
        if (l >= 0) {
            Row4 y = ld_row_bf16(YS + (size_t)(m * 4) * D, lane);
#pragma unroll
            for (int s = 1; s < 4; ++s) { const Row4 t = ld_row_bf16(YS + (size_t)(m * 4 + s) * D, lane);
#pragma unroll
                for (int j = 0; j < 4; ++j) y.v[j] += t.v[j]; }
            const Row4 gt = ld_row_f32(modp(F, l, b, 5), lane);
#pragma unroll
            for (int j = 0; j < 4; ++j) x.v[j] += gt.v[j] * y.v[j];
        }
        const float rstd = rsqrtf(row_ssq(x) * (1.0f / D) + NORM_EPS);
        if (l == DEPTH - 1) {
            const Row4 gv = ld_row_f32(F.in[27], lane); Row4 o;
#pragma unroll
            for (int j = 0; j < 4; ++j) o.v[j] = x.v[j] * rstd * gv.v[j];
            st_row_f32(Xout + (size_t)m * D, lane, o);
        } else {
            if (l >= 0) st_row_f32(Xout + (size_t)m * D, lane, x);
            const int ln = l + 1;
            const Row4 h = norm_mod(x, rstd, F.in[3] + (size_t)ln * D, modp(F, ln, b, 1), modp(F, ln, b, 0), lane);
            st_row_bf16(Hout + (size_t)m * D, lane, h);
            if (l == NA - 1) {
                const float* kvm = (const float*)(F.ws + WS_KVMOD) + (size_t)b * 2 * D;
                const Row4 hk = norm_mod(x, rstd, F.in[11], kvm + D, kvm, lane);
                st_row_bf16((bf16_t*)(F.ws + WS_HK) + (size_t)m * D, lane, hk);
            }
        }
    }
}
__device__ __forceinline__ void phase_final_only(const Ctx& F, bool from_input) {
    PHASE_IDS;
    const int gw = F.vcu * NWAVES + wave, NGW = F.G * NWAVES;
    const float* Xin = from_input ? F.in[0] : F.out;
    for (int m = gw; m < T; m += NGW) {
        Row4 x = ld_row_f32(Xin + (size_t)m * D, lane);
        const float rstd = rsqrtf(row_ssq(x) * (1.0f / D) + NORM_EPS);
        const Row4 gv = ld_row_f32(F.in[27], lane); Row4 o;
#pragma unroll
        for (int j = 0; j < 4; ++j) o.v[j] = x.v[j] * rstd * gv.v[j];
        st_row_f32(F.out + (size_t)m * D, lane, o);
    }
}

__device__ __forceinline__ void phase_hgrn_gate(const Ctx& F, int l) {
    PHASE_IDS;
    const int gw = F.vcu * NWAVES + wave, NGW = F.G * NWAVES;
    const bf16_t* OO = (const bf16_t*)(F.ws + WS_OO); const bf16_t* GS = (const bf16_t*)(F.ws + WS_GS); bf16_t* OG = (bf16_t*)(F.ws + WS_OG);
    f32x4 gv; { const float* g = F.in[9] + (size_t)l * HGD + 4 * (lane & 31); gv = *(const f32x4*)g; }
    for (int m = gw; m < T; m += NGW) {
        const Row4 o = ld_row_bf16(OO + (size_t)m * D, lane), g = ld_row_bf16(GS + (size_t)m * D, lane); Row4 r;
#pragma unroll
        for (int j = 0; j < 4; ++j) {
            float s = (o.v[j][0] * o.v[j][0] + o.v[j][1] * o.v[j][1]) + (o.v[j][2] * o.v[j][2] + o.v[j][3] * o.v[j][3]);
#pragma unroll
            for (int d = 1; d < 32; d <<= 1) s += __shfl_xor(s, d);
            const float rstd = rsqrtf(s * (1.0f / HGD) + NORM_EPS);
            r.v[j] = (o.v[j] * rstd * gv) * g.v[j];
        }
        st_row_bf16(OG + (size_t)m * D, lane, r);
    }
}

__device__ __forceinline__ void phase_kv_rows(const Ctx& F) {
    PHASE_IDS;
    const int gw = F.vcu * NWAVES + wave, NGW = F.G * NWAVES;
    const bf16_t* CKR = (const bf16_t*)(F.ws + WS_CKR); bf16_t* CKV = (bf16_t*)(F.ws + WS_CKV); bf16_t* KB = (bf16_t*)(F.ws + WS_KB);
    const float* rope = (const float*)(F.ws + WS_ROPE);
    const f32x4 gv = *(const f32x4*)(F.in[15] + 4 * lane);
    for (int m = gw; m < T; m += NGW) {
        const bf16_t* rp = CKR + (size_t)m * 512;
        const u32x2 w = *((const u32x2*)rp + lane);
        f32x4 v = (f32x4){bflo(w.x), bfhi(w.x), bflo(w.y), bfhi(w.y)};
        const float ss = wave_sum((v[0] * v[0] + v[1] * v[1]) + (v[2] * v[2] + v[3] * v[3]));
        const float rstd = rsqrtf(ss * (1.0f / KVRANK) + NORM_EPS);
        v = v * rstd * gv;
        u32x2 o; o.x = cvt_pk_bf16(v[0], v[1]); o.y = cvt_pk_bf16(v[2], v[3]);
        *((u32x2*)(CKV + (size_t)m * KVRANK) + lane) = o;
        const int i = lane & 31;
        const float t1 = bf2f(rp[KVRANK + i]), t2 = bf2f(rp[KVRANK + 32 + i]);
        const float cs = rope[(size_t)m * 64 + i], sn = rope[(size_t)m * 64 + 32 + i];
        const float r1 = t1 * cs - t2 * sn, r2 = t2 * cs + t1 * sn;
        const unsigned short b1 = f2bf(r1), b2 = f2bf(r2);
        const int hb = (lane >> 5) * 4;
#pragma unroll
        for (int h = 0; h < 4; ++h) { bf16_t* kp = KB + (size_t)m * (MH * QK) + (hb + h) * QK + NOPE; kp[i] = b1; kp[32 + i] = b2; }
    }
}

__device__ __forceinline__ void phase_cq_rows(const Ctx& F, int j) {
    PHASE_IDS;
    const int gw = F.vcu * NWAVES + wave, NGW = F.G * NWAVES;
    const bf16_t* CQ = (const bf16_t*)(F.ws + WS_CQ); bf16_t* CQN = (bf16_t*)(F.ws + WS_CQN);
    const float* g = F.in[18] + (size_t)j * QRANK;
    float gq[3][2];
#pragma unroll
    for (int q = 0; q < 3; ++q) { gq[q][0] = g[128 * q + 2 * lane]; gq[q][1] = g[128 * q + 2 * lane + 1]; }
    for (int m = gw; m < T; m += NGW) {
        const unsigned* rp = (const unsigned*)(CQ + (size_t)m * 512);
        float v[3][2]; float s = 0.f;
#pragma unroll
        for (int q = 0; q < 3; ++q) { const unsigned w = rp[64 * q + lane]; v[q][0] = bflo(w); v[q][1] = bfhi(w); s += v[q][0] * v[q][0] + v[q][1] * v[q][1]; }
        const float rstd = rsqrtf(wave_sum(s) * (1.0f / QRANK) + NORM_EPS);
        unsigned* op = (unsigned*)(CQN + (size_t)m * QRANK);
#pragma unroll
        for (int q = 0; q < 3; ++q) op[64 * q + lane] = cvt_pk_bf16(v[q][0] * rstd * gq[q][0], v[q][1] * rstd * gq[q][1]);
    }
}
__device__ __forceinline__ void phase_router(const Ctx& F, int l, bool dummy = false) {
    PHASE_IDS;
    LAS float* gmt = (LAS float*)(F.lds);
    LAS float* sht = (LAS float*)(F.lds + 4096);
    LAS float* rst = (LAS float*)(F.lds + 8192) + wave * 32;
    LAS float* lgt = (LAS float*)(F.lds + 16384) + wave * (32 * 33);
    LAS int* hist = (LAS int*)(F.lds + 65536);
    LAS int* basev = (LAS int*)(F.lds + 65536 + 256);
    const float* Wr = F.in[21] + (size_t)l * D * NE; const float* br = F.in[22] + (size_t)l * NE;
    const float* X = F.out; unsigned char* H = (unsigned char*)(F.ws + (dummy ? WS_ACT : WS_H));
    int* TKE = (int*)(F.ws + (dummy ? WS_YS : WS_TKE)); float* TKW = (float*)(F.ws + (dummy ? WS_YS + 4 * MiB : WS_TKW)); int* TKR = (int*)(F.ws + (dummy ? WS_YS + 8 * MiB : WS_TKR));
    unsigned* cnt = F.ctl() + CW_CNT + l * 64 + (dummy ? 1024 : 0);
    const int r32 = lane & 31, hi = lane >> 5;
    for (int bt = F.vcu; bt < T / 256; bt += F.G) {
        const int b = (bt * 256) / SEQ;
        const float* g = F.in[4] + (size_t)l * D; const float* sc = modp(F, l, b, 4); const float* sh = modp(F, l, b, 3);
        for (int i = tid; i < D; i += NTHREADS) { gmt[i] = g[i] * (1.0f + sc[i]); sht[i] = sh[i]; }
        if (tid < 32) hist[tid] = 0;
        __syncthreads();
        const int row0 = bt * 256 + wave * 32;
        for (int i = 0; i < 32; ++i) {
            const Row4 x = ld_row_f32(X + (size_t)(row0 + i) * D, lane);
            const float rstd = rsqrtf(row_ssq(x) * (1.0f / D) + NORM_EPS);
            Row4 h;
#pragma unroll
            for (int j = 0; j < 4; ++j) { const f32x4 gm = *(const LAS f32x4*)(gmt + 256 * j + 4 * lane), s4 = *(const LAS f32x4*)(sht + 256 * j + 4 * lane); h.v[j] = x.v[j] * rstd * gm + s4; }
            st_row_fp8(H + (size_t)(row0 + i) * D, lane, h);
            if (lane == 0) rst[i] = rstd;
        }
        LDS_WAIT(); asm volatile("" ::: "memory");
        f32x16 acc = {};
        { const float rstd = rst[r32]; const float* xr = X + (size_t)(row0 + r32) * D + 4 * hi; const float* wp = Wr + (size_t)(4 * hi) * NE + r32;
#pragma unroll 2
          for (int j = 0; j < 128; ++j) {
              const f32x4 xv = *(const f32x4*)(xr + 8 * j);
              const f32x4 gm = *(const LAS f32x4*)(gmt + 8 * j + 4 * hi), s4 = *(const LAS f32x4*)(sht + 8 * j + 4 * hi);
              const f32x4 hv = xv * rstd * gm + s4;
              const float w0 = wp[(size_t)(8 * j + 0) * NE], w1 = wp[(size_t)(8 * j + 1) * NE], w2 = wp[(size_t)(8 * j + 2) * NE], w3 = wp[(size_t)(8 * j + 3) * NE];
              acc = __builtin_amdgcn_mfma_f32_32x32x2f32(hv[0], w0, acc, 0, 0, 0);
              acc = __builtin_amdgcn_mfma_f32_32x32x2f32(hv[1], w1, acc, 0, 0, 0);
              acc = __builtin_amdgcn_mfma_f32_32x32x2f32(hv[2], w2, acc, 0, 0, 0);
              acc = __builtin_amdgcn_mfma_f32_32x32x2f32(hv[3], w3, acc, 0, 0, 0);
          } }
        { const float bias = br[r32];
#pragma unroll
          for (int r = 0; r < 16; ++r) lgt[((r & 3) + 8 * (r >> 2) + 4 * hi) * 33 + r32] = acc[r] + bias; }
        LDS_WAIT(); asm volatile("" ::: "memory");
        int te[4]; float tw[4]; int tr[4];
        if (lane < 32) {
            float v[32];
#pragma unroll
            for (int e = 0; e < 32; ++e) v[e] = lgt[lane * 33 + e];
            float tv[4];
#pragma unroll
            for (int k = 0; k < 4; ++k) { float best = v[0]; int bi = 0;
#pragma unroll
                for (int e = 1; e < 32; ++e) { if (v[e] > best) { best = v[e]; bi = e; } }
                tv[k] = best; te[k] = bi;
#pragma unroll
                for (int e = 0; e < 32; ++e) v[e] = (e == bi) ? -3.0e38f : v[e]; }
            const float e1 = __expf(tv[1] - tv[0]), e2 = __expf(tv[2] - tv[0]), e3 = __expf(tv[3] - tv[0]);
            const float inv = 1.0f / (1.0f + e1 + e2 + e3);
            tw[0] = inv; tw[1] = e1 * inv; tw[2] = e2 * inv; tw[3] = e3 * inv;
#pragma unroll
            for (int k = 0; k < 4; ++k) tr[k] = __hip_atomic_fetch_add(hist + te[k], 1, __ATOMIC_RELAXED, __HIP_MEMORY_SCOPE_WORKGROUP);
        }
        __syncthreads();
        if (tid < 32) basev[tid] = (int)__hip_atomic_fetch_add(cnt + tid, (unsigned)hist[tid], RLX_AGENT);
        __syncthreads();
        if (lane < 32) {
            const int row = row0 + lane;
            int4 ev = make_int4(te[0], te[1], te[2], te[3]); *(int4*)(TKE + (size_t)row * 4) = ev;
            *(f32x4*)(TKW + (size_t)row * 4) = (f32x4){tw[0], tw[1], tw[2], tw[3]};
            int4 rv = make_int4(basev[te[0]] + tr[0], basev[te[1]] + tr[1], basev[te[2]] + tr[2], basev[te[3]] + tr[3]); *(int4*)(TKR + (size_t)row * 4) = rv;
        }
        __syncthreads();
    }
}

__device__ __forceinline__ void moe_table(const Ctx& F, int l) {
    PHASE_IDS;
    LAS int* tab = (LAS int*)(F.lds + LDS_TAB);
    if (tid < 32) tab[64 + tid] = (int)__hip_atomic_load(F.ctl() + CW_CNT + l * 64 + tid, RLX_AGENT);
    __syncthreads();
    if (tid == 0) { int s = 0;
        for (int e = 0; e < 32; ++e) { tab[e] = s; s += (tab[64 + e] + MOEB - 1) / MOEB; }
        tab[32] = s; }
    __syncthreads();
}
__device__ __forceinline__ void phase_scatter(const Ctx& F, int l) {
    PHASE_IDS;
    moe_table(F, l);
    const LAS int* tab = (const LAS int*)(F.lds + LDS_TAB);
    const int* TKE = (const int*)(F.ws + WS_TKE); const float* TKW = (const float*)(F.ws + WS_TKW); const int* TKR = (const int*)(F.ws + WS_TKR);
    int* RI = (int*)(F.ws + WS_RINFO); float* RW = (float*)(F.ws + WS_RW);
    const int gt = (F.vcu * NTHREADS + tid), NGT = F.G * NTHREADS;
    for (int i = gt; i < NASSIGN; i += NGT) { const int e = TKE[i], r = TKR[i]; const int row = tab[e] * MOEB + r; RI[row] = i; RW[row] = TKW[i]; }
    for (int i = gt; i < NE * MOEB; i += NGT) { const int e = i >> 8, j = i & 255; const int c = tab[64 + e]; const int npad = (tab[e + 1] - tab[e]) * MOEB - c;
        if (j < npad) { const int row = tab[e] * MOEB + c + j; RI[row] = -1; RW[row] = 0.f; } }
}
namespace scan {
constexpr int RS_K = 272, RS_S = 144;
constexpr int O_QT = 0, O_KT = 17408, O_QH = 34816, O_KHT = 52224, O_VT = 70656, O_SS = 79872, O_ST0 = 89088, O_ST1 = 106496, O_SEG = 123904, O_DEC = 125952;
__device__ __forceinline__ bf16x8 ldfrag(const LAS unsigned char* base, int row, int rs, int kb  ) { return *(const LAS bf16x8*)(base + row * rs + kb); }
}
__device__ __forceinline__ void phase_hgrn_scan(const Ctx& F) {
    PHASE_IDS;
    using namespace scan;
    LAS unsigned char* L = F.lds;
    const bf16_t* QH_g = (const bf16_t*)(F.ws + WS_QH); const bf16_t* KK_g = (const bf16_t*)(F.ws + WS_KK); const bf16_t* VV_g = (const bf16_t*)(F.ws + WS_VV);
    const float* LF_g = (const float*)(F.ws + WS_LF); bf16_t* OO_g = (bf16_t*)(F.ws + WS_OO);
    const int w = wave, l15 = lane & 15, l4 = lane >> 4;
    const int cg = lane & 3, seg = lane >> 2, kc0 = 16 * w + 4 * cg;
    const int vs = tid >> 3, vc = (tid & 7) * 8;
    LAS float* DEC = (LAS float*)(L + O_DEC);
    for (int u = F.vcu; u < NB * HGH * 2; u += F.G) {
        const int vh = u & 1, h = (u >> 1) & 7, b = u >> 4;
        const size_t rowb = (size_t)b * SEQ; const int hk = h * HGD, hv = h * HGD + vh * 64;
        for (int i = tid; i < 64 * RS_K / 16; i += NTHREADS) *(LAS u32x4*)(L + O_ST0 + i * 16) = (u32x4){0u, 0u, 0u, 0u};
        f32x4 sacc[4];
#pragma unroll
        for (int vi = 0; vi < 4; ++vi) sacc[vi] = (f32x4){0.f, 0.f, 0.f, 0.f};
        f32x4 lfr[4]; u32x2 qr[4], kr[4]; u32x4 vw;
#define SCAN_LOAD(c_) do { const size_t base_ = (rowb + (size_t)(c_) * HGC + 4 * seg) * D + hk + kc0; \
            _Pragma("unroll") for (int i = 0; i < 4; ++i) { lfr[i] = *(const f32x4*)(LF_g + base_ + (size_t)i * D); qr[i] = *(const u32x2*)(QH_g + base_ + (size_t)i * D); kr[i] = *(const u32x2*)(KK_g + base_ + (size_t)i * D); } \
            vw = *(const u32x4*)(VV_g + (rowb + (size_t)(c_) * HGC + vs) * D + hv + vc); } while (0)
        SCAN_LOAD(0);
        __syncthreads();
        for (int c = 0; c < SEQ / HGC; ++c) {
            const size_t r0 = rowb + (size_t)c * HGC;
            const LAS unsigned char* STc = L + ((c & 1) ? O_ST1 : O_ST0); LAS unsigned char* STn = L + ((c & 1) ? O_ST0 : O_ST1);
            { float cs[4][4], I[4];
#pragma unroll
              for (int j = 0; j < 4; ++j) { float run = 0.f;
#pragma unroll
                  for (int i = 0; i < 4; ++i) { run += lfr[i][j]; cs[i][j] = run; }
                  float x = run;
#pragma unroll
                  for (int d = 4; d < 64; d <<= 1) { const float y = __shfl_up(x, d); if (lane >= d) x += y; }
                  I[j] = x; }
              float qv[4][4], kv[4][4];
#pragma unroll
              for (int i = 0; i < 4; ++i) { qv[i][0] = bflo(qr[i].x); qv[i][1] = bfhi(qr[i].x); qv[i][2] = bflo(qr[i].y); qv[i][3] = bfhi(qr[i].y);
                  kv[i][0] = bflo(kr[i].x); kv[i][1] = bfhi(kr[i].x); kv[i][2] = bflo(kr[i].y); kv[i][3] = bfhi(kr[i].y); }
              float qt[4][4], kt[4][4], qh[4][4], kh[4][4];
#pragma unroll
              for (int j = 0; j < 4; ++j) { const float ref = __shfl(I[j], cg + 28), last = __shfl(I[j], cg + 60), P = I[j] - cs[3][j];
                  const float eref = __expf(ref), elr = __expf(last - ref);
                  if (seg == 0) DEC[kc0 + j] = eref * elr;
#pragma unroll
                  for (int i = 0; i < 4; ++i) { const float d = fminf(fmaxf(P + cs[i][j] - ref, -60.f), 60.f); const float E = __expf(d), R = __builtin_amdgcn_rcpf(E);
                      qt[i][j] = qv[i][j] * E; kt[i][j] = kv[i][j] * R; qh[i][j] = qt[i][j] * eref; kh[i][j] = kt[i][j] * elr; } }
#pragma unroll
              for (int i = 0; i < 4; ++i) { const int ro = (4 * seg + i) * RS_K + kc0 * 2; u32x2 o;
                  o.x = cvt_pk_bf16(qt[i][0], qt[i][1]); o.y = cvt_pk_bf16(qt[i][2], qt[i][3]); *(LAS u32x2*)(L + O_QT + ro) = o;
                  o.x = cvt_pk_bf16(kt[i][0], kt[i][1]); o.y = cvt_pk_bf16(kt[i][2], kt[i][3]); *(LAS u32x2*)(L + O_KT + ro) = o;
                  o.x = cvt_pk_bf16(qh[i][0], qh[i][1]); o.y = cvt_pk_bf16(qh[i][2], qh[i][3]); *(LAS u32x2*)(L + O_QH + ro) = o; }
#pragma unroll
              for (int j = 0; j < 4; ++j) { u32x2 o; o.x = cvt_pk_bf16(kh[0][j], kh[1][j]); o.y = cvt_pk_bf16(kh[2][j], kh[3][j]); *(LAS u32x2*)(L + O_KHT + (kc0 + j) * RS_S + seg * 8) = o; }
              LAS unsigned short* vt = (LAS unsigned short*)(L + O_VT) + vc * (RS_S / 2) + vs;
              vt[0 * (RS_S / 2)] = (unsigned short)(vw.x & 0xffffu); vt[1 * (RS_S / 2)] = (unsigned short)(vw.x >> 16);
              vt[2 * (RS_S / 2)] = (unsigned short)(vw.y & 0xffffu); vt[3 * (RS_S / 2)] = (unsigned short)(vw.y >> 16);
              vt[4 * (RS_S / 2)] = (unsigned short)(vw.z & 0xffffu); vt[5 * (RS_S / 2)] = (unsigned short)(vw.z >> 16);
              vt[6 * (RS_S / 2)] = (unsigned short)(vw.w & 0xffffu); vt[7 * (RS_S / 2)] = (unsigned short)(vw.w >> 16); }
            if (c + 1 < SEQ / HGC) SCAN_LOAD(c + 1);
            __syncthreads();
#pragma unroll
            for (int q = 0; q < 2; ++q) { const int id = 2 * w + q, si = id >> 2, ti = id & 3;
                f32x4 a = (f32x4){0.f, 0.f, 0.f, 0.f};
                if (si <= ti) {
#pragma unroll
                    for (int ks = 0; ks < 4; ++ks) a = __builtin_amdgcn_mfma_f32_16x16x32_bf16(ldfrag(L + O_KT, si * 16 + l15, RS_K, ks * 64 + l4 * 16), ldfrag(L + O_QT, ti * 16 + l15, RS_K, ks * 64 + l4 * 16), a, 0, 0, 0);
                }
                const int t = ti * 16 + l15, s0 = si * 16 + l4 * 4;
#pragma unroll
                for (int r = 0; r < 4; ++r) a[r] = (s0 + r <= t) ? a[r] : 0.f;
                u32x2 o; o.x = cvt_pk_bf16(a[0], a[1]); o.y = cvt_pk_bf16(a[2], a[3]);
                *(LAS u32x2*)(L + O_SS + t * RS_S + s0 * 2) = o; }
            __syncthreads();
#pragma unroll
            for (int q = 0; q < 2; ++q) { const int id = 2 * w + q, vi = id >> 2, ti = id & 3;
                f32x4 a = (f32x4){0.f, 0.f, 0.f, 0.f};
#pragma unroll
                for (int ks = 0; ks < 2; ++ks) a = __builtin_amdgcn_mfma_f32_16x16x32_bf16(ldfrag(L + O_VT, vi * 16 + l15, RS_S, ks * 64 + l4 * 16), ldfrag(L + O_SS, ti * 16 + l15, RS_S, ks * 64 + l4 * 16), a, 0, 0, 0);
#pragma unroll
                for (int ks = 0; ks < 4; ++ks) a = __builtin_amdgcn_mfma_f32_16x16x32_bf16(ldfrag(STc, vi * 16 + l15, RS_K, ks * 64 + l4 * 16), ldfrag(L + O_QH, ti * 16 + l15, RS_K, ks * 64 + l4 * 16), a, 0, 0, 0);
                const int t = ti * 16 + l15, v0 = vi * 16 + l4 * 4;
                u32x2 o; o.x = cvt_pk_bf16(a[0], a[1]); o.y = cvt_pk_bf16(a[2], a[3]);
                *(u32x2*)(OO_g + (r0 + t) * D + hv + v0) = o; }
            { const f32x4 dec = *(const LAS f32x4*)(DEC + w * 16 + l4 * 4);
              const bf16x8 ka0 = ldfrag(L + O_KHT, w * 16 + l15, RS_S, l4 * 16), ka1 = ldfrag(L + O_KHT, w * 16 + l15, RS_S, 64 + l4 * 16);
#pragma unroll
              for (int vi = 0; vi < 4; ++vi) { f32x4 a = sacc[vi] * dec;
                  a = __builtin_amdgcn_mfma_f32_16x16x32_bf16(ka0, ldfrag(L + O_VT, vi * 16 + l15, RS_S, l4 * 16), a, 0, 0, 0);
                  a = __builtin_amdgcn_mfma_f32_16x16x32_bf16(ka1, ldfrag(L + O_VT, vi * 16 + l15, RS_S, 64 + l4 * 16), a, 0, 0, 0);
                  sacc[vi] = a;
                  u32x2 o; o.x = cvt_pk_bf16(a[0], a[1]); o.y = cvt_pk_bf16(a[2], a[3]);
                  *(LAS u32x2*)(STn + (vi * 16 + l15) * RS_K + (w * 16 + l4 * 4) * 2) = o; } }
            __syncthreads();
        }
#undef SCAN_LOAD
    }
}
namespace mla {
constexpr int QBLK = 32, KVBLK = 64, QB = 256;
constexpr int SHM_V = KVBLK * VD * 2  , SHM_K = KVBLK * QK * 2  ;
constexpr int O_V = 0, O_K = 2 * SHM_V, O_WS = 2 * SHM_V + 2 * SHM_K;
constexpr float SCALE = 0.07216878364870322f;
#define KSWZ192(row, colB) ((row) * 384 + ((colB) ^ (((row) & 7) << 4)))
#define SBAR() __builtin_amdgcn_sched_barrier(0)
__device__ __forceinline__ int v_st(int k, int c) { const int kk = (k & ~0xC) | ((k & 4) << 1) | ((k & 8) >> 1); return ((kk >> 3) * 4 + (c >> 5)) * 512 + ((kk & 7) * 32 + (c & 31)) * 2; }
__device__ __forceinline__ int v_rd_base(int lane) { return ((lane & 3) << 3) | (((lane >> 2) & 3) << 6) | (((lane >> 4) & 1) << 5) | (((lane >> 5) & 1) << 8); }
constexpr int v_rd_off(int d0, int ks, int half) { return d0 * 512 + ks * 4096 + half * 2048; }
__device__ __forceinline__ int crow(int r, int hi) { return (r & 3) + 8 * (r >> 2) + 4 * hi; }
__device__ __forceinline__ void mask_tile(f32x16& p0, f32x16& p1, int dq) {
    const float NEG = -__builtin_inff();
#pragma unroll
    for (int r = 0; r < 16; ++r) { const int c = (r & 3) + 8 * (r >> 2); if (dq - c < 0) p0[r] = NEG; if (dq - c - 32 < 0) p1[r] = NEG; }
}
__device__ __forceinline__ void partialSM(f32x16& p0, f32x16& p1, float& m_reg, float& mn, float& alpha) {
    float pmax = p0[0];
#pragma unroll
    for (int r = 1; r < 16; ++r) pmax = fmaxf(pmax, p0[r]);
#pragma unroll
    for (int r = 0; r < 16; ++r) pmax = fmaxf(pmax, p1[r]);
    { auto rr = __builtin_amdgcn_permlane32_swap(__float_as_uint(pmax), __float_as_uint(pmax), false, false);
      pmax = fmaxf(__uint_as_float(rr[0]), __uint_as_float(rr[1])); }
    constexpr float C2 = 1.4426950408889634f * SCALE;
    constexpr float THR = 8.f;
    if (__builtin_expect(__all((pmax - m_reg) * SCALE <= THR), 1)) { mn = m_reg; alpha = 1.f; }
    else { mn = fmaxf(m_reg, pmax); alpha = __builtin_amdgcn_exp2f((m_reg - mn) * C2); m_reg = mn; }
    const float mnL = -mn * C2;
#pragma unroll
    for (int r = 0; r < 16; ++r) p0[r] = fmaf(p0[r], C2, mnL);
#pragma unroll
    for (int r = 0; r < 16; ++r) p1[r] = fmaf(p1[r], C2, mnL);
#pragma unroll
    for (int r = 0; r < 16; ++r) p0[r] = __builtin_amdgcn_exp2f(p0[r]);
}
__device__ __forceinline__ void finishSM(f32x16& p0, f32x16& p1, float alpha, float& l_reg, bf16x8& pa0, bf16x8& pa1, bf16x8& pa2, bf16x8& pa3) {
#pragma unroll
    for (int r = 0; r < 16; ++r) p1[r] = __builtin_amdgcn_exp2f(p1[r]);
    float ps = 0;
#pragma unroll
    for (int r = 0; r < 16; ++r) ps += p0[r];
#pragma unroll
    for (int r = 0; r < 16; ++r) ps += p1[r];
    { auto rr = __builtin_amdgcn_permlane32_swap(__float_as_uint(ps), __float_as_uint(ps), false, false);
      ps = __uint_as_float(rr[0]) + __uint_as_float(rr[1]); }
    l_reg = l_reg * alpha + ps;
#define PK4(P, B_, OUT) do { unsigned a0 = cvt_pk_bf16(P[B_+0], P[B_+1]), a1 = cvt_pk_bf16(P[B_+2], P[B_+3]);                          \
        unsigned b0 = cvt_pk_bf16(P[B_+4], P[B_+5]), b1 = cvt_pk_bf16(P[B_+6], P[B_+7]);                                             \
        auto r0 = __builtin_amdgcn_permlane32_swap(a0, b0, false, false); auto r1 = __builtin_amdgcn_permlane32_swap(a1, b1, false, false); \
        u32x4 w = {r0[0], r1[0], r0[1], r1[1]}; OUT = *reinterpret_cast<bf16x8*>(&w); } while (0)
    PK4(p0, 0, pa0); PK4(p0, 8, pa1); PK4(p1, 0, pa2); PK4(p1, 8, pa3);
#undef PK4
}
template <int KB>
__device__ __forceinline__ void qkt(f32x16& p0, f32x16& p1, const LAS unsigned char* K_lds, int r32, int hi, const bf16x8* qr) {
    p0 = f32x16{}; p1 = f32x16{};
    const LAS unsigned char* kb[4];
#pragma unroll
    for (int dd = 0; dd < 4; ++dd) kb[dd] = K_lds + KB * SHM_K + KSWZ192(r32, (dd * 16 + hi * 8) * 2);
#pragma unroll
    for (int g = 0; g < 3; ++g) {
        bf16x8 b0[4], b1[4];
#pragma unroll
        for (int dd = 0; dd < 4; ++dd) { const LAS unsigned char* a = kb[dd] + g * 128;
            b0[dd] = *reinterpret_cast<const LAS bf16x8*>(a); b1[dd] = *reinterpret_cast<const LAS bf16x8*>(a + 32 * 384); }
#pragma unroll
        for (int dd = 0; dd < 4; ++dd) {
            p0 = __builtin_amdgcn_mfma_f32_32x32x16_bf16(b0[dd], qr[4 * g + dd], p0, 0, 0, 0);
            p1 = __builtin_amdgcn_mfma_f32_32x32x16_bf16(b1[dd], qr[4 * g + dd], p1, 0, 0, 0); }
        SBAR();
    }
}
template <int VB>
__device__ __forceinline__ void pv_tile(f32x16* o, int vb0, bf16x8 pa0, bf16x8 pa1, bf16x8 pa2, bf16x8 pa3) {
#define TRRD(dst, off) asm volatile("ds_read_b64_tr_b16 %0, %1 offset:%2" : "=&v"(dst) : "v"(vb0), "i"(off) : "memory")
#define PV_D0(d0) do { s16x4 l0, l1, l2, l3, h0, h1, h2, h3; constexpr int b_ = VB * SHM_V + v_rd_off(d0, 0, 0); \
        TRRD(l0, b_); TRRD(h0, b_ + 2048); TRRD(l1, b_ + 4096); TRRD(h1, b_ + 6144); TRRD(l2, b_ + 8192); TRRD(h2, b_ + 10240); TRRD(l3, b_ + 12288); TRRD(h3, b_ + 14336); \
        asm volatile("s_waitcnt lgkmcnt(0)" ::: "memory"); SBAR(); \
        o[d0] = __builtin_amdgcn_mfma_f32_32x32x16_bf16(pa0, (bf16x8){l0[0], l0[1], l0[2], l0[3], h0[0], h0[1], h0[2], h0[3]}, o[d0], 0, 0, 0);   \
        o[d0] = __builtin_amdgcn_mfma_f32_32x32x16_bf16(pa1, (bf16x8){l1[0], l1[1], l1[2], l1[3], h1[0], h1[1], h1[2], h1[3]}, o[d0], 0, 0, 0);   \
        o[d0] = __builtin_amdgcn_mfma_f32_32x32x16_bf16(pa2, (bf16x8){l2[0], l2[1], l2[2], l2[3], h2[0], h2[1], h2[2], h2[3]}, o[d0], 0, 0, 0);   \
        o[d0] = __builtin_amdgcn_mfma_f32_32x32x16_bf16(pa3, (bf16x8){l3[0], l3[1], l3[2], l3[3], h3[0], h3[1], h3[2], h3[3]}, o[d0], 0, 0, 0); } while (0)
    PV_D0(0); PV_D0(1); PV_D0(2); PV_D0(3);
#undef PV_D0
#undef TRRD
}
}

__device__ __forceinline__ void attn_block(const Ctx& F, int b, int h, int qb) {
    using namespace mla;
    PHASE_IDS;
    LAS unsigned char* L = F.lds;
    const bf16_t* Qg = (const bf16_t*)(F.ws + WS_QB); const bf16_t* Kg = (const bf16_t*)(F.ws + WS_KB); const bf16_t* Vg = (const bf16_t*)(F.ws + WS_VB); bf16_t* Og = (bf16_t*)(F.ws + WS_AO);
    const int wid = wave, r32 = lane & 31, hi = lane >> 5;
    const size_t rowb = (size_t)b * SEQ; const int P0 = qb * QB;
    const int NT = (P0 + QB) / KVBLK;
    LAS unsigned char* V_lds = L + O_V; LAS unsigned char* K_lds = L + O_K;
    LAS float* wsf = (LAS float*)(L + O_WS) + wid * 64; LAS float* li_l = wsf; LAS float* al_l = wsf + 32;
    const bf16_t* Kh = Kg + rowb * (MH * QK) + h * QK; const bf16_t* Vh = Vg + rowb * D + h * VD;
    unsigned koff[3], voff[2];
#pragma unroll
    for (int i = 0; i < 3; ++i) { const int p = (wid + 8 * i) * 64 + lane, row = p / 24, cs = p - row * 24, ch = cs ^ (row & 7); koff[i] = (unsigned)(row * (MH * QK) + ch * 8) * 2u; }
#pragma unroll
    for (int i = 0; i < 2; ++i) { const int p = (wid + 8 * i) * 64 + lane, sub = p >> 5, r = p & 31, kk = (sub >> 2) * 8 + (r >> 2), k = (kk & ~0xC) | ((kk & 4) << 1) | ((kk & 8) >> 1), c = (sub & 3) * 32 + (r & 3) * 8;
        voff[i] = (unsigned)(k * D + c) * 2u; }
    const int vb0 = (int)(uintptr_t)V_lds + v_rd_base(lane);
    bf16x8 qr[12];
    { const bf16_t* qp = Qg + (rowb + P0 + wid * QBLK + r32) * (MH * QK) + h * QK + hi * 8;
#pragma unroll
      for (int d0 = 0; d0 < 12; ++d0) qr[d0] = *(const bf16x8*)(qp + d0 * 16); }
#define DMA(t, bf) do { const char* kp_ = (const char*)(Kh + (size_t)(t) * KVBLK * (MH * QK)); const char* vp_ = (const char*)(Vh + (size_t)(t) * KVBLK * D); \
        _Pragma("unroll") for (int i_ = 0; i_ < 3; ++i_) glds16s(kp_, koff[i_], klds0 + (bf) * SHM_K + (wid + 8 * i_) * 1024); \
        _Pragma("unroll") for (int i_ = 0; i_ < 2; ++i_) glds16s(vp_, voff[i_], vlds0 + (bf) * SHM_V + (wid + 8 * i_) * 1024); } while (0)
    const unsigned klds0 = (unsigned)(uintptr_t)K_lds, vlds0 = (unsigned)(uintptr_t)V_lds;
    DMA(0, 0); VM_WAIT();
    __syncthreads();
    float m_reg = -1e30f, l_reg = 0.f, mn, alpha; f32x16 o[4] = {}; f32x16 p0, p1; bf16x8 pa0, pa1, pa2, pa3;
    const int qlo = P0 + wid * QBLK, qm = qlo + r32 - 4 * hi;
#define RESC(a) do { if (__any((a) < 1.f)) { if (hi == 0) al_l[r32] = (a); LDS_WAIT(); \
        _Pragma("unroll") for (int d_ = 0; d_ < 4; ++d_) _Pragma("unroll") for (int r = 0; r < 16; ++r) o[d_][r] *= al_l[crow(r, hi)]; } } while (0)
#define STEP(t, CB) do { \
        if ((t) + 1 < NT) DMA((t) + 1, 1 - (CB)); \
        SBAR(); qkt<CB>(p0, p1, K_lds, r32, hi, qr); \
        { const int kb_ = (t) * KVBLK; if (kb_ + KVBLK - 1 > qlo) mask_tile(p0, p1, qm - kb_); } \
        partialSM(p0, p1, m_reg, mn, alpha); \
        finishSM(p0, p1, alpha, l_reg, pa0, pa1, pa2, pa3); SBAR(); \
        RESC(alpha); \
        pv_tile<CB>(o, vb0, pa0, pa1, pa2, pa3); \
        VM_WAIT(); \
        __syncthreads(); } while (0)
    for (int t = 0; t < NT; t += 2) { STEP(t, 0); STEP(t + 1, 1); }
    if (hi == 0) li_l[r32] = l_reg; LDS_WAIT();
    float rli[16];
#pragma unroll
    for (int r = 0; r < 16; ++r) rli[r] = __builtin_amdgcn_rcpf(li_l[crow(r, hi)]);
    bf16_t* Ow = Og + (rowb + P0 + wid * QBLK) * D + h * VD;
#pragma unroll
    for (int r = 0; r < 16; ++r) { const int orow = crow(r, hi);
#pragma unroll
        for (int d0 = 0; d0 < 4; ++d0) { const float v = o[d0][r] * rli[r]; const float vn = __shfl_xor(v, 1);
            if ((r32 & 1) == 0) *(unsigned*)(Ow + (size_t)orow * D + d0 * 32 + r32) = cvt_pk_bf16(v, vn); } }
    __syncthreads();
#undef DMA
#undef RESC
#undef STEP
}
__device__ __forceinline__ void phase_attn(const Ctx& F) {
    constexpr int NQB = SEQ / 256, NITEM = NB * MH * (NQB / 2);
    for (int L = F.vcu; L < NITEM; L += F.G) {
        const int bh = L / (NQB / 2), x = L - bh * (NQB / 2);
        attn_block(F, bh / MH, bh % MH, NQB - 1 - x);
        attn_block(F, bh / MH, bh % MH, x);
    }
}
constexpr int NP = 13, NSTEPS = 2 + DEPTH * NP;
__host__ __device__ constexpr bool step_applies(int st) {
    if (st < 2) return true;
    const int l = (st - 2) / NP, p = (st - 2) % NP;
    if (p == 3) return l >= NA;
    if (p >= 10) return l == NA - 1;
    return true;
}
struct Args { const float* in[28]; float* out; unsigned char* ws; int lo, hi, final_only, pad; };

__global__ void __launch_bounds__(NTHREADS, 2) fwd_kernel(Args args) {
    extern __shared__ __attribute__((aligned(16))) unsigned char lds_raw[];
    Ctx F;
    F.lds = (LAS unsigned char*)lds_raw;
    F.G = gridDim.x; { const int bx = blockIdx.x; F.vcu = (F.G % 8 == 0) ? (bx % 8) * (F.G / 8) + bx / 8 : bx; }
#pragma unroll
    for (int i = 0; i < 28; ++i) F.in[i] = args.in[i];
    F.out = args.out; F.ws = args.ws;
    volatile LAS unsigned* MISC = (volatile LAS unsigned*)(F.lds + LDS_MISC);
    if (threadIdx.x < 64) MISC[threadIdx.x] = 0u;
    __syncthreads();
    XcdBarrier bar; bar.bar = F.ctl() + CW_BAR; bar.x = 0; bar.st = nullptr;
#if MK_ONE_LAUNCH
    bar = xcd_barrier_post(F.ctl() + CW_BAR, MISC);
#endif
    const int lo = args.lo, hi = args.hi;
    bool did = false;
#if MK_ONE_LAUNCH
#define PHASE_BEGIN(st) if ((st) >= lo && (st) < hi) { if (did) xcd_barrier(bar); did = true;
#else
#define PHASE_BEGIN(st) if ((st) >= lo && (st) < hi) { did = true;
#endif
#define PHASE_END }

    if (args.final_only) { phase_final_only(F, args.final_only == 1); return; }

    PHASE_BEGIN(0) phase_mod(F); __syncthreads(); phase_convert(F); PHASE_END
    PHASE_BEGIN(1) phase_combine(F, -1); PHASE_END

    for (int l = 0; l < DEPTH; ++l) {
        const int sb = 2 + l * NP;
        if (l < NA) {
            PHASE_BEGIN(sb + 0) {
                pg8::PlainSched S; S.init(T, 4096, F.G, (int)blockIdx.x); S.Bt = (const char*)(F.ws + WS_WIN) + (size_t)l * 4096 * 1024 * 2; S.K = 2048;
                pg8::EpiHgrnIn E{(bf16_t*)(F.ws + WS_QH), (float*)(F.ws + WS_LF), (const float*)(F.ws + WS_LB) + (size_t)l * D};
                pg8::gemm_phase<false>(F.lds, (const char*)(F.ws + WS_H), 2048, S, E); }
            PHASE_END
            PHASE_BEGIN(sb + 1) phase_hgrn_scan(F); PHASE_END
            PHASE_BEGIN(sb + 2) phase_hgrn_gate(F, l); PHASE_END
        } else {
            const int j = l - NA;
            PHASE_BEGIN(sb + 0) {
                pg8::PlainSched S; S.init(T, 512, F.G, (int)blockIdx.x); S.Bt = (const char*)(F.ws + WS_WDQ) + (size_t)j * 512 * 1024 * 2; S.K = 2048;
                pg8::EpiPlainBf16 E{(bf16_t*)(F.ws + WS_CQ), 512};
                pg8::gemm_phase<false>(F.lds, (const char*)(F.ws + WS_H), 2048, S, E); }
            PHASE_END
            PHASE_BEGIN(sb + 1) phase_cq_rows(F, j); PHASE_END
            PHASE_BEGIN(sb + 2) {
                pg8::PlainSched S; S.init(T, 1536, F.G, (int)blockIdx.x); S.Bt = (const char*)(F.ws + WS_WUQ) + (size_t)j * 1536 * 384 * 2; S.K = 768;
                pg8::EpiQUp E{(bf16_t*)(F.ws + WS_QB), (const float*)(F.ws + WS_ROPE)};
                pg8::gemm_phase<false>(F.lds, (const char*)(F.ws + WS_CQN), 768, S, E); }
            PHASE_END
            PHASE_BEGIN(sb + 3) phase_attn(F); PHASE_END
        }
        PHASE_BEGIN(sb + 4) {
            pg8::PlainSched S; S.init(T, 1024, F.G, (int)blockIdx.x); S.K = 2048;
            S.Bt = (l < NA) ? (const char*)(F.ws + WS_WOUT) + (size_t)l * 1024 * 1024 * 2 : (const char*)(F.ws + WS_WO) + (size_t)(l - NA) * 1024 * 1024 * 2;
            const char* A = (l < NA) ? (const char*)(F.ws + WS_OG) : (const char*)(F.ws + WS_AO);
            pg8::EpiResid E{l == 0 ? F.in[0] : F.out, F.out, modp(F, l, 0, 2), 6 * D};
            pg8::gemm_phase<false>(F.lds, A, 2048, S, E); }
        PHASE_END
        PHASE_BEGIN(sb + 5) phase_router(F, l, args.pad != 0); PHASE_END
        PHASE_BEGIN(sb + 6) phase_scatter(F, l); PHASE_END
        PHASE_BEGIN(sb + 7) {
            moe_table(F, l);
            pg8::MoeSched<true> S{(const LAS int*)(F.lds + LDS_TAB), 8, F.G, F.vcu, (const char*)(F.ws + WS_WGU) + (size_t)l * NE * 2048 * 1024, (size_t)2048 * 1024, 1024, (const int*)(F.ws + WS_RINFO)};
            pg8::EpiMoeGU E{(unsigned char*)(F.ws + WS_ACT), F.in[24] + (size_t)l * NE * 2048};
            pg8::gemm_phase<true>(F.lds, (const char*)(F.ws + WS_H), 1024, S, E); }
        PHASE_END
        PHASE_BEGIN(sb + 8) {
            moe_table(F, l);
            pg8::MoeSched<false> S{(const LAS int*)(F.lds + LDS_TAB), 4, F.G, F.vcu, (const char*)(F.ws + WS_WDN) + (size_t)l * NE * 1024 * 1024, (size_t)1024 * 1024, 1024, nullptr};
            pg8::EpiMoeDN E{(bf16_t*)(F.ws + WS_YS), F.in[26] + (size_t)l * NE * 1024, (const int*)(F.ws + WS_RINFO), (const float*)(F.ws + WS_RW)};
            pg8::gemm_phase<true>(F.lds, (const char*)(F.ws + WS_ACT), 1024, S, E); }
        PHASE_END
        PHASE_BEGIN(sb + 9) phase_combine(F, l, args.pad != 0); PHASE_END
        if (l == NA - 1) {
            PHASE_BEGIN(sb + 10) {
                pg8::PlainSched S; S.init(T, 512, F.G, (int)blockIdx.x); S.Bt = (const char*)(F.ws + WS_WDKV); S.K = 2048;
                pg8::EpiPlainBf16 E{(bf16_t*)(F.ws + WS_CKR), 512};
                pg8::gemm_phase<false>(F.lds, (const char*)(F.ws + WS_HK), 2048, S, E); }
            PHASE_END
            PHASE_BEGIN(sb + 11) phase_kv_rows(F); PHASE_END
            PHASE_BEGIN(sb + 12) {
                pg8::PlainSched S; S.init(T, 2048, F.G, (int)blockIdx.x); S.Bt = (const char*)(F.ws + WS_WUKV); S.K = 512;
                pg8::EpiKvUp E{(bf16_t*)(F.ws + WS_KB), (bf16_t*)(F.ws + WS_VB)};
                pg8::gemm_phase<false>(F.lds, (const char*)(F.ws + WS_CKV), 512, S, E); }
            PHASE_END
        }
    }
#undef PHASE_BEGIN
#undef PHASE_END
}

extern "C" void kernel_launch(void* const* d_in, const int* in_sizes, int n_in, void* d_out, int out_size, void* d_ws, size_t ws_size, hipStream_t stream) {
    static int grid = 0;
    if (grid == 0) {
        if (n_in != 28 || in_sizes[0] != T * D || out_size != T * D || ws_size < WS_END) {
            fprintf(stderr, "kernel_launch: shape mismatch: n_in %d in0 %d out %d ws %zu (need %zu)\n", n_in, n_in > 0 ? in_sizes[0] : -1, out_size, ws_size, (size_t)WS_END); grid = -1; return; }
        int dev = 0, cus = 0, per_cu = 0;
        if (hipGetDevice(&dev) != hipSuccess || hipDeviceGetAttribute(&cus, hipDeviceAttributeMultiprocessorCount, dev) != hipSuccess) { fprintf(stderr, "kernel_launch: device query failed\n"); grid = -1; return; }
        if (hipFuncSetAttribute((const void*)fwd_kernel, hipFuncAttributeMaxDynamicSharedMemorySize, LDS_BYTES) != hipSuccess) { fprintf(stderr, "kernel_launch: hipFuncSetAttribute failed\n"); grid = -1; return; }
        if (hipOccupancyMaxActiveBlocksPerMultiprocessor(&per_cu, (const void*)fwd_kernel, NTHREADS, LDS_BYTES) != hipSuccess || per_cu < 1)
            fprintf(stderr, "kernel_launch: note: occupancy query reports %d workgroups per CU\n", per_cu);
        (void)hipGetLastError();
        grid = cus;
    }
    if (grid < 0) return;
    if (hipMemsetAsync((char*)d_ws + WS_CTL, 0, CTL_ZERO_BYTES, stream) != hipSuccess) { fprintf(stderr, "kernel_launch: memset failed\n"); return; }
    Args a{};
    for (int i = 0; i < 28; ++i) a.in[i] = (const float*)d_in[i];
    a.out = (float*)d_out; a.ws = (unsigned char*)d_ws; a.final_only = 0; a.pad = 0;
    constexpr int LAST = (MK_LAST_STEP < NSTEPS) ? MK_LAST_STEP : NSTEPS;
#if MK_ONE_LAUNCH
    a.lo = 0; a.hi = LAST;
    hipLaunchKernelGGL(fwd_kernel, dim3(grid), dim3(NTHREADS), LDS_BYTES, stream, a);
#else
    for (int st = 0; st < LAST; ++st) { if (!step_applies(st)) continue;
#ifdef MK_SKIP_LO
        if (st >= MK_SKIP_LO && st < MK_SKIP_HI) continue;
#endif
        a.lo = st; a.hi = st + 1;
        hipLaunchKernelGGL(fwd_kernel, dim3(grid), dim3(NTHREADS), LDS_BYTES, stream, a);
#ifdef MK_REPEAT_LO
        if (st >= MK_REPEAT_LO && st < MK_REPEAT_HI) { a.pad = 1; hipLaunchKernelGGL(fwd_kernel, dim3(grid), dim3(NTHREADS), LDS_BYTES, stream, a); a.pad = 0; }
#endif
    }
#endif
    if (LAST < NSTEPS) {
        a.lo = 0; a.hi = 0; a.final_only = (LAST <= 2 + 4) ? 1 : 2;
        hipLaunchKernelGGL(fwd_kernel, dim3(grid), dim3(NTHREADS), LDS_BYTES, stream, a);
    }
    const hipError_t le = hipPeekAtLastError();
    if (le != hipSuccess) fprintf(stderr, "kernel_launch: launch failed: %s\n", hipGetErrorName(le));
}
```

```cpp
#define MK_ONE_LAUNCH 1
#define MK_LAST_STEP 9999
#include <hip/hip_runtime.h>
#include <cstdio>
#include <cstdint>

#ifndef MK_ONE_LAUNCH
#define MK_ONE_LAUNCH 1
#endif
#ifndef MK_LAST_STEP
#define MK_LAST_STEP 9999
#endif

#define GAS __attribute__((address_space(1)))
#define LAS __attribute__((address_space(3)))
typedef unsigned short bf16_t;
typedef short bf16x8 __attribute__((ext_vector_type(8)));
typedef short s16x4 __attribute__((ext_vector_type(4)));
typedef float f32x4 __attribute__((ext_vector_type(4)));
typedef float f32x2 __attribute__((ext_vector_type(2)));
typedef float f32x16 __attribute__((ext_vector_type(16)));
typedef unsigned u32x4 __attribute__((ext_vector_type(4)));
typedef unsigned u32x2 __attribute__((ext_vector_type(2)));

constexpr int NB = 16, SEQ = 4096, D = 1024, T = NB * SEQ;
constexpr int DEPTH = 4, NA = 2;
constexpr int HGH = 8, HGD = 128, HGC = 64;
constexpr int MH = 8, NOPE = 128, ROPE = 64, VD = 128, QK = NOPE + ROPE;
constexpr int QRANK = 384, KVRANK = 256;
constexpr int NE = 32, TOPK = 4, FF = 1024, MOEB = 256;
constexpr int NASSIGN = T * TOPK;
constexpr int NROWS_MAX = NASSIGN + NE * MOEB;
constexpr int NBLK_MAX = NROWS_MAX / MOEB;
constexpr float NORM_EPS = 1e-6f;
constexpr float SWIGLU_LIMIT = 7.0f, SWIGLU_ALPHA = 1.702f;
constexpr int NWAVES = 8, NTHREADS = 512;

constexpr size_t MiB = 1u << 20;
constexpr size_t al256(size_t x) { return (x + 255) & ~(size_t)255; }
constexpr size_t WS_CTL = 0, CTL_ZERO_BYTES = 1 * MiB;
constexpr int CW_BAR = 4096;
constexpr int CW_CNT = 16384;
constexpr size_t WS_MOD   = 1 * MiB;
constexpr size_t WS_KVMOD = WS_MOD + al256((size_t)DEPTH * NB * 6 * D * 4);
constexpr size_t WS_LB    = WS_KVMOD + al256((size_t)NB * 2 * D * 4);
constexpr size_t WS_ROPE  = WS_LB + al256((size_t)NA * D * 4);
constexpr size_t WS_TKE   = WS_ROPE + al256((size_t)T * 64 * 4);
constexpr size_t WS_TKW   = WS_TKE + al256((size_t)T * 4 * 4);
constexpr size_t WS_TKR   = WS_TKW + al256((size_t)T * 4 * 4);
constexpr size_t WS_RINFO = WS_TKR + al256((size_t)T * 4 * 4);
constexpr size_t WS_RW    = WS_RINFO + al256((size_t)NROWS_MAX * 4);
constexpr size_t WS_WIN   = al256(WS_RW + (size_t)NROWS_MAX * 4 + MiB);
constexpr size_t WS_WOUT  = WS_WIN + (size_t)NA * 4096 * 1024 * 2;
constexpr size_t WS_WDKV  = WS_WOUT + (size_t)NA * 1024 * 1024 * 2;
constexpr size_t WS_WUKV  = WS_WDKV + (size_t)512 * 1024 * 2;
constexpr size_t WS_WDQ   = WS_WUKV + (size_t)2048 * 256 * 2;
constexpr size_t WS_WUQ   = WS_WDQ + (size_t)2 * 512 * 1024 * 2;
constexpr size_t WS_WO    = WS_WUQ + (size_t)2 * 1536 * 384 * 2;
constexpr size_t WS_WGU   = al256(WS_WO + (size_t)2 * 1024 * 1024 * 2);
constexpr size_t WS_WDN   = WS_WGU + (size_t)DEPTH * NE * 2048 * 1024 * 2;
constexpr size_t WS_H     = WS_WDN + (size_t)DEPTH * NE * 1024 * 1024 * 2;
constexpr size_t WS_HK    = WS_H + (size_t)T * D * 2;
constexpr size_t WS_XB    = WS_HK + (size_t)T * D * 2;
constexpr size_t WS_ACT   = WS_XB + (size_t)T * D * 2;
constexpr size_t WS_YS    = WS_ACT + (size_t)NROWS_MAX * FF * 2;
constexpr size_t WS_MIX   = WS_YS + (size_t)NASSIGN * D * 2;
constexpr size_t WS_QH = WS_MIX;
constexpr size_t WS_KK = WS_QH + (size_t)T * D * 2;
constexpr size_t WS_VV = WS_KK + (size_t)T * D * 2;
constexpr size_t WS_GS = WS_VV + (size_t)T * D * 2;
constexpr size_t WS_LF = WS_GS + (size_t)T * D * 2;
constexpr size_t WS_OO = WS_LF + (size_t)T * D * 4;
constexpr size_t WS_OG = WS_OO + (size_t)T * D * 2;
constexpr size_t WS_MIX_END_A = WS_OG + (size_t)T * D * 2;
constexpr size_t WS_KB  = WS_MIX;
constexpr size_t WS_VB  = WS_KB + (size_t)T * MH * QK * 2;
constexpr size_t WS_QB  = WS_VB + (size_t)T * D * 2;
constexpr size_t WS_CKR = WS_QB + (size_t)T * MH * QK * 2;
constexpr size_t WS_CKV = WS_CKR + (size_t)T * 512 * 2;
constexpr size_t WS_CQ  = WS_CKV + (size_t)T * 256 * 2;
constexpr size_t WS_CQN = WS_CQ + (size_t)T * 512 * 2;
constexpr size_t WS_AO  = WS_CQN + (size_t)T * 384 * 2;
constexpr size_t WS_MIX_END_B = WS_AO + (size_t)T * D * 2;
constexpr size_t WS_END = (WS_MIX_END_A > WS_MIX_END_B ? WS_MIX_END_A : WS_MIX_END_B);
static_assert(WS_END < (size_t)4200 * MiB / 1 && WS_END < 4294967296ull, "workspace map must fit 4 x largest tensor");

constexpr int RING_BYTES = 131072;
constexpr int LDS_TAB = RING_BYTES;
constexpr int LDS_MISC = RING_BYTES + 512;
constexpr int LDS_BYTES = 147456;

#define RLX_AGENT __ATOMIC_RELAXED, __HIP_MEMORY_SCOPE_AGENT
#define LDS_WAIT() asm volatile("s_waitcnt lgkmcnt(0)" ::: "memory")
#define VM_WAIT() asm volatile("s_waitcnt vmcnt(0)" ::: "memory")
typedef __bf16 bf16x2_t __attribute__((ext_vector_type(2)));
__device__ __forceinline__ unsigned cvt_pk_bf16(float lo, float hi) { f32x2 v = {lo, hi}; bf16x2_t b = __builtin_convertvector(v, bf16x2_t); return __builtin_bit_cast(unsigned, b); }
__device__ __forceinline__ float bf2f(unsigned short b) { return __uint_as_float(((unsigned)b) << 16); }
__device__ __forceinline__ float bflo(unsigned w) { return __uint_as_float(w << 16); }
__device__ __forceinline__ float bfhi(unsigned w) { return __uint_as_float(w & 0xffff0000u); }
__device__ __forceinline__ unsigned short f2bf(float f) { return (unsigned short)(cvt_pk_bf16(f, 0.f) & 0xffffu); }
__device__ __forceinline__ float wave_sum(float v) {
#pragma unroll
    for (int o = 1; o < 64; o <<= 1) v += __shfl_xor(v, o);
    return v;
}
__device__ __forceinline__ void glds16s(const void* sbase, unsigned voff, unsigned lds_dst) { unsigned keep;
    asm volatile("s_mov_b32 %0, m0\n\ts_mov_b32 m0, %3\n\ts_nop 0\n\tglobal_load_lds_dwordx4 %1, %2\n\ts_mov_b32 m0, %0" : "=&s"(keep) : "v"(voff), "s"(sbase), "s"(lds_dst) : "memory"); }
__device__ __forceinline__ int opaque_v(int x) { asm volatile("" : "+v"(x)); return x; }
#define PHASE_IDS const int tid = opaque_v((int)threadIdx.x), lane = tid & 63, wave = __builtin_amdgcn_readfirstlane(tid >> 6); (void)lane; (void)wave
__device__ __forceinline__ float fsigmoid(float x) { return __builtin_amdgcn_rcpf(1.0f + __expf(-x)); }
__device__ __forceinline__ float fsilu(float x) { return x * __builtin_amdgcn_rcpf(1.0f + __expf(-x)); }

#define XB_TMO      128
#define XB_XCNT(j)  (256  + 64 * (j))
#define XB_XSUB(j)  (1280 + 64 * (j))
#define XB_XGEN(j)  (2304 + 64 * (j))
#define XB_TOP      3328
#define XB_TOPGEN   3392
#define XCD_BAR_WORDS 3456
#define XB_SPIN_CAP (1u << 23)
__device__ __forceinline__ unsigned xb_ld(unsigned* p)              { return __hip_atomic_load(p, __ATOMIC_RELAXED, __HIP_MEMORY_SCOPE_AGENT); }
__device__ __forceinline__ unsigned xb_add(unsigned* p, unsigned v) { return __hip_atomic_fetch_add(p, v, __ATOMIC_RELAXED, __HIP_MEMORY_SCOPE_AGENT); }
__device__ __forceinline__ unsigned xb_xcc_id() { return (unsigned)__builtin_amdgcn_s_getreg((3 << 11) | 20) & 0xFu; }
#define XB_SPIN(cond, bar) do { unsigned _sp = 0; while (cond) { __builtin_amdgcn_s_sleep(1); \
    if ((++_sp & 255u) == 0u) { if (xb_ld(&(bar)[XB_TMO])) break; if (_sp > XB_SPIN_CAP) { atomicAdd(&(bar)[XB_TMO], 1u); break; } } } } while (0)
struct XcdBarrier { unsigned* bar; unsigned x; volatile LAS unsigned* st; };
__device__ __forceinline__ XcdBarrier xcd_barrier_post(unsigned* bar, volatile LAS unsigned* st) {
    XcdBarrier b; b.bar = bar; b.x = xb_xcc_id(); b.st = st;
    if (threadIdx.x == 0) (void)xb_add(&bar[XB_XCNT(b.x)], 1u);
    return b;
}
__device__ __forceinline__ void xcd_barrier_complete(unsigned* bar, unsigned x, unsigned& nloc, unsigned& nx) {
    const unsigned G = gridDim.x * gridDim.y * gridDim.z;
    unsigned sum, cnt, mine, sp = 0u;
    for (;;) {
        sum = 0u; cnt = 0u; mine = 0u;
#pragma unroll
        for (unsigned j = 0; j < 16; ++j) { const unsigned c = xb_ld(&bar[XB_XCNT(j)]); sum += c; cnt += (c > 0u) ? 1u : 0u; mine = (j == x) ? c : mine; }
        if (sum == G) break;
        __builtin_amdgcn_s_sleep(1);
        if ((++sp & 255u) == 0u) { if (xb_ld(&bar[XB_TMO])) break; if (sp > XB_SPIN_CAP) { atomicAdd(&bar[XB_TMO], 1u); break; } }
    }
    nloc = mine > 0u ? mine : 1u; nx = cnt > 0u ? cnt : 1u;
}
__device__ __forceinline__ void xcd_barrier(const XcdBarrier& b) {
    asm volatile("s_waitcnt vmcnt(0)" ::: "memory");
    __syncthreads();
    if (threadIdx.x == 0) {
        unsigned* bar = b.bar;
        __builtin_amdgcn_s_waitcnt(0);
        unsigned nloc = b.st[0], nx = b.st[1];
        if (nloc == 0u) { xcd_barrier_complete(bar, b.x, nloc, nx); b.st[0] = nloc; b.st[1] = nx; }
        const unsigned old = xb_add(&bar[XB_XSUB(b.x)], 1u);
        const unsigned gen = old / nloc;
        if (old + 1u == (gen + 1u) * nloc) {
            __builtin_amdgcn_fence(__ATOMIC_RELEASE, "agent");
            asm volatile("s_waitcnt vmcnt(0)" ::: "memory");
            const unsigned og = xb_add(&bar[XB_TOP], 1u);
            const unsigned tg = og / nx;
            if (og + 1u == (tg + 1u) * nx) xb_add(&bar[XB_TOPGEN], 1u);
            else XB_SPIN(xb_ld(&bar[XB_TOPGEN]) == tg, bar);
            __builtin_amdgcn_fence(__ATOMIC_ACQUIRE, "agent");
            xb_add(&bar[XB_XGEN(b.x)], 1u);
            asm volatile("s_waitcnt vmcnt(0)" ::: "memory");
        } else {
            XB_SPIN(xb_ld(&bar[XB_XGEN(b.x)]) == gen, bar);
            __builtin_amdgcn_fence(__ATOMIC_ACQUIRE, "agent");
            asm volatile("s_waitcnt vmcnt(0)" ::: "memory");
        }
    }
    __syncthreads();
}
namespace pg8 {
constexpr int BM = 256, BK = 64, HALF = 128, HTB = HALF * BK * 2, STAGE_BYTES = 8 * HTB, NXCD = 8, WGM = 8;
__host__ __device__ __forceinline__ int lds_byte(int r, int c) { const int st = (r >> 4) * 2 + (c >> 5), rr = r & 15, cc = c & 31, ob = rr * 64 + cc * 2; return st * 1024 + (ob ^ (((ob >> 9) & 1) << 5)); }
__host__ __device__ __forceinline__ void stage_rc(int b, int& R, int& C) { const int st = b / 1024, sb = b % 1024, swz = sb ^ (((sb >> 9) & 1) << 5); R = (st >> 1) * 16 + swz / 64; C = (st & 1) * 32 + (swz % 64) / 2; }
__host__ __device__ __forceinline__ int perm32(int rho) { const int n = rho >> 4, i = rho & 15; return 8 * (i >> 2) + 4 * n + (i & 3); }

struct Unit { int pm, pn, e; };

struct StaticOrder {
    int nM, nN, nwg, G, c;
    __device__ void init(int M, int N, int G_, int c_) { nM = M / BM; nN = N / BM; nwg = nM * nN; G = G_; c = c_; }
    __device__ bool next(int i, Unit& u) const {
        const long L = (long)i * G + c; if (L >= nwg) return false;
        int wgid = (int)L; { const int q = nwg / NXCD, r = nwg % NXCD, xcd = wgid % NXCD, off = wgid / NXCD; wgid = (xcd < r ? xcd * (q + 1) : r * (q + 1) + (xcd - r) * q) + off; }
        const int nig = WGM * nN, gid = wgid / nig, fm = gid * WGM, gsz = (nM - fm) < WGM ? (nM - fm) : WGM;
        u.pm = fm + ((wgid % nig) % gsz); u.pn = (wgid % nig) / gsz; u.e = 0; return true;
    }
};

struct PlainSched : StaticOrder {
    static constexpr bool GATHER = false;
    const char* Bt; int K;
    __device__ __forceinline__ const char* bptr(const Unit& u) const { return Bt + (size_t)u.pn * BM * K; }
    __device__ __forceinline__ unsigned adelta(const Unit& a, const Unit& b) const { return (unsigned)((b.pm - a.pm) * BM * K); }
    __device__ __forceinline__ void aoffs(const Unit& u, unsigned (&o)[2][2]) const {
        int R0, C0, R1, C1; { const int t_ = opaque_v((int)threadIdx.x); stage_rc(t_ * 16, R0, C0); stage_rc(t_ * 16 + 8192, R1, C1); C0 *= 2; C1 *= 2; }
#pragma unroll
        for (int h = 0; h < 2; ++h) { o[h][0] = (unsigned)((u.pm * BM + h * HALF + R0) * K + C0); o[h][1] = (unsigned)((u.pm * BM + h * HALF + R1) * K + C1); }
    }
};

#define PG8_SA(b, h) (((b) * 2 + (h)) * HTB)
#define PG8_SB(b, h) ((4 + (b) * 2 + (h)) * HTB)
#define PG8_STAGE_B(bufoff, gbase) do { glds16s((gbase), voffB, lds0 + (bufoff) + ldsw); glds16s((gbase) + r64, voffB, lds0 + (bufoff) + ldsw + 8192u); } while (0)
#define PG8_STAGE_A(bufoff, gbase, h) do { if constexpr (Sched::GATHER) { glds16s((gbase), vc[h][0], lds0 + (bufoff) + ldsw); glds16s((gbase), vc[h][1], lds0 + (bufoff) + ldsw + 8192u); } \
        else { glds16s((gbase) + (h) * hstep, vc[0][0], lds0 + (bufoff) + ldsw); glds16s((gbase) + (h) * hstep + r64, vc[0][0], lds0 + (bufoff) + ldsw + 8192u); } } while (0)
#define PG8_LDA(dst, b, h) do { _Pragma("unroll") for (int m = 0; m < 4; ++m) _Pragma("unroll") for (int k = 0; k < 2; ++k) dst[m][k] = *(const LAS bf16x8*)(lds + PG8_SA(b, h) + aoff + m * 2048 + k * 1024); } while (0)
#define PG8_LDB(dst, b, h) do { _Pragma("unroll") for (int n = 0; n < 2; ++n) _Pragma("unroll") for (int k = 0; k < 2; ++k) dst[n][k] = *(const LAS bf16x8*)(lds + PG8_SB(b, h) + boff + n * 2048 + k * 1024); } while (0)
#define PG8_MMA(ai, bj, At, Bt) do { __builtin_amdgcn_s_setprio(1); _Pragma("unroll") for (int m = 0; m < 4; ++m) _Pragma("unroll") for (int n = 0; n < 2; ++n) _Pragma("unroll") for (int k = 0; k < 2; ++k) \
        acc[ai][bj][m][n] = __builtin_amdgcn_mfma_f32_16x16x32_bf16(Bt[n][k], At[m][k], acc[ai][bj][m][n], 0, 0, 0); __builtin_amdgcn_s_setprio(0); } while (0)
#define PG8_WAIT_V(n) asm volatile("s_waitcnt vmcnt(" #n ")" ::: "memory")
#define PG8_WAIT_L(n) asm volatile("s_waitcnt lgkmcnt(" #n ")" ::: "memory")
#define PG8_BAR __builtin_amdgcn_s_barrier()
#define PG8_SCHED __builtin_amdgcn_sched_barrier(0)

typedef int i32x4v __attribute__((ext_vector_type(4)));
typedef int i32x8v __attribute__((ext_vector_type(8)));
__device__ __forceinline__ i32x8v cat8(bf16x8 a, bf16x8 b) { const i32x4v x = __builtin_bit_cast(i32x4v, a), y = __builtin_bit_cast(i32x4v, b); return __builtin_shufflevector(x, y, 0, 1, 2, 3, 4, 5, 6, 7); }
#define PG8_MFMA8(accv, b8, a8) asm volatile("v_mfma_f32_16x16x128_f8f6f4 %0, %1, %2, %0" : "+v"(accv) : "v"(b8), "v"(a8))
#define PG8_MFMA_DRAIN() asm volatile("s_nop 15\n\ts_nop 15\n\ts_nop 15\n\ts_nop 15" ::: "memory")
#define PG8_MMA8(ai, bj, At, Bt) do { __builtin_amdgcn_s_setprio(1); _Pragma("unroll") for (int m = 0; m < 4; ++m) _Pragma("unroll") for (int n = 0; n < 2; ++n) \
        PG8_MFMA8(acc[ai][bj][m][n], Bt##8[n], At##8[m]); __builtin_amdgcn_s_setprio(0); } while (0)
#define PG8_MM(ai, bj, At, Bt) do { if constexpr (FP8) PG8_MMA8(ai, bj, At, Bt); else PG8_MMA(ai, bj, At, Bt); } while (0)
#define PG8_LDA8(dst, b, h) do { _Pragma("unroll") for (int m = 0; m < 4; ++m) dst##8[m] = cat8(*(const LAS bf16x8*)(lds + PG8_SA(b, h) + aoff + m * 2048), *(const LAS bf16x8*)(lds + PG8_SA(b, h) + aoff + m * 2048 + 1024)); } while (0)
#define PG8_LDB8(dst, b, h) do { _Pragma("unroll") for (int n = 0; n < 2; ++n) dst##8[n] = cat8(*(const LAS bf16x8*)(lds + PG8_SB(b, h) + boff + n * 2048), *(const LAS bf16x8*)(lds + PG8_SB(b, h) + boff + n * 2048 + 1024)); } while (0)
#define PG8_LA(dst, b, h) do { if constexpr (FP8) PG8_LDA8(dst, b, h); else PG8_LDA(dst, b, h); } while (0)
#define PG8_LB(dst, b, h) do { if constexpr (FP8) PG8_LDB8(dst, b, h); else PG8_LDB(dst, b, h); } while (0)
template <bool FP8, class Epi, class Sched>
__device__ __forceinline__ void gemm_phase(LAS unsigned char* lds, const char* A0, int K, const Sched& S, const Epi& E) {
    const int tid = opaque_v((int)threadIdx.x), wid = __builtin_amdgcn_readfirstlane(tid >> 6), lane = tid & 63, wr = wid >> 2, wc = wid & 3, fr = lane & 15, fq = lane >> 4;
    const int nt = K / (BK * 2);
    unsigned voffB;
    { int R0, C0; stage_rc(tid * 16, R0, C0); C0 *= 2;
      const int Rb0 = Epi::PERM ? ((R0 & ~31) + perm32(R0 & 31)) : R0;
      voffB = (unsigned)(Rb0 * K + C0); }
    const size_t r64 = (size_t)64 * K;
    const size_t kstep = (size_t)(BK * 2);
    const size_t hstep = (size_t)HALF * K;
    const unsigned ldsw = (unsigned)wid * 1024u, lds0 = (unsigned)(uintptr_t)lds;
    const int aoff = lds_byte(wr * 64 + fr, fq * 8), boff = lds_byte(wc * 32 + fr, fq * 8);
    Unit cur, nxt; int ui = 0;
    if (!S.next(0, cur)) return;
    f32x4 acc[2][2][4][2];
#pragma unroll
    for (int a = 0; a < 2; ++a)
#pragma unroll
        for (int b = 0; b < 2; ++b)
#pragma unroll
            for (int m = 0; m < 4; ++m)
#pragma unroll
                for (int n = 0; n < 2; ++n) acc[a][b][m][n] = (f32x4){0.f, 0.f, 0.f, 0.f};
    bf16x8 At[4][2], B0[2][2], B1[2][2];
    i32x8v At8[4], B08[2], B18[2];
    unsigned vc[2][2], vn[2][2];
    S.aoffs(cur, vc);
    const char* cB = S.bptr(cur);
    PG8_STAGE_B(PG8_SB(0, 0), cB); PG8_STAGE_B(PG8_SB(0, 1), cB + hstep); PG8_STAGE_A(PG8_SA(0, 0), A0, 0); PG8_STAGE_A(PG8_SA(0, 1), A0, 1);
    if (wr == 1) PG8_BAR;
    PG8_WAIT_V(2); PG8_BAR;
    PG8_STAGE_B(PG8_SB(1, 0), cB + kstep); PG8_STAGE_A(PG8_SA(1, 0), A0 + kstep, 0); PG8_STAGE_B(PG8_SB(1, 1), cB + hstep + kstep);
    PG8_WAIT_V(6); PG8_BAR;
#pragma unroll 1
    for (;;) {
        const bool has_next = S.next(ui + 1, nxt);
        const char* nB = cB; unsigned dlt = 0u;
        if constexpr (Sched::GATHER) {
            if (has_next) { S.aload(nxt, vn); nB = S.bptr(nxt); }
        } else { if (has_next) { dlt = S.adelta(cur, nxt); nB = S.bptr(nxt); } }
#pragma unroll 1
        for (int t = 0; t < nt; t += 2) {
            const bool last = (t == nt - 2);
            const char* a1 = A0 + (size_t)(t + 1) * kstep;
            const char* a2 = last ? A0 : A0 + (size_t)(t + 2) * kstep; const char* b2 = last ? nB : cB + (size_t)(t + 2) * kstep;
            const char* a3 = a2 + kstep; const char* b3 = b2 + kstep;
            PG8_LB(B0, 0, 0); PG8_LB(B1, 0, 1); PG8_SCHED; PG8_LA(At, 0, 0); PG8_STAGE_A(PG8_SA(1, 1), a1, 1);
            PG8_WAIT_V(8); PG8_WAIT_L(0); PG8_BAR;
            if (last) {
                if constexpr (Sched::GATHER) { if (has_next) {
#pragma unroll
                    for (int h = 0; h < 2; ++h) { vc[h][0] = (unsigned)opaque_v((int)vn[h][0]); vc[h][1] = (unsigned)opaque_v((int)vn[h][1]); }
                    S.aconv(vc); } }
                else vc[0][0] += dlt; }
            PG8_MM(0, 0, At, B0); PG8_MM(0, 1, At, B1); PG8_BAR; PG8_SCHED;
            PG8_LA(At, 0, 1); PG8_STAGE_B(PG8_SB(0, 0), b2); PG8_STAGE_B(PG8_SB(0, 1), b2 + hstep); PG8_STAGE_A(PG8_SA(0, 0), a2, 0);
            PG8_WAIT_V(8); PG8_WAIT_L(0); PG8_BAR; PG8_MM(1, 0, At, B0); PG8_MM(1, 1, At, B1); PG8_BAR; PG8_SCHED;
            PG8_LB(B0, 1, 0); PG8_LB(B1, 1, 1); PG8_SCHED; PG8_LA(At, 1, 0); PG8_STAGE_A(PG8_SA(0, 1), a2, 1);
            PG8_WAIT_V(8); PG8_WAIT_L(0); PG8_BAR; PG8_MM(0, 0, At, B0); PG8_MM(0, 1, At, B1); PG8_BAR; PG8_SCHED;
            PG8_LA(At, 1, 1); PG8_STAGE_B(PG8_SB(1, 0), b3); PG8_STAGE_B(PG8_SB(1, 1), b3 + hstep); PG8_STAGE_A(PG8_SA(1, 0), a3, 0);
            PG8_WAIT_V(8); PG8_WAIT_L(0); PG8_BAR; PG8_MM(1, 0, At, B0); PG8_MM(1, 1, At, B1); PG8_BAR; PG8_SCHED;
        }
        if (wr == 0) PG8_BAR;
        if constexpr (FP8) PG8_MFMA_DRAIN();
        { const int l_ = opaque_v((int)threadIdx.x) & 63; E(acc, cur, wr, wc, l_ & 15, l_ >> 4); }
        if (!has_next) break;
#pragma unroll
        for (int a = 0; a < 2; ++a)
#pragma unroll
            for (int b = 0; b < 2; ++b)
#pragma unroll
                for (int m = 0; m < 4; ++m)
#pragma unroll
                    for (int n = 0; n < 2; ++n) acc[a][b][m][n] = (f32x4){0.f, 0.f, 0.f, 0.f};
        cur = nxt; cB = nB; ++ui;
        if (wr == 1) PG8_BAR;
    }
    PG8_WAIT_V(0);
    PG8_BAR;
}
}
namespace pg8 {
__device__ __forceinline__ u32x2 pack8_fp8(const f32x4 a, const f32x4 b) { int w0 = 0, w1 = 0;
    w0 = __builtin_amdgcn_cvt_pk_fp8_f32(a[0], a[1], w0, false); w0 = __builtin_amdgcn_cvt_pk_fp8_f32(a[2], a[3], w0, true);
    w1 = __builtin_amdgcn_cvt_pk_fp8_f32(b[0], b[1], w1, false); w1 = __builtin_amdgcn_cvt_pk_fp8_f32(b[2], b[3], w1, true); u32x2 r; r.x = (unsigned)w0; r.y = (unsigned)w1; return r; }
__device__ __forceinline__ u32x4 pack8(const f32x4 a, const f32x4 b) { u32x4 w; w.x = cvt_pk_bf16(a[0], a[1]); w.y = cvt_pk_bf16(a[2], a[3]); w.z = cvt_pk_bf16(b[0], b[1]); w.w = cvt_pk_bf16(b[2], b[3]); return w; }

struct EpiPlainBf16 {
    static constexpr bool PERM = true;
    bf16_t* O; int ldc;
    __device__ __forceinline__ void operator()(const f32x4 (&acc)[2][2][4][2], const Unit& u, int wr, int wc, int fr, int fq) const {
        const int row0 = u.pm * BM + wr * 64 + fr, col0 = u.pn * BM + wc * 32 + 8 * fq;
#pragma unroll
        for (int ai = 0; ai < 2; ++ai)
#pragma unroll
            for (int m = 0; m < 4; ++m) { bf16_t* rowp = O + (size_t)(row0 + ai * HALF + m * 16) * ldc + col0;
#pragma unroll
                for (int bj = 0; bj < 2; ++bj) *(u32x4*)(rowp + bj * HALF) = pack8(acc[ai][bj][m][0], acc[ai][bj][m][1]); }
    }
};

struct EpiHgrnIn {
    static constexpr bool PERM = true;
    bf16_t* P; float* LF; const float* lb;
    __device__ __forceinline__ void operator()(const f32x4 (&acc)[2][2][4][2], const Unit& u, int wr, int wc, int fr, int fq) const {
        const int seg = u.pn >> 2;
        const int row0 = u.pm * BM + wr * 64 + fr, col0 = (u.pn & 3) * BM + wc * 32 + 8 * fq;
        if (seg == 1) {
            float lbv[2][8];
#pragma unroll
            for (int bj = 0; bj < 2; ++bj) { const f32x4 a = *(const f32x4*)(lb + col0 + bj * HALF), b = *(const f32x4*)(lb + col0 + bj * HALF + 4);
                lbv[bj][0] = a[0]; lbv[bj][1] = a[1]; lbv[bj][2] = a[2]; lbv[bj][3] = a[3]; lbv[bj][4] = b[0]; lbv[bj][5] = b[1]; lbv[bj][6] = b[2]; lbv[bj][7] = b[3]; }
#pragma unroll
            for (int ai = 0; ai < 2; ++ai)
#pragma unroll
                for (int m = 0; m < 4; ++m) { const size_t off = (size_t)(row0 + ai * HALF + m * 16) * D + col0;
#pragma unroll
                    for (int bj = 0; bj < 2; ++bj) { float lf[8], ky[8];
#pragma unroll
                        for (int j = 0; j < 8; ++j) { const float f = acc[ai][bj][m][j >> 2][j & 3], l = lbv[bj][j];
                            const float sg = fsigmoid(f); const float fg = l + (1.0f - l) * sg;
                            lf[j] = __logf(fmaxf(fg, 1e-30f)); ky[j] = (1.0f - l) * (1.0f - sg); }
                        *(f32x4*)(LF + off + bj * HALF) = (f32x4){lf[0], lf[1], lf[2], lf[3]}; *(f32x4*)(LF + off + bj * HALF + 4) = (f32x4){lf[4], lf[5], lf[6], lf[7]};
                        u32x4 w; w.x = cvt_pk_bf16(ky[0], ky[1]); w.y = cvt_pk_bf16(ky[2], ky[3]); w.z = cvt_pk_bf16(ky[4], ky[5]); w.w = cvt_pk_bf16(ky[6], ky[7]);
                        *(u32x4*)(P + (size_t)T * D + off + bj * HALF) = w; }
                    __builtin_amdgcn_sched_barrier(0); }
        } else {
            bf16_t* O = P + (size_t)seg * T * D;
            const bool act = (seg != 2);
#pragma unroll
            for (int ai = 0; ai < 2; ++ai)
#pragma unroll
                for (int m = 0; m < 4; ++m) { const size_t off = (size_t)(row0 + ai * HALF + m * 16) * D + col0;
#pragma unroll
                    for (int bj = 0; bj < 2; ++bj) { f32x4 a = acc[ai][bj][m][0], b = acc[ai][bj][m][1];
                        if (act) {
#pragma unroll
                            for (int j = 0; j < 4; ++j) { a[j] = fsilu(a[j]); b[j] = fsilu(b[j]); } }
                        *(u32x4*)(O + off + bj * HALF) = pack8(a, b); }
                    __builtin_amdgcn_sched_barrier(0); }
        }
    }
};

struct EpiResid {
    static constexpr bool PERM = true;
    const float* Xf; bf16_t* Xb; const float* gate;
    int gstride;
    __device__ __forceinline__ void operator()(const f32x4 (&acc)[2][2][4][2], const Unit& u, int wr, int wc, int fr, int fq) const {
        const int row0 = u.pm * BM + wr * 64 + fr, col0 = u.pn * BM + wc * 32 + 8 * fq;
        const float* g = gate + (size_t)((u.pm * BM) / SEQ) * gstride;
        f32x4 gv[2][2];
#pragma unroll
        for (int bj = 0; bj < 2; ++bj)
#pragma unroll
            for (int n = 0; n < 2; ++n) gv[bj][n] = *(const f32x4*)(g + col0 + bj * HALF + n * 4);
#pragma unroll
        for (int ai = 0; ai < 2; ++ai)
#pragma unroll
            for (int m = 0; m < 4; ++m) { const size_t off = (size_t)(row0 + ai * HALF + m * 16) * D + col0;
#pragma unroll
                for (int bj = 0; bj < 2; ++bj) { f32x4 x0, x1;
                    if (Xf) { x0 = *(const f32x4*)(Xf + off + bj * HALF); x1 = *(const f32x4*)(Xf + off + bj * HALF + 4); }
                    else { const u32x4 w = *(const u32x4*)(Xb + off + bj * HALF); x0 = (f32x4){bflo(w.x), bfhi(w.x), bflo(w.y), bfhi(w.y)}; x1 = (f32x4){bflo(w.z), bfhi(w.z), bflo(w.w), bfhi(w.w)}; }
                    *(u32x4*)(Xb + off + bj * HALF) = pack8(x0 + gv[bj][0] * acc[ai][bj][m][0], x1 + gv[bj][1] * acc[ai][bj][m][1]); }
                __builtin_amdgcn_sched_barrier(0); }
    }
};

struct EpiKvUp {
    static constexpr bool PERM = true;
    bf16_t *Kb, *Vb;
    __device__ __forceinline__ void operator()(const f32x4 (&acc)[2][2][4][2], const Unit& u, int wr, int wc, int fr, int fq) const {
        const int row0 = u.pm * BM + wr * 64 + fr, c = wc * 32 + 8 * fq, h = u.pn;
#pragma unroll
        for (int ai = 0; ai < 2; ++ai)
#pragma unroll
            for (int m = 0; m < 4; ++m) { const size_t row = (size_t)(row0 + ai * HALF + m * 16);
                *(u32x4*)(Kb + row * (MH * QK) + h * QK + c) = pack8(acc[ai][0][m][0], acc[ai][0][m][1]);
                *(u32x4*)(Vb + row * D + h * VD + c) = pack8(acc[ai][1][m][0], acc[ai][1][m][1]); }
    }
};

struct EpiQUp {
    static constexpr bool PERM = true;
    bf16_t* Qb; const float* rope;
    __device__ __forceinline__ void operator()(const f32x4 (&acc)[2][2][4][2], const Unit& u, int wr, int wc, int fr, int fq) const {
        const int row0 = u.pm * BM + wr * 64 + fr, c = wc * 32 + 8 * fq;
        if (u.pn < 4) {
#pragma unroll
            for (int ai = 0; ai < 2; ++ai)
#pragma unroll
                for (int m = 0; m < 4; ++m) { const size_t row = (size_t)(row0 + ai * HALF + m * 16);
#pragma unroll
                    for (int bj = 0; bj < 2; ++bj) *(u32x4*)(Qb + row * (MH * QK) + (2 * u.pn + bj) * QK + c) = pack8(acc[ai][bj][m][0], acc[ai][bj][m][1]); }
        } else {
            const int h = 4 * (u.pn - 4) + wc, i0 = 8 * fq;
#pragma unroll
            for (int ai = 0; ai < 2; ++ai)
#pragma unroll
                for (int m = 0; m < 4; ++m) { const size_t row = (size_t)(row0 + ai * HALF + m * 16);
                    const float* rp = rope + row * 64 + i0;
                    const f32x4 c0 = *(const f32x4*)(rp), c1 = *(const f32x4*)(rp + 4), s0 = *(const f32x4*)(rp + 32), s1 = *(const f32x4*)(rp + 36);
                    const f32x4 a0 = acc[ai][0][m][0], a1 = acc[ai][0][m][1], b0 = acc[ai][1][m][0], b1 = acc[ai][1][m][1];
                    const f32x4 o10 = a0 * c0 - b0 * s0, o11 = a1 * c1 - b1 * s1, o20 = b0 * c0 + a0 * s0, o21 = b1 * c1 + a1 * s1;
                    bf16_t* qp = Qb + row * (MH * QK) + h * QK + NOPE + i0;
                    *(u32x4*)(qp) = pack8(o10, o11); *(u32x4*)(qp + 32) = pack8(o20, o21);
                    __builtin_amdgcn_sched_barrier(0); }
        }
    }
};

template <bool GATHER_> struct MoeSched {
    static constexpr bool GATHER = GATHER_;
    const LAS int* tab;
    int NT, G, c;
    const char* Bt; size_t estride; int K;
    const int* rinfo;
    __device__ __forceinline__ unsigned adelta(const Unit& a, const Unit& b) const { return (unsigned)((b.pm - a.pm) * BM * K); }
    __device__ __forceinline__ bool next(int i, Unit& u) const {
        const int L = i * G + c; const int rb = L / NT;
        if (rb >= tab[32]) return false;
        int e = 0;
#pragma unroll 1
        for (int j = 1; j < 32; ++j) e += (tab[j] <= rb) ? 1 : 0;
        u.pm = rb; u.pn = L - rb * NT; u.e = e; return true;
    }
    __device__ __forceinline__ const char* bptr(const Unit& u) const { return Bt + (size_t)u.e * estride + (size_t)u.pn * BM * K; }
    __device__ __forceinline__ void aload(const Unit& u, unsigned (&raw)[2][2]) const {
        int R0, C0, R1, C1; { const int t_ = opaque_v((int)threadIdx.x); stage_rc(t_ * 16, R0, C0); stage_rc(t_ * 16 + 8192, R1, C1); }
        const int* rp = rinfo + u.pm * BM;
#pragma unroll
        for (int h = 0; h < 2; ++h) {
            raw[h][0] = (unsigned)rp[h * HALF + R0]; raw[h][1] = (unsigned)rp[h * HALF + R1]; }
    }
    __device__ __forceinline__ void aconv(unsigned (&o)[2][2]) const {
        int R0, C0, R1, C1; { const int t_ = opaque_v((int)threadIdx.x); stage_rc(t_ * 16, R0, C0); stage_rc(t_ * 16 + 8192, R1, C1); C0 *= 2; C1 *= 2; }
#pragma unroll
        for (int h = 0; h < 2; ++h) { const int i0 = (int)o[h][0], i1 = (int)o[h][1]; const int t0 = (i0 < 0 ? 0 : i0) >> 2, t1 = (i1 < 0 ? 0 : i1) >> 2;
            o[h][0] = (unsigned)(t0 * K + C0); o[h][1] = (unsigned)(t1 * K + C1); }
    }
    __device__ __forceinline__ void aoffs(const Unit& u, unsigned (&o)[2][2]) const {
        int R0, C0, R1, C1; { const int t_ = opaque_v((int)threadIdx.x); stage_rc(t_ * 16, R0, C0); stage_rc(t_ * 16 + 8192, R1, C1); C0 *= 2; C1 *= 2; }
        if constexpr (GATHER_) { aload(u, o); asm volatile("s_waitcnt vmcnt(0)" : "+v"(o[0][0]), "+v"(o[0][1]), "+v"(o[1][0]), "+v"(o[1][1]) :: "memory"); aconv(o); }
        else {
#pragma unroll
            for (int h = 0; h < 2; ++h) { o[h][0] = (unsigned)((u.pm * BM + h * HALF + R0) * K + C0); o[h][1] = (unsigned)((u.pm * BM + h * HALF + R1) * K + C1); }
        }
    }
};

struct EpiMoeGU {
    static constexpr bool PERM = true;
    unsigned char* ACT; const float* bgu;
    __device__ __forceinline__ void operator()(const f32x4 (&acc)[2][2][4][2], const Unit& u, int wr, int wc, int fr, int fq) const {
        const int row0 = u.pm * BM + wr * 64 + fr, c = u.pn * HALF + wc * 32 + 8 * fq;
        const float* bp = bgu + (size_t)u.e * 2048 + c;
        const f32x4 bg0 = *(const f32x4*)(bp), bg1 = *(const f32x4*)(bp + 4), bu0 = *(const f32x4*)(bp + 1024), bu1 = *(const f32x4*)(bp + 1028);
#pragma unroll
        for (int ai = 0; ai < 2; ++ai)
#pragma unroll
            for (int m = 0; m < 4; ++m) { const size_t row = (size_t)(row0 + ai * HALF + m * 16);
                f32x4 g0 = acc[ai][0][m][0] * 0.015625f + bg0, g1 = acc[ai][0][m][1] * 0.015625f + bg1, u0 = acc[ai][1][m][0] * 0.015625f + bu0, u1 = acc[ai][1][m][1] * 0.015625f + bu1, r0, r1;
#pragma unroll
                for (int j = 0; j < 4; ++j) {
                    const float ga = fminf(g0[j], SWIGLU_LIMIT), gb = fminf(g1[j], SWIGLU_LIMIT);
                    const float ua = fminf(fmaxf(u0[j], -SWIGLU_LIMIT), SWIGLU_LIMIT), ub = fminf(fmaxf(u1[j], -SWIGLU_LIMIT), SWIGLU_LIMIT);
                    r0[j] = (ua + 1.0f) * ga * fsigmoid(SWIGLU_ALPHA * ga); r1[j] = (ub + 1.0f) * gb * fsigmoid(SWIGLU_ALPHA * gb); }
                *(u32x2*)(ACT + row * FF + c) = pack8_fp8(r0, r1);
                __builtin_amdgcn_sched_barrier(0); }
    }
};

struct EpiMoeDN {
    static constexpr bool PERM = true;
    bf16_t* YS; const float* bdn; const int* rinfo; const float* rw;
    __device__ __forceinline__ void operator()(const f32x4 (&acc)[2][2][4][2], const Unit& u, int wr, int wc, int fr, int fq) const {
        const int row0 = u.pm * BM + wr * 64 + fr, c = u.pn * BM + wc * 32 + 8 * fq;
        const float* bp = bdn + (size_t)u.e * 1024 + c;
#pragma unroll
        for (int ai = 0; ai < 2; ++ai)
#pragma unroll
            for (int m = 0; m < 4; ++m) { const int row = row0 + ai * HALF + m * 16; const int info = rinfo[row]; const float w = rw[row] * 0.015625f;
                if (info >= 0) { bf16_t* yp = YS + (size_t)info * D + c;
#pragma unroll
                    for (int bj = 0; bj < 2; ++bj) { const f32x4 b0 = *(const f32x4*)(bp + bj * HALF) * 64.0f, b1 = *(const f32x4*)(bp + bj * HALF + 4) * 64.0f;
                        *(u32x4*)(yp + bj * HALF) = pack8((acc[ai][bj][m][0] + b0) * w, (acc[ai][bj][m][1] + b1) * w); } }
                __builtin_amdgcn_sched_barrier(0); }
    }
};
}
struct Ctx {
    LAS unsigned char* lds;
    int G, vcu;
    const float* in[28]; float* out; unsigned char* ws;
    __device__ __forceinline__ float* MOD() const { return (float*)(ws + WS_MOD); }
    __device__ __forceinline__ unsigned* ctl() const { return (unsigned*)(ws + WS_CTL); }
};
__device__ __forceinline__ const float* modp(const Ctx& F, int l, int b, int which) { return (const float*)(F.ws + WS_MOD) + ((size_t)(l * NB + b) * 6 + which) * D; }

__device__ const double ROPE_INV_FREQ[32] = {
    1.0, 0.7498942093324559, 0.5623413251903491, 0.4216965034285822, 0.31622776601683794, 0.23713737056616552, 0.1778279410038923, 0.1333521432163324,
    0.1, 0.07498942093324559, 0.05623413251903491, 0.04216965034285822, 0.03162277660168379, 0.023713737056616554, 0.01778279410038923, 0.01333521432163324,
    0.01, 0.007498942093324559, 0.005623413251903491, 0.004216965034285822, 0.0031622776601683794, 0.0023713737056616554, 0.001778279410038923, 0.001333521432163324,
    0.001, 0.0007498942093324559, 0.0005623413251903491, 0.0004216965034285822, 0.00031622776601683794, 0.00023713737056616554, 0.0001778279410038923, 0.0001333521432163324};

__device__ __forceinline__ int map_rows(int maptype, int n0) {
    if (maptype == 1) { return n0 < 1024 ? (n0 >> 7) * 256 + (n0 & 127) : ((n0 - 1024) >> 7) * 256 + 128 + ((n0 - 1024) & 127); }
    if (maptype == 2) { const int h = n0 / QK, d = n0 - h * QK; if (d < NOPE) return h * NOPE + d; const int i = d - NOPE;
                        return 1024 + (h >> 2) * 256 + (i >> 5) * 128 + (h & 3) * 32 + (i & 31); }
    return n0;
}
struct ConvD { const float* src; unsigned char* dst; int N, Kb, f8; };
#define CONV_DEC(Wp, wstride, nmat, K_, N_, dstoff, dstride, mt, f8_) do { const int per = ((K_) / 64) * ((N_) / 32), tot = (nmat) * per; \
        if (r < tot) { const int mi = r / per, item = r - mi * per, nblk = (N_) / 32, kb = item / nblk, nb = item - kb * nblk, es = (f8_) ? 1 : 2; \
            d.src = (Wp) + (size_t)mi * (wstride) + (size_t)(64 * kb) * (N_) + 32 * nb; d.N = (N_); d.Kb = (K_) * es; d.f8 = (f8_); \
            d.dst = F.ws + (dstoff) + ((size_t)mi * (dstride) + (size_t)map_rows((mt), 32 * nb) * (K_) + 64 * kb) * es; return d; } r -= tot; } while (0)
__device__ __forceinline__ ConvD conv_decode(const Ctx& F, int it) {
    ConvD d; int r = it;
    CONV_DEC(F.in[23], (size_t)1024 * 2048, 128, 1024, 2048, WS_WGU, (size_t)2048 * 1024, 1, 1);
    CONV_DEC(F.in[25], (size_t)1024 * 1024, 128, 1024, 1024, WS_WDN, (size_t)1024 * 1024, 0, 1);
    CONV_DEC(F.in[7],  (size_t)1024 * 4096, 2, 1024, 4096, WS_WIN, (size_t)4096 * 1024, 0, 0);
    CONV_DEC(F.in[10], (size_t)1024 * 1024, 2, 1024, 1024, WS_WOUT, (size_t)1024 * 1024, 0, 0);
    CONV_DEC(F.in[14], (size_t)0, 1, 1024, 320, WS_WDKV, (size_t)0, 0, 0);
    CONV_DEC(F.in[16], (size_t)0, 1, 256, 2048, WS_WUKV, (size_t)0, 0, 0);
    CONV_DEC(F.in[17], (size_t)1024 * 384, 2, 1024, 384, WS_WDQ, (size_t)512 * 1024, 0, 0);
    CONV_DEC(F.in[19], (size_t)384 * 1536, 2, 384, 1536, WS_WUQ, (size_t)1536 * 384, 2, 0);
    CONV_DEC(F.in[20], (size_t)1024 * 1024, 2, 1024, 1024, WS_WO, (size_t)1024 * 1024, 0, 0);
    d.src = F.in[20]; d.dst = F.ws + WS_WO; d.N = 1024; d.Kb = 2048; d.f8 = 0; return d;
}
__device__ __forceinline__ void conv_load(const ConvD& d, int lane, float (&wv)[32]) {
    const float* p = d.src + (size_t)(lane >> 5) * d.N + (lane & 31);
#pragma unroll
    for (int i = 0; i < 32; ++i) wv[i] = p[(size_t)(2 * i) * d.N];
}
__device__ __forceinline__ void conv_store(const ConvD& d, int lane, LAS float* scr, const float (&wv)[32]) {
#pragma unroll
    for (int i = 0; i < 32; ++i) scr[(2 * i + (lane >> 5)) * 33 + (lane & 31)] = wv[i];
    LDS_WAIT(); asm volatile("" ::: "memory");
    const int c = lane & 7;
#pragma unroll
    for (int j = 0; j < 4; ++j) { const int n = (lane >> 3) + 8 * j; const LAS float* s = scr + (8 * c) * 33 + n;
        if (d.f8) { int w0 = 0, w1 = 0;
            w0 = __builtin_amdgcn_cvt_pk_fp8_f32(s[0 * 33] * 64.f, s[1 * 33] * 64.f, w0, false); w0 = __builtin_amdgcn_cvt_pk_fp8_f32(s[2 * 33] * 64.f, s[3 * 33] * 64.f, w0, true);
            w1 = __builtin_amdgcn_cvt_pk_fp8_f32(s[4 * 33] * 64.f, s[5 * 33] * 64.f, w1, false); w1 = __builtin_amdgcn_cvt_pk_fp8_f32(s[6 * 33] * 64.f, s[7 * 33] * 64.f, w1, true);
            u32x2 o; o.x = (unsigned)w0; o.y = (unsigned)w1; *(u32x2*)(d.dst + (size_t)n * d.Kb + 8 * c) = o; }
        else { u32x4 o; o.x = cvt_pk_bf16(s[0 * 33], s[1 * 33]); o.y = cvt_pk_bf16(s[2 * 33], s[3 * 33]); o.z = cvt_pk_bf16(s[4 * 33], s[5 * 33]); o.w = cvt_pk_bf16(s[6 * 33], s[7 * 33]);
            *(u32x4*)(d.dst + (size_t)n * d.Kb + 16 * c) = o; } }
    LDS_WAIT(); asm volatile("" ::: "memory");
}
__device__ __forceinline__ void phase_convert(const Ctx& F) {
    PHASE_IDS;
    LAS float* scr = (LAS float*)(F.lds + wave * 16384);
    const int gw = F.vcu * NWAVES + wave, NGW = F.G * NWAVES;
    constexpr int TOTAL = 2 * 16 * 128 + 2 * 16 * 32 + 16 * 10 + 4 * 64 + 2 * 16 * 12 + 2 * 6 * 48 + 2 * 16 * 32 + 128 * 16 * 64 + 128 * 16 * 32;
    float wa[32], wb[32];
    int it = gw;
    if (it < TOTAL) { ConvD da = conv_decode(F, it); conv_load(da, lane, wa);
        for (;;) {
            const int it1 = it + NGW; ConvD db = da; const bool h1 = it1 < TOTAL;
            if (h1) { db = conv_decode(F, it1); conv_load(db, lane, wb); }
            conv_store(da, lane, scr, wa);
            if (!h1) break;
            const int it2 = it1 + NGW; const bool h2 = it2 < TOTAL;
            if (h2) { da = conv_decode(F, it2); conv_load(da, lane, wa); }
            conv_store(db, lane, scr, wb);
            if (!h2) break;
            it = it2;
        } }
    const int gt = (F.vcu * NTHREADS + tid), NGT = F.G * NTHREADS;
    for (int i = gt; i < 192 * 1024 / 8; i += NGT) *((u32x4*)(F.ws + WS_WDKV + (size_t)320 * 1024 * 2) + i) = (u32x4){0u, 0u, 0u, 0u};
    for (int i = gt; i < 2 * 128 * 1024 / 8; i += NGT) { const int m = i / (128 * 1024 / 8), j = i - m * (128 * 1024 / 8);
        *((u32x4*)(F.ws + WS_WDQ + (size_t)m * 512 * 1024 * 2 + (size_t)384 * 1024 * 2) + j) = (u32x4){0u, 0u, 0u, 0u}; }
}

__device__ __forceinline__ void phase_mod(const Ctx& F) {
    PHASE_IDS;
    LAS float* cact = (LAS float*)(F.lds);
    LAS float* red = (LAS float*)(F.lds + 65536);
    const float* c = F.in[1];
    for (int i = tid; i < NB * D; i += NTHREADS) { const int b = i / D, k = i - b * D; cact[k * 16 + b] = fsilu(c[i]); }
    __syncthreads();
    constexpr int NTASK = (DEPTH * 6 * D + 2 * D) / 128;
    const int kq = tid >> 7, jj = tid & 127;
    for (int task = F.vcu; task < NTASK; task += F.G) {
        const int gcol = task * 128 + jj;
        const float* W; const float* bias; float* outp; int N, col, l = gcol / (6 * D);
        if (l < DEPTH) { col = gcol - l * 6 * D; N = 6 * D; W = F.in[5] + (size_t)l * D * N; bias = F.in[6] + (size_t)l * N; outp = (float*)(F.ws + WS_MOD) + (size_t)l * NB * N; }
        else { col = gcol - DEPTH * 6 * D; N = 2 * D; W = F.in[12]; bias = F.in[13]; outp = (float*)(F.ws + WS_KVMOD); }
        float acc[16];
#pragma unroll
        for (int b = 0; b < 16; ++b) acc[b] = 0.f;
#pragma unroll 8
        for (int k = kq * 256; k < kq * 256 + 256; ++k) {
            const float w = W[(size_t)k * N + col];
            const LAS f32x4* cp = (const LAS f32x4*)(cact + k * 16);
#pragma unroll
            for (int q = 0; q < 4; ++q) { const f32x4 cv = cp[q]; acc[4 * q] += cv[0] * w; acc[4 * q + 1] += cv[1] * w; acc[4 * q + 2] += cv[2] * w; acc[4 * q + 3] += cv[3] * w; }
        }
#pragma unroll
        for (int q = 0; q < 4; ++q) *(LAS f32x4*)(red + (kq * 128 + jj) * 16 + 4 * q) = (f32x4){acc[4 * q], acc[4 * q + 1], acc[4 * q + 2], acc[4 * q + 3]};
        __syncthreads();
#pragma unroll
        for (int q = 0; q < 4; ++q) { const int o = tid + q * NTHREADS, cj = o >> 4, b = o & 15;
            const float s = red[(0 * 128 + cj) * 16 + b] + red[(1 * 128 + cj) * 16 + b] + red[(2 * 128 + cj) * 16 + b] + red[(3 * 128 + cj) * 16 + b];
            const int oc = (task * 128 + cj) - (l < DEPTH ? l * 6 * D : DEPTH * 6 * D);
            outp[(size_t)b * N + oc] = s + bias[oc]; }
        __syncthreads();
    }
    const int gt = (F.vcu * NTHREADS + tid), NGT = F.G * NTHREADS;
    for (int i = gt; i < D; i += NGT) { const float l0 = F.in[8][i], l1 = F.in[8][D + i];
        ((float*)(F.ws + WS_LB))[i] = 0.f; ((float*)(F.ws + WS_LB))[D + i] = 1.0f / (1.0f + __expf(l0 - l1)); }
    const int* pos = (const int*)F.in[2];
    for (int i = gt; i < T * 32; i += NGT) { const int t = i >> 5, j = i & 31;
        const double rev = (double)pos[t] * ROPE_INV_FREQ[j] * 0.15915494309189535;
        const float fr = (float)(rev - floor(rev));
        float* rp = (float*)(F.ws + WS_ROPE) + (size_t)t * 64 + j;
        rp[0] = __builtin_amdgcn_cosf(fr); rp[32] = __builtin_amdgcn_sinf(fr); }
}

struct Row4 { f32x4 v[4]; };
__device__ __forceinline__ int row4_col(int lane, int j) { return 512 * (j >> 1) + 8 * lane + 4 * (j & 1); }
__device__ __forceinline__ Row4 ld_row_f32(const float* p, int lane) { Row4 r; const f32x4* q = (const f32x4*)p + 2 * lane;
#pragma unroll
    for (int j = 0; j < 4; ++j) r.v[j] = q[128 * (j >> 1) + (j & 1)]; return r; }
__device__ __forceinline__ void st_row_f32(float* p, int lane, const Row4& r) { f32x4* q = (f32x4*)p + 2 * lane;
#pragma unroll
    for (int j = 0; j < 4; ++j) q[128 * (j >> 1) + (j & 1)] = r.v[j]; }
__device__ __forceinline__ Row4 ld_row_bf16(const bf16_t* p, int lane) { Row4 r; const u32x4* q = (const u32x4*)p + lane;
#pragma unroll
    for (int jj = 0; jj < 2; ++jj) { const u32x4 w = q[64 * jj]; r.v[2 * jj] = (f32x4){bflo(w.x), bfhi(w.x), bflo(w.y), bfhi(w.y)}; r.v[2 * jj + 1] = (f32x4){bflo(w.z), bfhi(w.z), bflo(w.w), bfhi(w.w)}; } return r; }
__device__ __forceinline__ void st_row_bf16(bf16_t* p, int lane, const Row4& r) { u32x4* q = (u32x4*)p + lane;
#pragma unroll
    for (int jj = 0; jj < 2; ++jj) { u32x4 w; w.x = cvt_pk_bf16(r.v[2 * jj][0], r.v[2 * jj][1]); w.y = cvt_pk_bf16(r.v[2 * jj][2], r.v[2 * jj][3]);
        w.z = cvt_pk_bf16(r.v[2 * jj + 1][0], r.v[2 * jj + 1][1]); w.w = cvt_pk_bf16(r.v[2 * jj + 1][2], r.v[2 * jj + 1][3]); q[64 * jj] = w; } }
__device__ __forceinline__ void st_row_fp8(unsigned char* p, int lane, const Row4& r) { u32x2* q = (u32x2*)p + lane;
#pragma unroll
    for (int jj = 0; jj < 2; ++jj) { int w0 = 0, w1 = 0;
        w0 = __builtin_amdgcn_cvt_pk_fp8_f32(r.v[2 * jj][0], r.v[2 * jj][1], w0, false); w0 = __builtin_amdgcn_cvt_pk_fp8_f32(r.v[2 * jj][2], r.v[2 * jj][3], w0, true);
        w1 = __builtin_amdgcn_cvt_pk_fp8_f32(r.v[2 * jj + 1][0], r.v[2 * jj + 1][1], w1, false); w1 = __builtin_amdgcn_cvt_pk_fp8_f32(r.v[2 * jj + 1][2], r.v[2 * jj + 1][3], w1, true);
        u32x2 o; o.x = (unsigned)w0; o.y = (unsigned)w1; q[64 * jj] = o; } }
__device__ __forceinline__ float row_ssq(const Row4& r) { float s = 0.f;
#pragma unroll
    for (int j = 0; j < 4; ++j) s += (r.v[j][0] * r.v[j][0] + r.v[j][1] * r.v[j][1]) + (r.v[j][2] * r.v[j][2] + r.v[j][3] * r.v[j][3]);
    return wave_sum(s); }
__device__ __forceinline__ Row4 norm_mod(const Row4& x, float rstd, const float* g, const float* sc, const float* sh, int lane) {
    const Row4 gv = ld_row_f32(g, lane), scv = ld_row_f32(sc, lane), shv = ld_row_f32(sh, lane); Row4 h;
#pragma unroll
    for (int j = 0; j < 4; ++j) h.v[j] = (x.v[j] * rstd * gv.v[j]) * (scv.v[j] + 1.0f) + shv.v[j];
    return h; }

__device__ __forceinline__ void phase_combine(const Ctx& F, int l, bool dummy = false) {
    PHASE_IDS;
    const int gw = F.vcu * NWAVES + wave, NGW = F.G * NWAVES;
    bf16_t* XB = (bf16_t*)(F.ws + (dummy ? WS_ACT + (size_t)T * D * 6 : WS_XB));
    float* Xout = dummy ? (float*)(F.ws + WS_ACT) : F.out; bf16_t* Hout = (bf16_t*)(F.ws + (dummy ? WS_ACT + (size_t)T * D * 4 : WS_H));
    const bf16_t* YS = (const bf16_t*)(F.ws + WS_YS);
    for (int m = gw; m < T; m += NGW) {
        const int b = m / SEQ;
        Row4 x = (l < 0) ? ld_row_f32(F.in[0] + (size_t)m * D, lane) : ld_row_bf16((const bf16_t*)(F.ws + WS_XB) + (size_t)m * D, lane);
        if (l >= 0) {
            Row4 y = ld_row_bf16(YS + (size_t)(m * 4) * D, lane);
#pragma unroll
            for (int s = 1; s < 4; ++s) { const Row4 t = ld_row_bf16(YS + (size_t)(m * 4 + s) * D, lane);
#pragma unroll
                for (int j = 0; j < 4; ++j) y.v[j] += t.v[j]; }
            const Row4 gt = ld_row_f32(modp(F, l, b, 5), lane);
#pragma unroll
            for (int j = 0; j < 4; ++j) x.v[j] += gt.v[j] * y.v[j];
        }
        const float rstd = rsqrtf(row_ssq(x) * (1.0f / D) + NORM_EPS);
        if (l == DEPTH - 1) {
            const Row4 gv = ld_row_f32(F.in[27], lane); Row4 o;
#pragma unroll
            for (int j = 0; j < 4; ++j) o.v[j] = x.v[j] * rstd * gv.v[j];
            st_row_f32(Xout + (size_t)m * D, lane, o);
        } else {
            if (l >= 0) st_row_bf16(XB + (size_t)m * D, lane, x);
            const int ln = l + 1;
            const Row4 h = norm_mod(x, rstd, F.in[3] + (size_t)ln * D, modp(F, ln, b, 1), modp(F, ln, b, 0), lane);
            st_row_bf16(Hout + (size_t)m * D, lane, h);
            if (l == NA - 1) {
                const float* kvm = (const float*)(F.ws + WS_KVMOD) + (size_t)b * 2 * D;
                const Row4 hk = norm_mod(x, rstd, F.in[11], kvm + D, kvm, lane);
                st_row_bf16((bf16_t*)(F.ws + WS_HK) + (size_t)m * D, lane, hk);
            }
        }
    }
}
__device__ __forceinline__ void phase_final_only(const Ctx& F, bool from_input) {
    PHASE_IDS;
    const int gw = F.vcu * NWAVES + wave, NGW = F.G * NWAVES;
    for (int m = gw; m < T; m += NGW) {
        Row4 x = from_input ? ld_row_f32(F.in[0] + (size_t)m * D, lane) : ld_row_bf16((const bf16_t*)(F.ws + WS_XB) + (size_t)m * D, lane);
        const float rstd = rsqrtf(row_ssq(x) * (1.0f / D) + NORM_EPS);
        const Row4 gv = ld_row_f32(F.in[27], lane); Row4 o;
#pragma unroll
        for (int j = 0; j < 4; ++j) o.v[j] = x.v[j] * rstd * gv.v[j];
        st_row_f32(F.out + (size_t)m * D, lane, o);
    }
}

__device__ __forceinline__ void phase_hgrn_gate(const Ctx& F, int l) {
    PHASE_IDS;
    const int gw = F.vcu * NWAVES + wave, NGW = F.G * NWAVES;
    const bf16_t* OO = (const bf16_t*)(F.ws + WS_OO); const bf16_t* GS = (const bf16_t*)(F.ws + WS_GS); bf16_t* OG = (bf16_t*)(F.ws + WS_OG);
    f32x4 gv[2]; { const float* g = F.in[9] + (size_t)l * HGD + 8 * (lane & 15); gv[0] = *(const f32x4*)g; gv[1] = *(const f32x4*)(g + 4); }
    for (int m = gw; m < T; m += NGW) {
        const Row4 o = ld_row_bf16(OO + (size_t)m * D, lane), g = ld_row_bf16(GS + (size_t)m * D, lane); Row4 r;
#pragma unroll
        for (int jh = 0; jh < 2; ++jh) {
            const f32x4 a = o.v[2 * jh], b2 = o.v[2 * jh + 1];
            float s = ((a[0] * a[0] + a[1] * a[1]) + (a[2] * a[2] + a[3] * a[3])) + ((b2[0] * b2[0] + b2[1] * b2[1]) + (b2[2] * b2[2] + b2[3] * b2[3]));
#pragma unroll
            for (int d = 1; d < 16; d <<= 1) s += __shfl_xor(s, d);
            const float rstd = rsqrtf(s * (1.0f / HGD) + NORM_EPS);
            r.v[2 * jh] = (a * rstd * gv[0]) * g.v[2 * jh]; r.v[2 * jh + 1] = (b2 * rstd * gv[1]) * g.v[2 * jh + 1];
        }
        st_row_bf16(OG + (size_t)m * D, lane, r);
    }
}

__device__ __forceinline__ void phase_kv_rows(const Ctx& F) {
    PHASE_IDS;
    const int gw = F.vcu * NWAVES + wave, NGW = F.G * NWAVES;
    const bf16_t* CKR = (const bf16_t*)(F.ws + WS_CKR); bf16_t* CKV = (bf16_t*)(F.ws + WS_CKV); bf16_t* KB = (bf16_t*)(F.ws + WS_KB);
    const float* rope = (const float*)(F.ws + WS_ROPE);
    const f32x4 gv = *(const f32x4*)(F.in[15] + 4 * lane);
    for (int m = gw; m < T; m += NGW) {
        const bf16_t* rp = CKR + (size_t)m * 512;
        const u32x2 w = *((const u32x2*)rp + lane);
        f32x4 v = (f32x4){bflo(w.x), bfhi(w.x), bflo(w.y), bfhi(w.y)};
        const float ss = wave_sum((v[0] * v[0] + v[1] * v[1]) + (v[2] * v[2] + v[3] * v[3]));
        const float rstd = rsqrtf(ss * (1.0f / KVRANK) + NORM_EPS);
        v = v * rstd * gv;
        u32x2 o; o.x = cvt_pk_bf16(v[0], v[1]); o.y = cvt_pk_bf16(v[2], v[3]);
        *((u32x2*)(CKV + (size_t)m * KVRANK) + lane) = o;
        const int i = lane & 31;
        const float t1 = bf2f(rp[KVRANK + i]), t2 = bf2f(rp[KVRANK + 32 + i]);
        const float cs = rope[(size_t)m * 64 + i], sn = rope[(size_t)m * 64 + 32 + i];
        const float r1 = t1 * cs - t2 * sn, r2 = t2 * cs + t1 * sn;
        const unsigned short b1 = f2bf(r1), b2 = f2bf(r2);
        const int hb = (lane >> 5) * 4;
#pragma unroll
        for (int h = 0; h < 4; ++h) { bf16_t* kp = KB + (size_t)m * (MH * QK) + (hb + h) * QK + NOPE; kp[i] = b1; kp[32 + i] = b2; }
    }
}

__device__ __forceinline__ void phase_cq_rows(const Ctx& F, int j) {
    PHASE_IDS;
    const int gw = F.vcu * NWAVES + wave, NGW = F.G * NWAVES;
    const bf16_t* CQ = (const bf16_t*)(F.ws + WS_CQ); bf16_t* CQN = (bf16_t*)(F.ws + WS_CQN);
    const float* g = F.in[18] + (size_t)j * QRANK;
    float gq[3][2];
#pragma unroll
    for (int q = 0; q < 3; ++q) { gq[q][0] = g[128 * q + 2 * lane]; gq[q][1] = g[128 * q + 2 * lane + 1]; }
    for (int m = gw; m < T; m += NGW) {
        const unsigned* rp = (const unsigned*)(CQ + (size_t)m * 512);
        float v[3][2]; float s = 0.f;
#pragma unroll
        for (int q = 0; q < 3; ++q) { const unsigned w = rp[64 * q + lane]; v[q][0] = bflo(w); v[q][1] = bfhi(w); s += v[q][0] * v[q][0] + v[q][1] * v[q][1]; }
        const float rstd = rsqrtf(wave_sum(s) * (1.0f / QRANK) + NORM_EPS);
        unsigned* op = (unsigned*)(CQN + (size_t)m * QRANK);
#pragma unroll
        for (int q = 0; q < 3; ++q) op[64 * q + lane] = cvt_pk_bf16(v[q][0] * rstd * gq[q][0], v[q][1] * rstd * gq[q][1]);
    }
}
__device__ __forceinline__ void phase_router(const Ctx& F, int l, bool dummy = false) {
    PHASE_IDS;
    LAS float* gmt = (LAS float*)(F.lds);
    LAS float* sht = (LAS float*)(F.lds + 4096);
    LAS float* rst = (LAS float*)(F.lds + 8192) + wave * 32;
    LAS float* lgt = (LAS float*)(F.lds + 16384) + wave * (32 * 33);
    LAS int* hist = (LAS int*)(F.lds + 65536);
    LAS int* basev = (LAS int*)(F.lds + 65536 + 256);
    const float* Wr = F.in[21] + (size_t)l * D * NE; const float* br = F.in[22] + (size_t)l * NE;
    const bf16_t* X = (const bf16_t*)(F.ws + WS_XB); unsigned char* H = (unsigned char*)(F.ws + (dummy ? WS_ACT : WS_H));
    int* TKE = (int*)(F.ws + (dummy ? WS_YS : WS_TKE)); float* TKW = (float*)(F.ws + (dummy ? WS_YS + 4 * MiB : WS_TKW)); int* TKR = (int*)(F.ws + (dummy ? WS_YS + 8 * MiB : WS_TKR));
    unsigned* cnt = F.ctl() + CW_CNT + l * 64 + (dummy ? 1024 : 0);
    const int r32 = lane & 31, hi = lane >> 5;
    for (int bt = F.vcu; bt < T / 256; bt += F.G) {
        const int b = (bt * 256) / SEQ;
        const float* g = F.in[4] + (size_t)l * D; const float* sc = modp(F, l, b, 4); const float* sh = modp(F, l, b, 3);
        for (int i = tid; i < D; i += NTHREADS) { gmt[i] = g[i] * (1.0f + sc[i]); sht[i] = sh[i]; }
        if (tid < 32) hist[tid] = 0;
        __syncthreads();
        const int row0 = bt * 256 + wave * 32;
        for (int i = 0; i < 32; ++i) {
            const Row4 x = ld_row_bf16(X + (size_t)(row0 + i) * D, lane);
            const float rstd = rsqrtf(row_ssq(x) * (1.0f / D) + NORM_EPS);
            Row4 h;
#pragma unroll
            for (int j = 0; j < 4; ++j) { const int cc = row4_col(lane, j); const f32x4 gm = *(const LAS f32x4*)(gmt + cc), s4 = *(const LAS f32x4*)(sht + cc); h.v[j] = x.v[j] * rstd * gm + s4; }
            st_row_fp8(H + (size_t)(row0 + i) * D, lane, h);
            if (lane == 0) rst[i] = rstd;
        }
        LDS_WAIT(); asm volatile("" ::: "memory");
        f32x16 acc = {};
        { const float rstd = rst[r32]; const bf16_t* xr = X + (size_t)(row0 + r32) * D + 4 * hi; const float* wp = Wr + (size_t)(4 * hi) * NE + r32;
#pragma unroll 2
          for (int j = 0; j < 128; ++j) {
              const u32x2 xw = *(const u32x2*)(xr + 8 * j); const f32x4 xv = (f32x4){bflo(xw.x), bfhi(xw.x), bflo(xw.y), bfhi(xw.y)};
              const f32x4 gm = *(const LAS f32x4*)(gmt + 8 * j + 4 * hi), s4 = *(const LAS f32x4*)(sht + 8 * j + 4 * hi);
              const f32x4 hv = xv * rstd * gm + s4;
              const float w0 = wp[(size_t)(8 * j + 0) * NE], w1 = wp[(size_t)(8 * j + 1) * NE], w2 = wp[(size_t)(8 * j + 2) * NE], w3 = wp[(size_t)(8 * j + 3) * NE];
              acc = __builtin_amdgcn_mfma_f32_32x32x2f32(hv[0], w0, acc, 0, 0, 0);
              acc = __builtin_amdgcn_mfma_f32_32x32x2f32(hv[1], w1, acc, 0, 0, 0);
              acc = __builtin_amdgcn_mfma_f32_32x32x2f32(hv[2], w2, acc, 0, 0, 0);
              acc = __builtin_amdgcn_mfma_f32_32x32x2f32(hv[3], w3, acc, 0, 0, 0);
          } }
        { const float bias = br[r32];
#pragma unroll
          for (int r = 0; r < 16; ++r) lgt[((r & 3) + 8 * (r >> 2) + 4 * hi) * 33 + r32] = acc[r] + bias; }
        LDS_WAIT(); asm volatile("" ::: "memory");
        int te[4]; float tw[4]; int tr[4];
        if (lane < 32) {
            float v[32];
#pragma unroll
            for (int e = 0; e < 32; ++e) v[e] = lgt[lane * 33 + e];
            float tv[4];
#pragma unroll
            for (int k = 0; k < 4; ++k) { float best = v[0]; int bi = 0;
#pragma unroll
                for (int e = 1; e < 32; ++e) { if (v[e] > best) { best = v[e]; bi = e; } }
                tv[k] = best; te[k] = bi;
#pragma unroll
                for (int e = 0; e < 32; ++e) v[e] = (e == bi) ? -3.0e38f : v[e]; }
            const float e1 = __expf(tv[1] - tv[0]), e2 = __expf(tv[2] - tv[0]), e3 = __expf(tv[3] - tv[0]);
            const float inv = 1.0f / (1.0f + e1 + e2 + e3);
            tw[0] = inv; tw[1] = e1 * inv; tw[2] = e2 * inv; tw[3] = e3 * inv;
#pragma unroll
            for (int k = 0; k < 4; ++k) tr[k] = __hip_atomic_fetch_add(hist + te[k], 1, __ATOMIC_RELAXED, __HIP_MEMORY_SCOPE_WORKGROUP);
        }
        __syncthreads();
        if (tid < 32) basev[tid] = (int)__hip_atomic_fetch_add(cnt + tid, (unsigned)hist[tid], RLX_AGENT);
        __syncthreads();
        if (lane < 32) {
            const int row = row0 + lane;
            int4 ev = make_int4(te[0], te[1], te[2], te[3]); *(int4*)(TKE + (size_t)row * 4) = ev;
            *(f32x4*)(TKW + (size_t)row * 4) = (f32x4){tw[0], tw[1], tw[2], tw[3]};
            int4 rv = make_int4(basev[te[0]] + tr[0], basev[te[1]] + tr[1], basev[te[2]] + tr[2], basev[te[3]] + tr[3]); *(int4*)(TKR + (size_t)row * 4) = rv;
        }
        __syncthreads();
    }
}

__device__ __forceinline__ void moe_table(const Ctx& F, int l) {
    PHASE_IDS;
    LAS int* tab = (LAS int*)(F.lds + LDS_TAB);
    if (tid < 32) tab[64 + tid] = (int)__hip_atomic_load(F.ctl() + CW_CNT + l * 64 + tid, RLX_AGENT);
    __syncthreads();
    if (tid == 0) { int s = 0;
        for (int e = 0; e < 32; ++e) { tab[e] = s; s += (tab[64 + e] + MOEB - 1) / MOEB; }
        tab[32] = s; }
    __syncthreads();
}
__device__ __forceinline__ void phase_scatter(const Ctx& F, int l) {
    PHASE_IDS;
    moe_table(F, l);
    const LAS int* tab = (const LAS int*)(F.lds + LDS_TAB);
    const int* TKE = (const int*)(F.ws + WS_TKE); const float* TKW = (const float*)(F.ws + WS_TKW); const int* TKR = (const int*)(F.ws + WS_TKR);
    int* RI = (int*)(F.ws + WS_RINFO); float* RW = (float*)(F.ws + WS_RW);
    const int gt = (F.vcu * NTHREADS + tid), NGT = F.G * NTHREADS;
    for (int i = gt; i < NASSIGN; i += NGT) { const int e = TKE[i], r = TKR[i]; const int row = tab[e] * MOEB + r; RI[row] = i; RW[row] = TKW[i]; }
    for (int i = gt; i < NE * MOEB; i += NGT) { const int e = i >> 8, j = i & 255; const int c = tab[64 + e]; const int npad = (tab[e + 1] - tab[e]) * MOEB - c;
        if (j < npad) { const int row = tab[e] * MOEB + c + j; RI[row] = -1; RW[row] = 0.f; } }
}
namespace scan {
constexpr int RS_K = 272, RS_S = 144;
constexpr int O_QT = 0, O_KT = 17408, O_QH = 34816, O_KHT = 52224, O_VT = 70656, O_SS = 79872, O_ST0 = 89088, O_ST1 = 106496, O_SEG = 123904, O_DEC = 125952;
__device__ __forceinline__ bf16x8 ldfrag(const LAS unsigned char* base, int row, int rs, int kb  ) { return *(const LAS bf16x8*)(base + row * rs + kb); }
}
__device__ __forceinline__ void phase_hgrn_scan(const Ctx& F) {
    PHASE_IDS;
    using namespace scan;
    LAS unsigned char* L = F.lds;
    const bf16_t* QH_g = (const bf16_t*)(F.ws + WS_QH); const bf16_t* KK_g = (const bf16_t*)(F.ws + WS_KK); const bf16_t* VV_g = (const bf16_t*)(F.ws + WS_VV);
    const float* LF_g = (const float*)(F.ws + WS_LF); bf16_t* OO_g = (bf16_t*)(F.ws + WS_OO);
    const int w = wave, l15 = lane & 15, l4 = lane >> 4;
    const int cg = lane & 3, seg = lane >> 2, kc0 = 16 * w + 4 * cg;
    const int vs = tid >> 3, vc = (tid & 7) * 8;
    LAS float* DEC = (LAS float*)(L + O_DEC);
    for (int u = F.vcu; u < NB * HGH * 2; u += F.G) {
        const int vh = u & 1, h = (u >> 1) & 7, b = u >> 4;
        const size_t rowb = (size_t)b * SEQ; const int hk = h * HGD, hv = h * HGD + vh * 64;
        for (int i = tid; i < 64 * RS_K / 16; i += NTHREADS) *(LAS u32x4*)(L + O_ST0 + i * 16) = (u32x4){0u, 0u, 0u, 0u};
        f32x4 sacc[4];
#pragma unroll
        for (int vi = 0; vi < 4; ++vi) sacc[vi] = (f32x4){0.f, 0.f, 0.f, 0.f};
        f32x4 lfr[4]; u32x2 qr[4], kr[4]; u32x4 vw;
#define SCAN_LOAD(c_) do { const size_t base_ = (rowb + (size_t)(c_) * HGC + 4 * seg) * D + hk + kc0; \
            _Pragma("unroll") for (int i = 0; i < 4; ++i) { lfr[i] = *(const f32x4*)(LF_g + base_ + (size_t)i * D); qr[i] = *(const u32x2*)(QH_g + base_ + (size_t)i * D); kr[i] = *(const u32x2*)(KK_g + base_ + (size_t)i * D); } \
            vw = *(const u32x4*)(VV_g + (rowb + (size_t)(c_) * HGC + vs) * D + hv + vc); } while (0)
        SCAN_LOAD(0);
        __syncthreads();
        for (int c = 0; c < SEQ / HGC; ++c) {
            const size_t r0 = rowb + (size_t)c * HGC;
            const LAS unsigned char* STc = L + ((c & 1) ? O_ST1 : O_ST0); LAS unsigned char* STn = L + ((c & 1) ? O_ST0 : O_ST1);
            { float cs[4][4], I[4];
#pragma unroll
              for (int j = 0; j < 4; ++j) { float run = 0.f;
#pragma unroll
                  for (int i = 0; i < 4; ++i) { run += lfr[i][j]; cs[i][j] = run; }
                  float x = run;
#pragma unroll
                  for (int d = 4; d < 64; d <<= 1) { const float y = __shfl_up(x, d); if (lane >= d) x += y; }
                  I[j] = x; }
              float qv[4][4], kv[4][4];
#pragma unroll
              for (int i = 0; i < 4; ++i) { qv[i][0] = bflo(qr[i].x); qv[i][1] = bfhi(qr[i].x); qv[i][2] = bflo(qr[i].y); qv[i][3] = bfhi(qr[i].y);
                  kv[i][0] = bflo(kr[i].x); kv[i][1] = bfhi(kr[i].x); kv[i][2] = bflo(kr[i].y); kv[i][3] = bfhi(kr[i].y); }
              float qt[4][4], kt[4][4], qh[4][4], kh[4][4];
#pragma unroll
              for (int j = 0; j < 4; ++j) { const float ref = __shfl(I[j], cg + 28), last = __shfl(I[j], cg + 60), P = I[j] - cs[3][j];
                  const float eref = __expf(ref), elr = __expf(last - ref);
                  if (seg == 0) DEC[kc0 + j] = eref * elr;
#pragma unroll
                  for (int i = 0; i < 4; ++i) { const float d = fminf(fmaxf(P + cs[i][j] - ref, -60.f), 60.f); const float E = __expf(d), R = __builtin_amdgcn_rcpf(E);
                      qt[i][j] = qv[i][j] * E; kt[i][j] = kv[i][j] * R; qh[i][j] = qt[i][j] * eref; kh[i][j] = kt[i][j] * elr; } }
#pragma unroll
              for (int i = 0; i < 4; ++i) { const int ro = (4 * seg + i) * RS_K + kc0 * 2; u32x2 o;
                  o.x = cvt_pk_bf16(qt[i][0], qt[i][1]); o.y = cvt_pk_bf16(qt[i][2], qt[i][3]); *(LAS u32x2*)(L + O_QT + ro) = o;
                  o.x = cvt_pk_bf16(kt[i][0], kt[i][1]); o.y = cvt_pk_bf16(kt[i][2], kt[i][3]); *(LAS u32x2*)(L + O_KT + ro) = o;
                  o.x = cvt_pk_bf16(qh[i][0], qh[i][1]); o.y = cvt_pk_bf16(qh[i][2], qh[i][3]); *(LAS u32x2*)(L + O_QH + ro) = o; }
#pragma unroll
              for (int j = 0; j < 4; ++j) { u32x2 o; o.x = cvt_pk_bf16(kh[0][j], kh[1][j]); o.y = cvt_pk_bf16(kh[2][j], kh[3][j]); *(LAS u32x2*)(L + O_KHT + (kc0 + j) * RS_S + seg * 8) = o; }
              LAS unsigned short* vt = (LAS unsigned short*)(L + O_VT) + vc * (RS_S / 2) + vs;
              vt[0 * (RS_S / 2)] = (unsigned short)(vw.x & 0xffffu); vt[1 * (RS_S / 2)] = (unsigned short)(vw.x >> 16);
              vt[2 * (RS_S / 2)] = (unsigned short)(vw.y & 0xffffu); vt[3 * (RS_S / 2)] = (unsigned short)(vw.y >> 16);
              vt[4 * (RS_S / 2)] = (unsigned short)(vw.z & 0xffffu); vt[5 * (RS_S / 2)] = (unsigned short)(vw.z >> 16);
              vt[6 * (RS_S / 2)] = (unsigned short)(vw.w & 0xffffu); vt[7 * (RS_S / 2)] = (unsigned short)(vw.w >> 16); }
            if (c + 1 < SEQ / HGC) SCAN_LOAD(c + 1);
            __syncthreads();
#pragma unroll
            for (int q = 0; q < 2; ++q) { const int id = 2 * w + q, si = id >> 2, ti = id & 3;
                f32x4 a = (f32x4){0.f, 0.f, 0.f, 0.f};
                if (si <= ti) {
#pragma unroll
                    for (int ks = 0; ks < 4; ++ks) a = __builtin_amdgcn_mfma_f32_16x16x32_bf16(ldfrag(L + O_KT, si * 16 + l15, RS_K, ks * 64 + l4 * 16), ldfrag(L + O_QT, ti * 16 + l15, RS_K, ks * 64 + l4 * 16), a, 0, 0, 0);
                }
                const int t = ti * 16 + l15, s0 = si * 16 + l4 * 4;
#pragma unroll
                for (int r = 0; r < 4; ++r) a[r] = (s0 + r <= t) ? a[r] : 0.f;
                u32x2 o; o.x = cvt_pk_bf16(a[0], a[1]); o.y = cvt_pk_bf16(a[2], a[3]);
                *(LAS u32x2*)(L + O_SS + t * RS_S + s0 * 2) = o; }
            __syncthreads();
#pragma unroll
            for (int q = 0; q < 2; ++q) { const int id = 2 * w + q, vi = id >> 2, ti = id & 3;
                f32x4 a = (f32x4){0.f, 0.f, 0.f, 0.f};
#pragma unroll
                for (int ks = 0; ks < 2; ++ks) a = __builtin_amdgcn_mfma_f32_16x16x32_bf16(ldfrag(L + O_VT, vi * 16 + l15, RS_S, ks * 64 + l4 * 16), ldfrag(L + O_SS, ti * 16 + l15, RS_S, ks * 64 + l4 * 16), a, 0, 0, 0);
#pragma unroll
                for (int ks = 0; ks < 4; ++ks) a = __builtin_amdgcn_mfma_f32_16x16x32_bf16(ldfrag(STc, vi * 16 + l15, RS_K, ks * 64 + l4 * 16), ldfrag(L + O_QH, ti * 16 + l15, RS_K, ks * 64 + l4 * 16), a, 0, 0, 0);
                const int t = ti * 16 + l15, v0 = vi * 16 + l4 * 4;
                u32x2 o; o.x = cvt_pk_bf16(a[0], a[1]); o.y = cvt_pk_bf16(a[2], a[3]);
                *(u32x2*)(OO_g + (r0 + t) * D + hv + v0) = o; }
            { const f32x4 dec = *(const LAS f32x4*)(DEC + w * 16 + l4 * 4);
              const bf16x8 ka0 = ldfrag(L + O_KHT, w * 16 + l15, RS_S, l4 * 16), ka1 = ldfrag(L + O_KHT, w * 16 + l15, RS_S, 64 + l4 * 16);
#pragma unroll
              for (int vi = 0; vi < 4; ++vi) { f32x4 a = sacc[vi] * dec;
                  a = __builtin_amdgcn_mfma_f32_16x16x32_bf16(ka0, ldfrag(L + O_VT, vi * 16 + l15, RS_S, l4 * 16), a, 0, 0, 0);
                  a = __builtin_amdgcn_mfma_f32_16x16x32_bf16(ka1, ldfrag(L + O_VT, vi * 16 + l15, RS_S, 64 + l4 * 16), a, 0, 0, 0);
                  sacc[vi] = a;
                  u32x2 o; o.x = cvt_pk_bf16(a[0], a[1]); o.y = cvt_pk_bf16(a[2], a[3]);
                  *(LAS u32x2*)(STn + (vi * 16 + l15) * RS_K + (w * 16 + l4 * 4) * 2) = o; } }
            __syncthreads();
        }
#undef SCAN_LOAD
    }
}
namespace mla {
constexpr int QBLK = 32, KVBLK = 64, QB = 256;
constexpr int SHM_V = KVBLK * VD * 2  , SHM_K = KVBLK * QK * 2  ;
constexpr int O_V = 0, O_K = 2 * SHM_V, O_WS = 2 * SHM_V + 2 * SHM_K;
constexpr float SCALE = 0.07216878364870322f;
#define KSWZ192(row, colB) ((row) * 384 + ((colB) ^ (((row) & 7) << 4)))
#define SBAR() __builtin_amdgcn_sched_barrier(0)
__device__ __forceinline__ int v_st(int k, int c) { const int kk = (k & ~0xC) | ((k & 4) << 1) | ((k & 8) >> 1); return ((kk >> 3) * 4 + (c >> 5)) * 512 + ((kk & 7) * 32 + (c & 31)) * 2; }
__device__ __forceinline__ int v_rd_base(int lane) { return ((lane & 3) << 3) | (((lane >> 2) & 3) << 6) | (((lane >> 4) & 1) << 5) | (((lane >> 5) & 1) << 8); }
constexpr int v_rd_off(int d0, int ks, int half) { return d0 * 512 + ks * 4096 + half * 2048; }
__device__ __forceinline__ int crow(int r, int hi) { return (r & 3) + 8 * (r >> 2) + 4 * hi; }
__device__ __forceinline__ void mask_tile(f32x16& p0, f32x16& p1, int dq) {
    const float NEG = -__builtin_inff();
#pragma unroll
    for (int r = 0; r < 16; ++r) { const int c = (r & 3) + 8 * (r >> 2); if (dq - c < 0) p0[r] = NEG; if (dq - c - 32 < 0) p1[r] = NEG; }
}
__device__ __forceinline__ void partialSM(f32x16& p0, f32x16& p1, float& m_reg, float& mn, float& alpha) {
    float pmax = p0[0];
#pragma unroll
    for (int r = 1; r < 16; ++r) pmax = fmaxf(pmax, p0[r]);
#pragma unroll
    for (int r = 0; r < 16; ++r) pmax = fmaxf(pmax, p1[r]);
    { auto rr = __builtin_amdgcn_permlane32_swap(__float_as_uint(pmax), __float_as_uint(pmax), false, false);
      pmax = fmaxf(__uint_as_float(rr[0]), __uint_as_float(rr[1])); }
    constexpr float C2 = 1.4426950408889634f * SCALE;
    constexpr float THR = 8.f;
    if (__builtin_expect(__all((pmax - m_reg) * SCALE <= THR), 1)) { mn = m_reg; alpha = 1.f; }
    else { mn = fmaxf(m_reg, pmax); alpha = __builtin_amdgcn_exp2f((m_reg - mn) * C2); m_reg = mn; }
    const float mnL = -mn * C2;
#pragma unroll
    for (int r = 0; r < 16; ++r) p0[r] = fmaf(p0[r], C2, mnL);
#pragma unroll
    for (int r = 0; r < 16; ++r) p1[r] = fmaf(p1[r], C2, mnL);
#pragma unroll
    for (int r = 0; r < 16; ++r) p0[r] = __builtin_amdgcn_exp2f(p0[r]);
}
__device__ __forceinline__ void finishSM(f32x16& p0, f32x16& p1, float alpha, float& l_reg, bf16x8& pa0, bf16x8& pa1, bf16x8& pa2, bf16x8& pa3) {
#pragma unroll
    for (int r = 0; r < 16; ++r) p1[r] = __builtin_amdgcn_exp2f(p1[r]);
    float ps = 0;
#pragma unroll
    for (int r = 0; r < 16; ++r) ps += p0[r];
#pragma unroll
    for (int r = 0; r < 16; ++r) ps += p1[r];
    { auto rr = __builtin_amdgcn_permlane32_swap(__float_as_uint(ps), __float_as_uint(ps), false, false);
      ps = __uint_as_float(rr[0]) + __uint_as_float(rr[1]); }
    l_reg = l_reg * alpha + ps;
#define PK4(P, B_, OUT) do { unsigned a0 = cvt_pk_bf16(P[B_+0], P[B_+1]), a1 = cvt_pk_bf16(P[B_+2], P[B_+3]);                          \
        unsigned b0 = cvt_pk_bf16(P[B_+4], P[B_+5]), b1 = cvt_pk_bf16(P[B_+6], P[B_+7]);                                             \
        auto r0 = __builtin_amdgcn_permlane32_swap(a0, b0, false, false); auto r1 = __builtin_amdgcn_permlane32_swap(a1, b1, false, false); \
        u32x4 w = {r0[0], r1[0], r0[1], r1[1]}; OUT = *reinterpret_cast<bf16x8*>(&w); } while (0)
    PK4(p0, 0, pa0); PK4(p0, 8, pa1); PK4(p1, 0, pa2); PK4(p1, 8, pa3);
#undef PK4
}
template <int KB>
__device__ __forceinline__ void qkt(f32x16& p0, f32x16& p1, const LAS unsigned char* K_lds, int r32, int hi, const bf16x8* qr) {
    p0 = f32x16{}; p1 = f32x16{};
    const LAS unsigned char* kb[4];
#pragma unroll
    for (int dd = 0; dd < 4; ++dd) kb[dd] = K_lds + KB * SHM_K + KSWZ192(r32, (dd * 16 + hi * 8) * 2);
#pragma unroll
    for (int g = 0; g < 3; ++g) {
        bf16x8 b0[4], b1[4];
#pragma unroll
        for (int dd = 0; dd < 4; ++dd) { const LAS unsigned char* a = kb[dd] + g * 128;
            b0[dd] = *reinterpret_cast<const LAS bf16x8*>(a); b1[dd] = *reinterpret_cast<const LAS bf16x8*>(a + 32 * 384); }
#pragma unroll
        for (int dd = 0; dd < 4; ++dd) {
            p0 = __builtin_amdgcn_mfma_f32_32x32x16_bf16(b0[dd], qr[4 * g + dd], p0, 0, 0, 0);
            p1 = __builtin_amdgcn_mfma_f32_32x32x16_bf16(b1[dd], qr[4 * g + dd], p1, 0, 0, 0); }
        SBAR();
    }
}
template <int VB>
__device__ __forceinline__ void pv_tile(f32x16* o, int vb0, bf16x8 pa0, bf16x8 pa1, bf16x8 pa2, bf16x8 pa3) {
#define TRRD(dst, off) asm volatile("ds_read_b64_tr_b16 %0, %1 offset:%2" : "=&v"(dst) : "v"(vb0), "i"(off) : "memory")
#define PV_D0(d0) do { s16x4 l0, l1, l2, l3, h0, h1, h2, h3; constexpr int b_ = VB * SHM_V + v_rd_off(d0, 0, 0); \
        TRRD(l0, b_); TRRD(h0, b_ + 2048); TRRD(l1, b_ + 4096); TRRD(h1, b_ + 6144); TRRD(l2, b_ + 8192); TRRD(h2, b_ + 10240); TRRD(l3, b_ + 12288); TRRD(h3, b_ + 14336); \
        asm volatile("s_waitcnt lgkmcnt(0)" ::: "memory"); SBAR(); \
        o[d0] = __builtin_amdgcn_mfma_f32_32x32x16_bf16(pa0, (bf16x8){l0[0], l0[1], l0[2], l0[3], h0[0], h0[1], h0[2], h0[3]}, o[d0], 0, 0, 0);   \
        o[d0] = __builtin_amdgcn_mfma_f32_32x32x16_bf16(pa1, (bf16x8){l1[0], l1[1], l1[2], l1[3], h1[0], h1[1], h1[2], h1[3]}, o[d0], 0, 0, 0);   \
        o[d0] = __builtin_amdgcn_mfma_f32_32x32x16_bf16(pa2, (bf16x8){l2[0], l2[1], l2[2], l2[3], h2[0], h2[1], h2[2], h2[3]}, o[d0], 0, 0, 0);   \
        o[d0] = __builtin_amdgcn_mfma_f32_32x32x16_bf16(pa3, (bf16x8){l3[0], l3[1], l3[2], l3[3], h3[0], h3[1], h3[2], h3[3]}, o[d0], 0, 0, 0); } while (0)
    PV_D0(0); PV_D0(1); PV_D0(2); PV_D0(3);
#undef PV_D0
#undef TRRD
}
}

__device__ __forceinline__ void attn_block(const Ctx& F, int b, int h, int qb) {
    using namespace mla;
    PHASE_IDS;
    LAS unsigned char* L = F.lds;
    const bf16_t* Qg = (const bf16_t*)(F.ws + WS_QB); const bf16_t* Kg = (const bf16_t*)(F.ws + WS_KB); const bf16_t* Vg = (const bf16_t*)(F.ws + WS_VB); bf16_t* Og = (bf16_t*)(F.ws + WS_AO);
    const int wid = wave, r32 = lane & 31, hi = lane >> 5;
    const size_t rowb = (size_t)b * SEQ; const int P0 = qb * QB;
    const int NT = (P0 + QB) / KVBLK;
    LAS unsigned char* V_lds = L + O_V; LAS unsigned char* K_lds = L + O_K;
    LAS float* wsf = (LAS float*)(L + O_WS) + wid * 64; LAS float* li_l = wsf; LAS float* al_l = wsf + 32;
    const bf16_t* Kh = Kg + rowb * (MH * QK) + h * QK; const bf16_t* Vh = Vg + rowb * D + h * VD;
    unsigned koff[3], voff[2];
#pragma unroll
    for (int i = 0; i < 3; ++i) { const int p = (wid + 8 * i) * 64 + lane, row = p / 24, cs = p - row * 24, ch = cs ^ (row & 7); koff[i] = (unsigned)(row * (MH * QK) + ch * 8) * 2u; }
#pragma unroll
    for (int i = 0; i < 2; ++i) { const int p = (wid + 8 * i) * 64 + lane, sub = p >> 5, r = p & 31, kk = (sub >> 2) * 8 + (r >> 2), k = (kk & ~0xC) | ((kk & 4) << 1) | ((kk & 8) >> 1), c = (sub & 3) * 32 + (r & 3) * 8;
        voff[i] = (unsigned)(k * D + c) * 2u; }
    const int vb0 = (int)(uintptr_t)V_lds + v_rd_base(lane);
    bf16x8 qr[12];
    { const bf16_t* qp = Qg + (rowb + P0 + wid * QBLK + r32) * (MH * QK) + h * QK + hi * 8;
#pragma unroll
      for (int d0 = 0; d0 < 12; ++d0) qr[d0] = *(const bf16x8*)(qp + d0 * 16); }
#define DMA(t, bf) do { const char* kp_ = (const char*)(Kh + (size_t)(t) * KVBLK * (MH * QK)); const char* vp_ = (const char*)(Vh + (size_t)(t) * KVBLK * D); \
        _Pragma("unroll") for (int i_ = 0; i_ < 3; ++i_) glds16s(kp_, koff[i_], klds0 + (bf) * SHM_K + (wid + 8 * i_) * 1024); \
        _Pragma("unroll") for (int i_ = 0; i_ < 2; ++i_) glds16s(vp_, voff[i_], vlds0 + (bf) * SHM_V + (wid + 8 * i_) * 1024); } while (0)
    const unsigned klds0 = (unsigned)(uintptr_t)K_lds, vlds0 = (unsigned)(uintptr_t)V_lds;
    DMA(0, 0); VM_WAIT();
    __syncthreads();
    float m_reg = -1e30f, l_reg = 0.f, mn, alpha; f32x16 o[4] = {}; f32x16 p0, p1; bf16x8 pa0, pa1, pa2, pa3;
    const int qlo = P0 + wid * QBLK, qm = qlo + r32 - 4 * hi;
#define RESC(a) do { if (__any((a) < 1.f)) { if (hi == 0) al_l[r32] = (a); LDS_WAIT(); \
        _Pragma("unroll") for (int d_ = 0; d_ < 4; ++d_) _Pragma("unroll") for (int r = 0; r < 16; ++r) o[d_][r] *= al_l[crow(r, hi)]; } } while (0)
#define STEP(t, CB) do { \
        if ((t) + 1 < NT) DMA((t) + 1, 1 - (CB)); \
        SBAR(); qkt<CB>(p0, p1, K_lds, r32, hi, qr); \
        { const int kb_ = (t) * KVBLK; if (kb_ + KVBLK - 1 > qlo) mask_tile(p0, p1, qm - kb_); } \
        partialSM(p0, p1, m_reg, mn, alpha); \
        finishSM(p0, p1, alpha, l_reg, pa0, pa1, pa2, pa3); SBAR(); \
        RESC(alpha); \
        pv_tile<CB>(o, vb0, pa0, pa1, pa2, pa3); \
        VM_WAIT(); \
        __syncthreads(); } while (0)
    for (int t = 0; t < NT; t += 2) { STEP(t, 0); STEP(t + 1, 1); }
    if (hi == 0) li_l[r32] = l_reg; LDS_WAIT();
    float rli[16];
#pragma unroll
    for (int r = 0; r < 16; ++r) rli[r] = __builtin_amdgcn_rcpf(li_l[crow(r, hi)]);
    bf16_t* Ow = Og + (rowb + P0 + wid * QBLK) * D + h * VD;
#pragma unroll
    for (int r = 0; r < 16; ++r) { const int orow = crow(r, hi);
#pragma unroll
        for (int d0 = 0; d0 < 4; ++d0) { const float v = o[d0][r] * rli[r]; const float vn = __shfl_xor(v, 1);
            if ((r32 & 1) == 0) *(unsigned*)(Ow + (size_t)orow * D + d0 * 32 + r32) = cvt_pk_bf16(v, vn); } }
    __syncthreads();
#undef DMA
#undef RESC
#undef STEP
}
__device__ __forceinline__ void phase_attn(const Ctx& F) {
    constexpr int NQB = SEQ / 256, NITEM = NB * MH * (NQB / 2);
    for (int L = F.vcu; L < NITEM; L += F.G) {
        const int bh = L / (NQB / 2), x = L - bh * (NQB / 2);
        attn_block(F, bh / MH, bh % MH, NQB - 1 - x);
        attn_block(F, bh / MH, bh % MH, x);
    }
}
constexpr int NP = 13, NSTEPS = 2 + DEPTH * NP;
__host__ __device__ constexpr bool step_applies(int st) {
    if (st < 2) return true;
    const int l = (st - 2) / NP, p = (st - 2) % NP;
    if (p == 3) return l >= NA;
    if (p >= 10) return l == NA - 1;
    return true;
}
struct Args { const float* in[28]; float* out; unsigned char* ws; int lo, hi, final_only, pad; };

__global__ void __launch_bounds__(NTHREADS, 2) fwd_kernel(Args args) {
    extern __shared__ __attribute__((aligned(16))) unsigned char lds_raw[];
    Ctx F;
    F.lds = (LAS unsigned char*)lds_raw;
    F.G = gridDim.x; { const int bx = blockIdx.x; F.vcu = (F.G % 8 == 0) ? (bx % 8) * (F.G / 8) + bx / 8 : bx; }
#pragma unroll
    for (int i = 0; i < 28; ++i) F.in[i] = args.in[i];
    F.out = args.out; F.ws = args.ws;
    volatile LAS unsigned* MISC = (volatile LAS unsigned*)(F.lds + LDS_MISC);
    if (threadIdx.x < 64) MISC[threadIdx.x] = 0u;
    __syncthreads();
    XcdBarrier bar; bar.bar = F.ctl() + CW_BAR; bar.x = 0; bar.st = nullptr;
#if MK_ONE_LAUNCH
    bar = xcd_barrier_post(F.ctl() + CW_BAR, MISC);
#endif
    const int lo = args.lo, hi = args.hi;
    bool did = false;
#if MK_ONE_LAUNCH
#define PHASE_BEGIN(st) if ((st) >= lo && (st) < hi) { if (did) xcd_barrier(bar); did = true;
#else
#define PHASE_BEGIN(st) if ((st) >= lo && (st) < hi) { did = true;
#endif
#define PHASE_END }

    if (args.final_only) { phase_final_only(F, args.final_only == 1); return; }

    PHASE_BEGIN(0) phase_mod(F); __syncthreads(); phase_convert(F); PHASE_END
    PHASE_BEGIN(1) phase_combine(F, -1); PHASE_END

    for (int l = 0; l < DEPTH; ++l) {
        const int sb = 2 + l * NP;
        if (l < NA) {
            PHASE_BEGIN(sb + 0) {
                pg8::PlainSched S; S.init(T, 4096, F.G, (int)blockIdx.x); S.Bt = (const char*)(F.ws + WS_WIN) + (size_t)l * 4096 * 1024 * 2; S.K = 2048;
                pg8::EpiHgrnIn E{(bf16_t*)(F.ws + WS_QH), (float*)(F.ws + WS_LF), (const float*)(F.ws + WS_LB) + (size_t)l * D};
                pg8::gemm_phase<false>(F.lds, (const char*)(F.ws + WS_H), 2048, S, E); }
            PHASE_END
            PHASE_BEGIN(sb + 1) phase_hgrn_scan(F); PHASE_END
            PHASE_BEGIN(sb + 2) phase_hgrn_gate(F, l); PHASE_END
        } else {
            const int j = l - NA;
            PHASE_BEGIN(sb + 0) {
                pg8::PlainSched S; S.init(T, 512, F.G, (int)blockIdx.x); S.Bt = (const char*)(F.ws + WS_WDQ) + (size_t)j * 512 * 1024 * 2; S.K = 2048;
                pg8::EpiPlainBf16 E{(bf16_t*)(F.ws + WS_CQ), 512};
                pg8::gemm_phase<false>(F.lds, (const char*)(F.ws + WS_H), 2048, S, E); }
            PHASE_END
            PHASE_BEGIN(sb + 1) phase_cq_rows(F, j); PHASE_END
            PHASE_BEGIN(sb + 2) {
                pg8::PlainSched S; S.init(T, 1536, F.G, (int)blockIdx.x); S.Bt = (const char*)(F.ws + WS_WUQ) + (size_t)j * 1536 * 384 * 2; S.K = 768;
                pg8::EpiQUp E{(bf16_t*)(F.ws + WS_QB), (const float*)(F.ws + WS_ROPE)};
                pg8::gemm_phase<false>(F.lds, (const char*)(F.ws + WS_CQN), 768, S, E); }
            PHASE_END
            PHASE_BEGIN(sb + 3) phase_attn(F); PHASE_END
        }
        PHASE_BEGIN(sb + 4) {
            pg8::PlainSched S; S.init(T, 1024, F.G, (int)blockIdx.x); S.K = 2048;
            S.Bt = (l < NA) ? (const char*)(F.ws + WS_WOUT) + (size_t)l * 1024 * 1024 * 2 : (const char*)(F.ws + WS_WO) + (size_t)(l - NA) * 1024 * 1024 * 2;
            const char* A = (l < NA) ? (const char*)(F.ws + WS_OG) : (const char*)(F.ws + WS_AO);
            pg8::EpiResid E{l == 0 ? F.in[0] : nullptr, (bf16_t*)(F.ws + WS_XB), modp(F, l, 0, 2), 6 * D};
            pg8::gemm_phase<false>(F.lds, A, 2048, S, E); }
        PHASE_END
        PHASE_BEGIN(sb + 5) phase_router(F, l, args.pad != 0); PHASE_END
        PHASE_BEGIN(sb + 6) phase_scatter(F, l); PHASE_END
        PHASE_BEGIN(sb + 7) {
            moe_table(F, l);
            pg8::MoeSched<true> S{(const LAS int*)(F.lds + LDS_TAB), 8, F.G, F.vcu, (const char*)(F.ws + WS_WGU) + (size_t)l * NE * 2048 * 1024, (size_t)2048 * 1024, 1024, (const int*)(F.ws + WS_RINFO)};
            pg8::EpiMoeGU E{(unsigned char*)(F.ws + WS_ACT), F.in[24] + (size_t)l * NE * 2048};
            pg8::gemm_phase<true>(F.lds, (const char*)(F.ws + WS_H), 1024, S, E); }
        PHASE_END
        PHASE_BEGIN(sb + 8) {
            moe_table(F, l);
            pg8::MoeSched<false> S{(const LAS int*)(F.lds + LDS_TAB), 4, F.G, F.vcu, (const char*)(F.ws + WS_WDN) + (size_t)l * NE * 1024 * 1024, (size_t)1024 * 1024, 1024, nullptr};
            pg8::EpiMoeDN E{(bf16_t*)(F.ws + WS_YS), F.in[26] + (size_t)l * NE * 1024, (const int*)(F.ws + WS_RINFO), (const float*)(F.ws + WS_RW)};
            pg8::gemm_phase<true>(F.lds, (const char*)(F.ws + WS_ACT), 1024, S, E); }
        PHASE_END
        PHASE_BEGIN(sb + 9) phase_combine(F, l, args.pad != 0); PHASE_END
        if (l == NA - 1) {
            PHASE_BEGIN(sb + 10) {
                pg8::PlainSched S; S.init(T, 512, F.G, (int)blockIdx.x); S.Bt = (const char*)(F.ws + WS_WDKV); S.K = 2048;
                pg8::EpiPlainBf16 E{(bf16_t*)(F.ws + WS_CKR), 512};
                pg8::gemm_phase<false>(F.lds, (const char*)(F.ws + WS_HK), 2048, S, E); }
            PHASE_END
            PHASE_BEGIN(sb + 11) phase_kv_rows(F); PHASE_END
            PHASE_BEGIN(sb + 12) {
                pg8::PlainSched S; S.init(T, 2048, F.G, (int)blockIdx.x); S.Bt = (const char*)(F.ws + WS_WUKV); S.K = 512;
                pg8::EpiKvUp E{(bf16_t*)(F.ws + WS_KB), (bf16_t*)(F.ws + WS_VB)};
                pg8::gemm_phase<false>(F.lds, (const char*)(F.ws + WS_CKV), 512, S, E); }
            PHASE_END
        }
    }
#undef PHASE_BEGIN
#undef PHASE_END
}

extern "C" void kernel_launch(void* const* d_in, const int* in_sizes, int n_in, void* d_out, int out_size, void* d_ws, size_t ws_size, hipStream_t stream) {
    static int grid = 0;
    if (grid == 0) {
        if (n_in != 28 || in_sizes[0] != T * D || out_size != T * D || ws_size < WS_END) {
            fprintf(stderr, "kernel_launch: shape mismatch: n_in %d in0 %d out %d ws %zu (need %zu)\n", n_in, n_in > 0 ? in_sizes[0] : -1, out_size, ws_size, (size_t)WS_END); grid = -1; return; }
        int dev = 0, cus = 0, per_cu = 0;
        if (hipGetDevice(&dev) != hipSuccess || hipDeviceGetAttribute(&cus, hipDeviceAttributeMultiprocessorCount, dev) != hipSuccess) { fprintf(stderr, "kernel_launch: device query failed\n"); grid = -1; return; }
        if (hipFuncSetAttribute((const void*)fwd_kernel, hipFuncAttributeMaxDynamicSharedMemorySize, LDS_BYTES) != hipSuccess) { fprintf(stderr, "kernel_launch: hipFuncSetAttribute failed\n"); grid = -1; return; }
        if (hipOccupancyMaxActiveBlocksPerMultiprocessor(&per_cu, (const void*)fwd_kernel, NTHREADS, LDS_BYTES) != hipSuccess || per_cu < 1)
            fprintf(stderr, "kernel_launch: note: occupancy query reports %d workgroups per CU\n", per_cu);
        (void)hipGetLastError();
        grid = cus;
    }
    if (grid < 0) return;
    if (hipMemsetAsync((char*)d_ws + WS_CTL, 0, CTL_ZERO_BYTES, stream) != hipSuccess) { fprintf(stderr, "kernel_launch: memset failed\n"); return; }
    Args a{};
    for (int i = 0; i < 28; ++i) a.in[i] = (const float*)d_in[i];
    a.out = (float*)d_out; a.ws = (unsigned char*)d_ws; a.final_only = 0; a.pad = 0;
    constexpr int LAST = (MK_LAST_STEP < NSTEPS) ? MK_LAST_STEP : NSTEPS;
#if MK_ONE_LAUNCH
    a.lo = 0; a.hi = LAST;
    hipLaunchKernelGGL(fwd_kernel, dim3(grid), dim3(NTHREADS), LDS_BYTES, stream, a);
#else
    for (int st = 0; st < LAST; ++st) { if (!step_applies(st)) continue;
#ifdef MK_SKIP_LO
        if (st >= MK_SKIP_LO && st < MK_SKIP_HI) continue;
#endif
        a.lo = st; a.hi = st + 1;
        hipLaunchKernelGGL(fwd_kernel, dim3(grid), dim3(NTHREADS), LDS_BYTES, stream, a);
#ifdef MK_REPEAT_LO
        if (st >= MK_REPEAT_LO && st < MK_REPEAT_HI) { a.pad = 1; hipLaunchKernelGGL(fwd_kernel, dim3(grid), dim3(NTHREADS), LDS_BYTES, stream, a); a.pad = 0; }
#endif
    }
#endif
    if (LAST < NSTEPS) {
        a.lo = 0; a.hi = 0; a.final_only = (LAST <= 2 + 4) ? 1 : 2;
        hipLaunchKernelGGL(fwd_kernel, dim3(grid), dim3(NTHREADS), LDS_BYTES, stream, a);
    }
    const hipError_t le = hipPeekAtLastError();
    if (le != hipSuccess) fprintf(stderr, "kernel_launch: launch failed: %s\n", hipGetErrorName(le));
}
```

```cpp
#define MK_ONE_LAUNCH 1
#define MK_LAST_STEP 9999
#include <hip/hip_runtime.h>
#include <cstdio>
#include <cstdint>

#ifndef MK_ONE_LAUNCH
#define MK_ONE_LAUNCH 1
#endif
#ifndef MK_LAST_STEP
#define MK_LAST_STEP 9999
#endif

#define GAS __attribute__((address_space(1)))
#define LAS __attribute__((address_space(3)))
typedef unsigned short bf16_t;
typedef short bf16x8 __attribute__((ext_vector_type(8)));
typedef short s16x4 __attribute__((ext_vector_type(4)));
typedef float f32x4 __attribute__((ext_vector_type(4)));
typedef float f32x2 __attribute__((ext_vector_type(2)));
typedef float f32x16 __attribute__((ext_vector_type(16)));
typedef unsigned u32x4 __attribute__((ext_vector_type(4)));
typedef unsigned u32x2 __attribute__((ext_vector_type(2)));

constexpr int NB = 16, SEQ = 4096, D = 1024, T = NB * SEQ;
constexpr int DEPTH = 4, NA = 2;
constexpr int HGH = 8, HGD = 128, HGC = 64;
constexpr int MH = 8, NOPE = 128, ROPE = 64, VD = 128, QK = NOPE + ROPE;
constexpr int QRANK = 384, KVRANK = 256;
constexpr int NE = 32, TOPK = 4, FF = 1024, MOEB = 256;
constexpr int NASSIGN = T * TOPK;
constexpr int NROWS_MAX = NASSIGN + NE * MOEB;
constexpr int NBLK_MAX = NROWS_MAX / MOEB;
constexpr float NORM_EPS = 1e-6f;
constexpr float SWIGLU_LIMIT = 7.0f, SWIGLU_ALPHA = 1.702f;
constexpr int NWAVES = 8, NTHREADS = 512;

constexpr size_t MiB = 1u << 20;
constexpr size_t al256(size_t x) { return (x + 255) & ~(size_t)255; }
constexpr size_t WS_CTL = 0, CTL_ZERO_BYTES = 1 * MiB;
constexpr int CW_BAR = 4096;
constexpr int CW_CNT = 16384;
constexpr size_t WS_MOD   = 1 * MiB;
constexpr size_t WS_KVMOD = WS_MOD + al256((size_t)DEPTH * NB * 6 * D * 4);
constexpr size_t WS_LB    = WS_KVMOD + al256((size_t)NB * 2 * D * 4);
constexpr size_t WS_ROPE  = WS_LB + al256((size_t)NA * D * 4);
constexpr size_t WS_TKE   = WS_ROPE + al256((size_t)T * 64 * 4);
constexpr size_t WS_TKW   = WS_TKE + al256((size_t)T * 4 * 4);
constexpr size_t WS_TKR   = WS_TKW + al256((size_t)T * 4 * 4);
constexpr int VCAP = T;
constexpr size_t WS_RINFO = WS_TKR + al256((size_t)T * 4 * 4);
constexpr size_t WS_RW    = WS_RINFO + al256((size_t)NE * VCAP * 4);
constexpr size_t WS_WR    = al256(WS_RW + (size_t)NE * VCAP * 4 + MiB);
constexpr size_t WS_WIN   = al256(WS_WR + (size_t)DEPTH * 131072);
constexpr size_t WS_WINF  = WS_WIN + (size_t)NA * 3072 * 1024;
constexpr size_t WS_WOUT  = WS_WIN + (size_t)NA * 4096 * 1024 * 2;
constexpr size_t WS_WDKV  = WS_WOUT + (size_t)NA * 1024 * 1024 * 2;
constexpr size_t WS_WUKV  = WS_WDKV + (size_t)512 * 1024 * 2;
constexpr size_t WS_WDQ   = WS_WUKV + (size_t)2048 * 256 * 2;
constexpr size_t WS_WUQ   = WS_WDQ + (size_t)2 * 512 * 1024 * 2;
constexpr size_t WS_WO    = WS_WUQ + (size_t)2 * 1536 * 384 * 2;
constexpr size_t WS_WGU   = al256(WS_WO + (size_t)2 * 1024 * 1024 * 2);
constexpr size_t WS_WDN   = WS_WGU + (size_t)DEPTH * NE * 2048 * 1024 * 2;
constexpr size_t WS_H     = WS_WDN + (size_t)DEPTH * NE * 1024 * 1024 * 2;
constexpr size_t WS_HK    = WS_H + (size_t)T * D * 2;
constexpr size_t WS_XB    = WS_HK + (size_t)T * D * 2;
constexpr size_t WS_H8    = WS_XB + (size_t)T * D * 2;
constexpr size_t WS_ACT   = WS_H8 + (size_t)T * D;
constexpr size_t WS_YS    = WS_ACT + (size_t)NROWS_MAX * FF * 2;
constexpr size_t WS_MIX   = WS_YS + (size_t)NROWS_MAX * D * 2;
constexpr size_t WS_QH = WS_MIX;
constexpr size_t WS_KK = WS_QH + (size_t)T * D * 2;
constexpr size_t WS_VV = WS_KK + (size_t)T * D * 2;
constexpr size_t WS_GS = WS_VV + (size_t)T * D * 2;
constexpr size_t WS_LF = WS_GS + (size_t)T * D * 2;
constexpr size_t WS_OO = WS_LF + (size_t)T * D * 4;
constexpr size_t WS_OG = WS_OO + (size_t)T * D * 2;
constexpr size_t WS_MIX_END_A = WS_OG + (size_t)T * D * 2;
constexpr size_t WS_KB  = WS_MIX;
constexpr size_t WS_VB  = WS_KB + (size_t)T * MH * QK * 2;
constexpr size_t WS_QB  = WS_VB + (size_t)T * D * 2;
constexpr size_t WS_CKR = WS_QB + (size_t)T * MH * QK * 2;
constexpr size_t WS_CKV = WS_CKR + (size_t)T * 512 * 2;
constexpr size_t WS_CQ  = WS_CKV + (size_t)T * 256 * 2;
constexpr size_t WS_CQN = WS_CQ + (size_t)T * 512 * 2;
constexpr size_t WS_AO  = WS_CQN + (size_t)T * 384 * 2;
constexpr size_t WS_MIX_END_B = WS_AO + (size_t)T * D * 2;
constexpr size_t WS_END = (WS_MIX_END_A > WS_MIX_END_B ? WS_MIX_END_A : WS_MIX_END_B);
static_assert(WS_END < (size_t)4200 * MiB / 1 && WS_END < 4294967296ull, "workspace map must fit 4 x largest tensor");

constexpr int RING_BYTES = 131072;
constexpr int LDS_TAB = RING_BYTES;
constexpr int LDS_BLKE = RING_BYTES + 1024;
constexpr int LDS_MISC = RING_BYTES + 512;
constexpr int LDS_SIDE = LDS_BLKE + NBLK_MAX * 4;
static_assert(LDS_SIDE % 16 == 0 && LDS_SIDE + 3 * 2048 <= 147456, "LDS map");
constexpr int LDS_BYTES = 147456;

#define RLX_AGENT __ATOMIC_RELAXED, __HIP_MEMORY_SCOPE_AGENT
#define LDS_WAIT() asm volatile("s_waitcnt lgkmcnt(0)" ::: "memory")
#define VM_WAIT() asm volatile("s_waitcnt vmcnt(0)" ::: "memory")
typedef __bf16 bf16x2_t __attribute__((ext_vector_type(2)));
__device__ __forceinline__ unsigned cvt_pk_bf16(float lo, float hi) { f32x2 v = {lo, hi}; bf16x2_t b = __builtin_convertvector(v, bf16x2_t); return __builtin_bit_cast(unsigned, b); }
__device__ __forceinline__ float bf2f(unsigned short b) { return __uint_as_float(((unsigned)b) << 16); }
__device__ __forceinline__ float bflo(unsigned w) { return __uint_as_float(w << 16); }
__device__ __forceinline__ float bfhi(unsigned w) { return __uint_as_float(w & 0xffff0000u); }
__device__ __forceinline__ unsigned short f2bf(float f) { return (unsigned short)(cvt_pk_bf16(f, 0.f) & 0xffffu); }
__device__ __forceinline__ float wave_sum(float v) {
#pragma unroll
    for (int o = 1; o < 64; o <<= 1) v += __shfl_xor(v, o);
    return v;
}
__device__ __forceinline__ void glds16s(const void* sbase, unsigned voff, unsigned lds_dst) {
    asm volatile("s_mov_b32 m0, %2\n\ts_nop 0\n\tglobal_load_lds_dwordx4 %0, %1" :: "v"(voff), "s"(sbase), "s"(lds_dst) : "memory", "m0"); }
__device__ __forceinline__ int opaque_v(int x) { asm volatile("" : "+v"(x)); return x; }
#define PHASE_IDS const int tid = opaque_v((int)threadIdx.x), lane = tid & 63, wave = __builtin_amdgcn_readfirstlane(tid >> 6); (void)lane; (void)wave
typedef _Float16 f16x2_t __attribute__((ext_vector_type(2)));
__device__ __forceinline__ unsigned pk_f16(float a, float b) { return __builtin_bit_cast(unsigned, __builtin_amdgcn_cvt_pkrtz(a, b)); }
__device__ __forceinline__ float f16lo(unsigned u) { return (float)__builtin_bit_cast(f16x2_t, u)[0]; }
__device__ __forceinline__ float f16hi(unsigned u) { return (float)__builtin_bit_cast(f16x2_t, u)[1]; }
__device__ __forceinline__ float fsigmoid(float x) { return __builtin_amdgcn_rcpf(1.0f + __expf(-x)); }
__device__ __forceinline__ float fsilu(float x) { return x * __builtin_amdgcn_rcpf(1.0f + __expf(-x)); }

#define XB_TMO      128
#define XB_XCNT(j)  (256  + 64 * (j))
#define XB_XSUB(j)  (1280 + 64 * (j))
#define XB_XGEN(j)  (2304 + 64 * (j))
#define XB_TOP      3328
#define XB_TOPGEN   3392
#define XCD_BAR_WORDS 3456
#define XB_SPIN_CAP (1u << 23)
__device__ __forceinline__ unsigned xb_ld(unsigned* p)              { return __hip_atomic_load(p, __ATOMIC_RELAXED, __HIP_MEMORY_SCOPE_AGENT); }
__device__ __forceinline__ unsigned xb_add(unsigned* p, unsigned v) { return __hip_atomic_fetch_add(p, v, __ATOMIC_RELAXED, __HIP_MEMORY_SCOPE_AGENT); }
__device__ __forceinline__ unsigned xb_xcc_id() { return (unsigned)__builtin_amdgcn_s_getreg((3 << 11) | 20) & 0xFu; }
#define XB_SPIN(cond, bar) do { unsigned _sp = 0; while (cond) { __builtin_amdgcn_s_sleep(1); \
    if ((++_sp & 255u) == 0u) { if (xb_ld(&(bar)[XB_TMO])) break; if (_sp > XB_SPIN_CAP) { atomicAdd(&(bar)[XB_TMO], 1u); break; } } } } while (0)
struct XcdBarrier { unsigned* bar; unsigned x; volatile LAS unsigned* st; };
__device__ __forceinline__ XcdBarrier xcd_barrier_post(unsigned* bar, volatile LAS unsigned* st) {
    XcdBarrier b; b.bar = bar; b.x = xb_xcc_id(); b.st = st;
    if (threadIdx.x == 0) (void)xb_add(&bar[XB_XCNT(b.x)], 1u);
    return b;
}
__device__ __forceinline__ void xcd_barrier_complete(unsigned* bar, unsigned x, unsigned& nloc, unsigned& nx) {
    const unsigned G = gridDim.x * gridDim.y * gridDim.z;
    unsigned sum, cnt, mine, sp = 0u;
    for (;;) {
        sum = 0u; cnt = 0u; mine = 0u;
#pragma unroll
        for (unsigned j = 0; j < 16; ++j) { const unsigned c = xb_ld(&bar[XB_XCNT(j)]); sum += c; cnt += (c > 0u) ? 1u : 0u; mine = (j == x) ? c : mine; }
        if (sum == G) break;
        __builtin_amdgcn_s_sleep(1);
        if ((++sp & 255u) == 0u) { if (xb_ld(&bar[XB_TMO])) break; if (sp > XB_SPIN_CAP) { atomicAdd(&bar[XB_TMO], 1u); break; } }
    }
    nloc = mine > 0u ? mine : 1u; nx = cnt > 0u ? cnt : 1u;
}
__device__ __forceinline__ void xcd_barrier(const XcdBarrier& b) {
    asm volatile("s_waitcnt vmcnt(0)" ::: "memory");
    __syncthreads();
    if (threadIdx.x == 0) {
        unsigned* bar = b.bar;
        __builtin_amdgcn_s_waitcnt(0);
        unsigned nloc = b.st[0], nx = b.st[1];
        if (nloc == 0u) { xcd_barrier_complete(bar, b.x, nloc, nx); b.st[0] = nloc; b.st[1] = nx; }
        const unsigned old = xb_add(&bar[XB_XSUB(b.x)], 1u);
        const unsigned gen = old / nloc;
        if (old + 1u == (gen + 1u) * nloc) {
            __builtin_amdgcn_fence(__ATOMIC_RELEASE, "agent");
            asm volatile("s_waitcnt vmcnt(0)" ::: "memory");
            const unsigned og = xb_add(&bar[XB_TOP], 1u);
            const unsigned tg = og / nx;
            if (og + 1u == (tg + 1u) * nx) xb_add(&bar[XB_TOPGEN], 1u);
            else XB_SPIN(xb_ld(&bar[XB_TOPGEN]) == tg, bar);
            __builtin_amdgcn_fence(__ATOMIC_ACQUIRE, "agent");
            xb_add(&bar[XB_XGEN(b.x)], 1u);
            asm volatile("s_waitcnt vmcnt(0)" ::: "memory");
        } else {
            XB_SPIN(xb_ld(&bar[XB_XGEN(b.x)]) == gen, bar);
            __builtin_amdgcn_fence(__ATOMIC_ACQUIRE, "agent");
            asm volatile("s_waitcnt vmcnt(0)" ::: "memory");
        }
    }
    __syncthreads();
}
namespace pg8 {
constexpr int BM = 256, BK = 64, HALF = 128, HTB = HALF * BK * 2, STAGE_BYTES = 8 * HTB, NXCD = 8, WGM = 8;
__host__ __device__ __forceinline__ int lds_byte(int r, int c) { const int st = (r >> 4) * 2 + (c >> 5), rr = r & 15, cc = c & 31, ob = rr * 64 + cc * 2; return st * 1024 + (ob ^ (((ob >> 9) & 1) << 5)); }
__host__ __device__ __forceinline__ void stage_rc(int b, int& R, int& C) { const int st = b / 1024, sb = b % 1024, swz = sb ^ (((sb >> 9) & 1) << 5); R = (st >> 1) * 16 + swz / 64; C = (st & 1) * 32 + (swz % 64) / 2; }
__host__ __device__ __forceinline__ int perm32(int rho) { const int n = rho >> 4, i = rho & 15; return 8 * (i >> 2) + 4 * n + (i & 3); }

struct Unit { int pm, pn, e; };

struct StaticOrder {
    int nM, nN, nwg, G, c;
    __device__ void init(int M, int N, int G_, int c_) { nM = M / BM; nN = N / BM; nwg = nM * nN; G = G_; c = c_; }
    __device__ bool next(int i, Unit& u) const {
        const long L = (long)i * G + c; if (L >= nwg) return false;
        int wgid = (int)L; { const int q = nwg / NXCD, r = nwg % NXCD, xcd = wgid % NXCD, off = wgid / NXCD; wgid = (xcd < r ? xcd * (q + 1) : r * (q + 1) + (xcd - r) * q) + off; }
        const int nig = WGM * nN, gid = wgid / nig, fm = gid * WGM, gsz = (nM - fm) < WGM ? (nM - fm) : WGM;
        u.pm = fm + ((wgid % nig) % gsz); u.pn = (wgid % nig) / gsz; u.e = 0; return true;
    }
};

struct PlainSched : StaticOrder {
    static constexpr bool GATHER = false;
    const char* Bt; int K;
    __device__ __forceinline__ const char* bptr(const Unit& u) const { return Bt + (size_t)u.pn * BM * K; }
    __device__ __forceinline__ unsigned adelta(const Unit& a, const Unit& b) const { return (unsigned)((b.pm - a.pm) * BM * K); }
    __device__ __forceinline__ void aoffs(const Unit& u, unsigned (&o)[2][2]) const {
        int R0, C0, R1, C1; { const int t_ = opaque_v((int)threadIdx.x); stage_rc(t_ * 16, R0, C0); stage_rc(t_ * 16 + 8192, R1, C1); C0 *= 2; C1 *= 2; }
#pragma unroll
        for (int h = 0; h < 2; ++h) { o[h][0] = (unsigned)((u.pm * BM + h * HALF + R0) * K + C0); o[h][1] = (unsigned)((u.pm * BM + h * HALF + R1) * K + C1); }
    }
};

#define PG8_SA(b, h) (((b) * 2 + (h)) * HTB)
#define PG8_SB(b, h) ((4 + (b) * 2 + (h)) * HTB)
#define PG8_STAGE_B(bufoff, gbase) do { glds16s((gbase), voffB, lds0 + (bufoff) + ldsw); glds16s((gbase) + r64, voffB, lds0 + (bufoff) + ldsw + 8192u); } while (0)
#define PG8_STAGE_A(bufoff, gbase, h) do { if constexpr (Sched::GATHER) { glds16s((gbase), vc[h][0], lds0 + (bufoff) + ldsw); glds16s((gbase), vc[h][1], lds0 + (bufoff) + ldsw + 8192u); } \
        else { glds16s((gbase) + (h) * hstep, vc[0][0], lds0 + (bufoff) + ldsw); glds16s((gbase) + (h) * hstep + r64, vc[0][0], lds0 + (bufoff) + ldsw + 8192u); } } while (0)
#define PG8_LDA(dst, b, h) do { _Pragma("unroll") for (int m = 0; m < 4; ++m) _Pragma("unroll") for (int k = 0; k < 2; ++k) dst[m][k] = *(const LAS bf16x8*)(lds + PG8_SA(b, h) + aoff + m * 2048 + k * 1024); } while (0)
#define PG8_LDB(dst, b, h) do { _Pragma("unroll") for (int n = 0; n < 2; ++n) _Pragma("unroll") for (int k = 0; k < 2; ++k) dst[n][k] = *(const LAS bf16x8*)(lds + PG8_SB(b, h) + boff + n * 2048 + k * 1024); } while (0)
#define PG8_MMA(ai, bj, At, Bt) do { __builtin_amdgcn_s_setprio(1); _Pragma("unroll") for (int m = 0; m < 4; ++m) _Pragma("unroll") for (int n = 0; n < 2; ++n) _Pragma("unroll") for (int k = 0; k < 2; ++k) \
        acc[ai][bj][m][n] = __builtin_amdgcn_mfma_f32_16x16x32_bf16(Bt[n][k], At[m][k], acc[ai][bj][m][n], 0, 0, 0); __builtin_amdgcn_s_setprio(0); } while (0)
#define PG8_WAIT_V(n) asm volatile("s_waitcnt vmcnt(" #n ")" ::: "memory")
#define PG8_WAIT_L(n) asm volatile("s_waitcnt lgkmcnt(" #n ")" ::: "memory")
#define PG8_BAR __builtin_amdgcn_s_barrier()
#define PG8_SCHED __builtin_amdgcn_sched_barrier(0)

typedef int i32x4v __attribute__((ext_vector_type(4)));
typedef int i32x8v __attribute__((ext_vector_type(8)));
__device__ __forceinline__ i32x8v cat8(bf16x8 a, bf16x8 b) { const i32x4v x = __builtin_bit_cast(i32x4v, a), y = __builtin_bit_cast(i32x4v, b); return __builtin_shufflevector(x, y, 0, 1, 2, 3, 4, 5, 6, 7); }
#define PG8_MFMA8(accv, b8, a8) asm volatile("v_mfma_f32_16x16x128_f8f6f4 %0, %1, %2, %0" : "+v"(accv) : "v"(b8), "v"(a8))
#define PG8_MFMA_DRAIN() asm volatile("s_nop 15\n\ts_nop 15\n\ts_nop 15\n\ts_nop 15" ::: "memory")
#define PG8_MMA8(ai, bj, At, Bt) do { __builtin_amdgcn_s_setprio(1); _Pragma("unroll") for (int m = 0; m < 4; ++m) _Pragma("unroll") for (int n = 0; n < 2; ++n) \
        PG8_MFMA8(acc[ai][bj][m][n], Bt##8[n], At##8[m]); __builtin_amdgcn_s_setprio(0); } while (0)
#define PG8_MM(ai, bj, At, Bt) do { if constexpr (FP8) PG8_MMA8(ai, bj, At, Bt); else PG8_MMA(ai, bj, At, Bt); } while (0)
#define PG8_LDA8(dst, b, h) do { _Pragma("unroll") for (int m = 0; m < 4; ++m) dst##8[m] = cat8(*(const LAS bf16x8*)(lds + PG8_SA(b, h) + aoff + m * 2048), *(const LAS bf16x8*)(lds + PG8_SA(b, h) + aoff + m * 2048 + 1024)); } while (0)
#define PG8_LDB8(dst, b, h) do { _Pragma("unroll") for (int n = 0; n < 2; ++n) dst##8[n] = cat8(*(const LAS bf16x8*)(lds + PG8_SB(b, h) + boff + n * 2048), *(const LAS bf16x8*)(lds + PG8_SB(b, h) + boff + n * 2048 + 1024)); } while (0)
#define PG8_LA(dst, b, h) do { if constexpr (FP8) PG8_LDA8(dst, b, h); else PG8_LDA(dst, b, h); } while (0)
#define PG8_LB(dst, b, h) do { if constexpr (FP8) PG8_LDB8(dst, b, h); else PG8_LDB(dst, b, h); } while (0)
template <bool FP8, class Epi, class Sched>
__device__ __forceinline__ void gemm_phase(LAS unsigned char* lds, const char* A0, int K, const Sched& S, const Epi& E) {
    asm volatile("" : "+s"(K));
    const int tid = opaque_v((int)threadIdx.x), wid = __builtin_amdgcn_readfirstlane(tid >> 6), lane = tid & 63, wr = wid >> 2, wc = wid & 3, fr = lane & 15, fq = lane >> 4;
    const int nt = K / (BK * 2);
    unsigned voffB;
    { int R0, C0; stage_rc(tid * 16, R0, C0); C0 *= 2;
      const int Rb0 = Epi::PERM ? ((R0 & ~31) + perm32(R0 & 31)) : R0;
      voffB = (unsigned)(Rb0 * K + C0); }
    const size_t r64 = (size_t)64 * K;
    const size_t kstep = (size_t)(BK * 2);
    const size_t hstep = (size_t)HALF * K;
    const unsigned ldsw = (unsigned)wid * 1024u, lds0 = (unsigned)(uintptr_t)lds;
    const int aoff = lds_byte(wr * 64 + fr, fq * 8), boff = lds_byte(wc * 32 + fr, fq * 8);
    Unit cur, nxt; int ui = 0;
    if (!S.next(0, cur)) return;
    f32x4 acc[2][2][4][2];
    float zz_ = 0.f; asm volatile("" : "+v"(zz_));
#pragma unroll
    for (int a = 0; a < 2; ++a)
#pragma unroll
        for (int b = 0; b < 2; ++b)
#pragma unroll
            for (int m = 0; m < 4; ++m)
#pragma unroll
                for (int n = 0; n < 2; ++n) acc[a][b][m][n] = (f32x4){zz_, zz_, zz_, zz_};
    bf16x8 At[4][2], B0[2][2], B1[2][2];
    i32x8v At8[4], B08[2], B18[2];
    unsigned vc[2][2], vn[2][2];
    int rcA = 0; if constexpr (Sched::GATHER) { int R0_, C0_; stage_rc(tid * 16, R0_, C0_); rcA = (R0_ << 8) | (C0_ * 2); }
    S.aoffs(cur, vc);
    const char* cB = S.bptr(cur);
    int sbc = 0;
#define PG8_SIDE(u_, buf_) do { if constexpr (Epi::NSIDE > 0) { _Pragma("unroll") for (int i_ = 0; i_ < Epi::NSIDE; ++i_) if (wid == i_) { const int ln_ = opaque_v((int)threadIdx.x) & 63; \
        const unsigned long long sp_ = (unsigned long long)(uintptr_t)E.side_base((u_), i_); const unsigned lo_ = __builtin_amdgcn_readfirstlane((unsigned)sp_), hi_ = __builtin_amdgcn_readfirstlane((unsigned)(sp_ >> 32)); \
        glds16s((const void*)(uintptr_t)(((unsigned long long)hi_ << 32) | lo_), E.side_voff(ln_, i_), lds0 + (unsigned)LDS_SIDE + (unsigned)(buf_) * 2048u + (unsigned)i_ * 1024u); } } } while (0)
    PG8_SIDE(cur, 0);
    PG8_STAGE_B(PG8_SB(0, 0), cB); PG8_STAGE_B(PG8_SB(0, 1), cB + hstep); PG8_STAGE_A(PG8_SA(0, 0), A0, 0); PG8_STAGE_A(PG8_SA(0, 1), A0, 1);
    if (wr == 1) PG8_BAR;
    PG8_WAIT_V(2); PG8_BAR;
    PG8_STAGE_B(PG8_SB(1, 0), cB + kstep); PG8_STAGE_A(PG8_SA(1, 0), A0 + kstep, 0); PG8_STAGE_B(PG8_SB(1, 1), cB + hstep + kstep);
    PG8_WAIT_V(6); PG8_BAR;
#pragma unroll 1
    for (;;) {
        const bool has_next = S.next(ui + 1, nxt);
        const char* nB = cB; unsigned dlt = 0u;
        if constexpr (Sched::GATHER) {
            if (has_next) { S.aload(nxt, vn, rcA); nB = S.bptr(nxt); }
        } else { if (has_next) { dlt = S.adelta(cur, nxt); nB = S.bptr(nxt); } }
        const int sbn = (sbc == 2) ? 0 : sbc + 1;
        if (has_next) PG8_SIDE(nxt, sbn);
#pragma unroll 1
        for (int t = 0; t < nt; t += 2) {
            const bool last = (t == nt - 2);
            const char* a1 = A0 + (size_t)(t + 1) * kstep;
            const char* a2 = last ? A0 : A0 + (size_t)(t + 2) * kstep; const char* b2 = last ? nB : cB + (size_t)(t + 2) * kstep;
            const char* a3 = a2 + kstep; const char* b3 = b2 + kstep;
            PG8_LB(B0, 0, 0); PG8_LB(B1, 0, 1); PG8_SCHED; PG8_LA(At, 0, 0); PG8_STAGE_A(PG8_SA(1, 1), a1, 1);
            PG8_WAIT_V(8); PG8_WAIT_L(0); PG8_BAR;
            if (last) {
                if constexpr (Sched::GATHER) { if (has_next) {
#pragma unroll
                    for (int h = 0; h < 2; ++h) { vc[h][0] = (unsigned)opaque_v((int)vn[h][0]); vc[h][1] = (unsigned)opaque_v((int)vn[h][1]); }
                    S.aconv(vc, rcA); } }
                else vc[0][0] += dlt; }
            PG8_MM(0, 0, At, B0); PG8_MM(0, 1, At, B1); PG8_BAR; PG8_SCHED;
            PG8_LA(At, 0, 1); PG8_STAGE_B(PG8_SB(0, 0), b2); PG8_STAGE_B(PG8_SB(0, 1), b2 + hstep); PG8_STAGE_A(PG8_SA(0, 0), a2, 0);
            PG8_WAIT_V(8); PG8_WAIT_L(0); PG8_BAR; PG8_MM(1, 0, At, B0); PG8_MM(1, 1, At, B1); PG8_BAR; PG8_SCHED;
            PG8_LB(B0, 1, 0); PG8_LB(B1, 1, 1); PG8_SCHED; PG8_LA(At, 1, 0); PG8_STAGE_A(PG8_SA(0, 1), a2, 1);
            PG8_WAIT_V(8); PG8_WAIT_L(0); PG8_BAR; PG8_MM(0, 0, At, B0); PG8_MM(0, 1, At, B1); PG8_BAR; PG8_SCHED;
            PG8_LA(At, 1, 1); PG8_STAGE_B(PG8_SB(1, 0), b3); PG8_STAGE_B(PG8_SB(1, 1), b3 + hstep); PG8_STAGE_A(PG8_SA(1, 0), a3, 0);
            PG8_WAIT_V(8); PG8_WAIT_L(0); PG8_BAR; PG8_MM(1, 0, At, B0); PG8_MM(1, 1, At, B1); PG8_BAR; PG8_SCHED;
        }
        if (wr == 0) PG8_BAR;
        if constexpr (FP8) PG8_MFMA_DRAIN();
        { const int l_ = opaque_v((int)threadIdx.x) & 63; E(acc, cur, wr, wc, l_ & 15, l_ >> 4, (const LAS float*)(lds + LDS_SIDE + sbc * 2048)); }
        if (!has_next) break;
        zz_ = 0.f; asm volatile("" : "+v"(zz_));
#pragma unroll
        for (int a = 0; a < 2; ++a)
#pragma unroll
            for (int b = 0; b < 2; ++b)
#pragma unroll
                for (int m = 0; m < 4; ++m)
#pragma unroll
                    for (int n = 0; n < 2; ++n) acc[a][b][m][n] = (f32x4){zz_, zz_, zz_, zz_};
        cur = nxt; cB = nB; ++ui; sbc = sbn;
        if (wr == 1) PG8_BAR;
    }
    PG8_WAIT_V(0);
    PG8_BAR;
}
}
namespace pg8 {
__device__ __forceinline__ u32x2 pack8_fp8(const f32x4 a, const f32x4 b) { int w0 = 0, w1 = 0;
    w0 = __builtin_amdgcn_cvt_pk_fp8_f32(a[0], a[1], w0, false); w0 = __builtin_amdgcn_cvt_pk_fp8_f32(a[2], a[3], w0, true);
    w1 = __builtin_amdgcn_cvt_pk_fp8_f32(b[0], b[1], w1, false); w1 = __builtin_amdgcn_cvt_pk_fp8_f32(b[2], b[3], w1, true); u32x2 r; r.x = (unsigned)w0; r.y = (unsigned)w1; return r; }
__device__ __forceinline__ u32x4 pack8(const f32x4 a, const f32x4 b) { u32x4 w; w.x = cvt_pk_bf16(a[0], a[1]); w.y = cvt_pk_bf16(a[2], a[3]); w.z = cvt_pk_bf16(b[0], b[1]); w.w = cvt_pk_bf16(b[2], b[3]); return w; }

struct EpiNull { static constexpr bool PERM = true; static constexpr int NSIDE = 0;
    __device__ __forceinline__ void operator()(const f32x4 (&acc)[2][2][4][2], const Unit& u, int wr, int wc, int fr, int fq, const LAS float* sd) const {} };
struct EpiPlainBf16 {
    static constexpr bool PERM = true; static constexpr int NSIDE = 0;
    bf16_t* O; int ldc; float sc;
    __device__ __forceinline__ void operator()(const f32x4 (&acc)[2][2][4][2], const Unit& u, int wr, int wc, int fr, int fq, const LAS float* sd) const {
        const int row0 = u.pm * BM + wr * 64 + fr, col0 = u.pn * BM + wc * 32 + 8 * fq;
#pragma unroll
        for (int ai = 0; ai < 2; ++ai)
#pragma unroll
            for (int m = 0; m < 4; ++m) { bf16_t* rowp = O + (size_t)(row0 + ai * HALF + m * 16) * ldc + col0;
#pragma unroll
                for (int bj = 0; bj < 2; ++bj) *(u32x4*)(rowp + bj * HALF) = pack8(acc[ai][bj][m][0] * sc, acc[ai][bj][m][1] * sc);
                __builtin_amdgcn_sched_barrier(0); }
    }
};

struct EpiHgrnIn {
    static constexpr bool PERM = true; static constexpr int NSIDE = 0;
    bf16_t* P; float* LF; const float* lb;
    int segmap; float scale;
    __device__ __forceinline__ void operator()(const f32x4 (&acc)[2][2][4][2], const Unit& u, int wr, int wc, int fr, int fq, const LAS float* sd) const {
        const int seg = (segmap >> (4 * (u.pn >> 2))) & 15;
        const int col0 = (u.pn & 3) * BM + wc * 32 + 8 * fq;
        const size_t ub = (size_t)((u.pm * 4 + wr) * 8 + (u.pn & 3) * 2) * 8192;
        const size_t base_t = ub + (size_t)(((2 * wc + (fq >> 1)) * 64 + (fr & 3) * 16 + (fr >> 2)) * 16 + 8 * (fq & 1));
        if (seg == 1) {
            float lbv[2][8];
#pragma unroll
            for (int bj = 0; bj < 2; ++bj) { const f32x4 a = *(const f32x4*)(lb + col0 + bj * HALF), b = *(const f32x4*)(lb + col0 + bj * HALF + 4);
                lbv[bj][0] = a[0]; lbv[bj][1] = a[1]; lbv[bj][2] = a[2]; lbv[bj][3] = a[3]; lbv[bj][4] = b[0]; lbv[bj][5] = b[1]; lbv[bj][6] = b[2]; lbv[bj][7] = b[3]; }
#pragma unroll
            for (int ai = 0; ai < 2; ++ai)
#pragma unroll
                for (int m = 0; m < 4; ++m) { const size_t off = base_t + (size_t)ai * 131072 + m * 64;
#pragma unroll
                    for (int bj = 0; bj < 2; ++bj) { float lf[8], ky[8];
#pragma unroll
                        for (int j = 0; j < 8; ++j) { const float f = acc[ai][bj][m][j >> 2][j & 3], l = lbv[bj][j];
                            const float sg = fsigmoid(f); const float fg = l + (1.0f - l) * sg;
                            lf[j] = __logf(fmaxf(fg, 1e-30f)); ky[j] = (1.0f - l) * (1.0f - sg); }
                        { u32x4 lw; lw.x = pk_f16(lf[0], lf[1]); lw.y = pk_f16(lf[2], lf[3]); lw.z = pk_f16(lf[4], lf[5]); lw.w = pk_f16(lf[6], lf[7]); *(u32x4*)((unsigned short*)LF + off + bj * 8192) = lw; }
                        u32x4 w; w.x = cvt_pk_bf16(ky[0], ky[1]); w.y = cvt_pk_bf16(ky[2], ky[3]); w.z = cvt_pk_bf16(ky[4], ky[5]); w.w = cvt_pk_bf16(ky[6], ky[7]);
                        *(u32x4*)(P + (size_t)T * D + off + bj * 8192) = w; }
                    __builtin_amdgcn_sched_barrier(0); }
        } else {
            bf16_t* O = P + (size_t)seg * T * D;
            const bool act = (seg != 2);
            size_t base = base_t; int SB = 8192, SM = 64;
            if (seg == 2) { base = ub + (size_t)(((4 * wc + fq) * 64 + fr) * 8); SM = 128; }
            if (seg == 3) { base = (size_t)(u.pm * BM + wr * 64 + fr) * D + col0; SB = HALF; SM = 16 * D; }
#pragma unroll
            for (int ai = 0; ai < 2; ++ai)
#pragma unroll
                for (int m = 0; m < 4; ++m) { const size_t off = base + (size_t)ai * 131072 + (size_t)(m * SM);
#pragma unroll
                    for (int bj = 0; bj < 2; ++bj) { f32x4 a = acc[ai][bj][m][0] * scale, b = acc[ai][bj][m][1] * scale;
                        asm volatile("" : "+v"(a), "+v"(b));
                        if (act) {
#pragma unroll
                            for (int j = 0; j < 4; ++j) { a[j] = fsilu(a[j]); b[j] = fsilu(b[j]); } }
                        *(u32x4*)(O + off + bj * SB) = pack8(a, b);
                        __builtin_amdgcn_sched_barrier(0); } }
        }
    }
};

struct EpiResid {
    static constexpr bool PERM = true; static constexpr int NSIDE = 0;
    const float* Xf; bf16_t* Xb; const float* gate; float sc;
    int gstride;
    __device__ __forceinline__ void operator()(const f32x4 (&acc)[2][2][4][2], const Unit& u, int wr, int wc, int fr, int fq, const LAS float* sd) const {
        const int row0 = u.pm * BM + wr * 64 + fr, col0 = u.pn * BM + wc * 32 + 8 * fq;
        const float* g = gate + (size_t)((u.pm * BM) / SEQ) * gstride;
        f32x4 gv[2][2];
#pragma unroll
        for (int bj = 0; bj < 2; ++bj)
#pragma unroll
            for (int n = 0; n < 2; ++n) gv[bj][n] = *(const f32x4*)(g + col0 + bj * HALF + n * 4) * sc;
#pragma unroll
        for (int ai = 0; ai < 2; ++ai) {
            if (Xf) {
#pragma unroll
                for (int mp = 0; mp < 2; ++mp) { f32x4 xin[2][2][2];
#pragma unroll
                    for (int mm = 0; mm < 2; ++mm) { const size_t off = (size_t)(row0 + ai * HALF + (2 * mp + mm) * 16) * D + col0;
#pragma unroll
                        for (int bj = 0; bj < 2; ++bj) { xin[mm][bj][0] = *(const f32x4*)(Xf + off + bj * HALF); xin[mm][bj][1] = *(const f32x4*)(Xf + off + bj * HALF + 4); } }
#pragma unroll
                    for (int mm = 0; mm < 2; ++mm) { const int m = 2 * mp + mm; const size_t off = (size_t)(row0 + ai * HALF + m * 16) * D + col0;
#pragma unroll
                        for (int bj = 0; bj < 2; ++bj) *(u32x4*)(Xb + off + bj * HALF) = pack8(xin[mm][bj][0] + gv[bj][0] * acc[ai][bj][m][0], xin[mm][bj][1] + gv[bj][1] * acc[ai][bj][m][1]); }
                    __builtin_amdgcn_sched_barrier(0); }
            } else if (ai == 0) {
                u32x4 xw[2][4][2];
#pragma unroll
                for (int a2 = 0; a2 < 2; ++a2)
#pragma unroll
                    for (int m = 0; m < 4; ++m) { const size_t off = (size_t)(row0 + a2 * HALF + m * 16) * D + col0;
#pragma unroll
                        for (int bj = 0; bj < 2; ++bj) xw[a2][m][bj] = *(const u32x4*)(Xb + off + bj * HALF); }
#pragma unroll
                for (int a2 = 0; a2 < 2; ++a2) {
#pragma unroll
                    for (int m = 0; m < 4; ++m) { const size_t off = (size_t)(row0 + a2 * HALF + m * 16) * D + col0;
#pragma unroll
                        for (int bj = 0; bj < 2; ++bj) { const u32x4 w = xw[a2][m][bj];
                            const f32x4 x0 = (f32x4){bflo(w.x), bfhi(w.x), bflo(w.y), bfhi(w.y)}, x1 = (f32x4){bflo(w.z), bfhi(w.z), bflo(w.w), bfhi(w.w)};
                            *(u32x4*)(Xb + off + bj * HALF) = pack8(x0 + gv[bj][0] * acc[a2][bj][m][0], x1 + gv[bj][1] * acc[a2][bj][m][1]); } }
                    __builtin_amdgcn_sched_barrier(0); }
                __builtin_amdgcn_sched_barrier(0); } }
    }
};

struct EpiKvUp {
    static constexpr bool PERM = true; static constexpr int NSIDE = 0;
    bf16_t *Kb, *Vb;
    __device__ __forceinline__ void operator()(const f32x4 (&acc)[2][2][4][2], const Unit& u, int wr, int wc, int fr, int fq, const LAS float* sd) const {
        const int row0 = u.pm * BM + wr * 64 + fr, c = wc * 32 + 8 * fq, h = u.pn;
#pragma unroll
        for (int ai = 0; ai < 2; ++ai)
#pragma unroll
            for (int m = 0; m < 4; ++m) { const size_t row = (size_t)(row0 + ai * HALF + m * 16);
                *(u32x4*)(Kb + row * (MH * QK) + h * QK + c) = pack8(acc[ai][0][m][0], acc[ai][0][m][1]);
                *(u32x4*)(Vb + row * D + h * VD + c) = pack8(acc[ai][1][m][0], acc[ai][1][m][1]);
                __builtin_amdgcn_sched_barrier(0); }
    }
};

struct EpiQUp {
    static constexpr bool PERM = true; static constexpr int NSIDE = 0;
    bf16_t* Qb; const float* rope;
    __device__ __forceinline__ void operator()(const f32x4 (&acc)[2][2][4][2], const Unit& u, int wr, int wc, int fr, int fq, const LAS float* sd) const {
        const int row0 = u.pm * BM + wr * 64 + fr, c = wc * 32 + 8 * fq;
        if (u.pn < 4) {
#pragma unroll
            for (int ai = 0; ai < 2; ++ai)
#pragma unroll
                for (int m = 0; m < 4; ++m) { const size_t row = (size_t)(row0 + ai * HALF + m * 16);
#pragma unroll
                    for (int bj = 0; bj < 2; ++bj) *(u32x4*)(Qb + row * (MH * QK) + (2 * u.pn + bj) * QK + c) = pack8(acc[ai][bj][m][0], acc[ai][bj][m][1]);
                    __builtin_amdgcn_sched_barrier(0); }
        } else {
            const int h = 4 * (u.pn - 4) + wc, i0 = 8 * fq;
#pragma unroll
            for (int ai = 0; ai < 2; ++ai)
#pragma unroll
              for (int mp = 0; mp < 1; ++mp) {
                f32x4 cs[4][4];
#pragma unroll
                for (int mm = 0; mm < 4; ++mm) { const float* rp = rope + (size_t)(row0 + ai * HALF + mm * 16) * 64 + i0;
                    cs[mm][0] = *(const f32x4*)(rp); cs[mm][1] = *(const f32x4*)(rp + 4); cs[mm][2] = *(const f32x4*)(rp + 32); cs[mm][3] = *(const f32x4*)(rp + 36); }
#pragma unroll
                for (int mm = 0; mm < 4; ++mm) { const int m = mm; const size_t row = (size_t)(row0 + ai * HALF + m * 16);
                    const f32x4 c0 = cs[mm][0], c1 = cs[mm][1], s0 = cs[mm][2], s1 = cs[mm][3];
                    const f32x4 a0 = acc[ai][0][m][0], a1 = acc[ai][0][m][1], b0 = acc[ai][1][m][0], b1 = acc[ai][1][m][1];
                    const f32x4 o10 = a0 * c0 - b0 * s0, o11 = a1 * c1 - b1 * s1, o20 = b0 * c0 + a0 * s0, o21 = b1 * c1 + a1 * s1;
                    bf16_t* qp = Qb + row * (MH * QK) + h * QK + NOPE + i0;
                    *(u32x4*)(qp) = pack8(o10, o11); *(u32x4*)(qp + 32) = pack8(o20, o21); }
                __builtin_amdgcn_sched_barrier(0); }
        }
    }
};

template <bool GATHER_> struct MoeSched {
    static constexpr bool GATHER = GATHER_;
    const LAS int* tab;
    const LAS int* blke;
    int NT, G, c;
    const char* Bt; size_t estride; int K;
    const int* rinfo;
    __device__ __forceinline__ unsigned adelta(const Unit& a, const Unit& b) const { return (unsigned)((b.pm - a.pm) * BM * K); }
    __device__ __forceinline__ bool next(int i, Unit& u) const {
        const int L = i * G + c; const int rb = L / NT;
        if (rb >= tab[32]) return false;
        u.pm = rb; u.pn = L - rb * NT; u.e = blke[rb]; return true;
    }
    __device__ __forceinline__ const char* bptr(const Unit& u) const { return Bt + (size_t)u.e * estride + (size_t)u.pn * BM * K; }
    __device__ __forceinline__ void aload(const Unit& u, unsigned (&raw)[2][2], int rc) const {
        const int R0 = rc >> 8; const int lb = (u.pm - tab[u.e]) * BM; const int lim = tab[64 + u.e] - lb;
        const int* rp = rinfo + (size_t)u.e * VCAP + lb;
#pragma unroll
        for (int h = 0; h < 2; ++h) { const int r0 = h * HALF + R0, r1 = r0 + 64; const int a = rp[r0 < lim ? r0 : 0], b = rp[r1 < lim ? r1 : 0];
            raw[h][0] = (unsigned)(r0 < lim ? a : -1); raw[h][1] = (unsigned)(r1 < lim ? b : -1); }
    }
    __device__ __forceinline__ void aconv(unsigned (&o)[2][2], int rc) const {
        const int C0 = rc & 255;
#pragma unroll
        for (int h = 0; h < 2; ++h) { const int i0 = (int)o[h][0], i1 = (int)o[h][1]; const int t0 = (i0 < 0 ? 0 : i0) >> 2, t1 = (i1 < 0 ? 0 : i1) >> 2;
            o[h][0] = (unsigned)(t0 * K + C0); o[h][1] = (unsigned)(t1 * K + C0); }
    }
    __device__ __forceinline__ void aoffs(const Unit& u, unsigned (&o)[2][2]) const {
        int R0, C0, R1, C1; { const int t_ = opaque_v((int)threadIdx.x); stage_rc(t_ * 16, R0, C0); stage_rc(t_ * 16 + 8192, R1, C1); C0 *= 2; C1 *= 2; }
        if constexpr (GATHER_) { const int rc = (R0 << 8) | C0; aload(u, o, rc); aconv(o, rc); }
        else {
#pragma unroll
            for (int h = 0; h < 2; ++h) { o[h][0] = (unsigned)((u.pm * BM + h * HALF + R0) * K + C0); o[h][1] = (unsigned)((u.pm * BM + h * HALF + R1) * K + C1); }
        }
    }
};

struct MoeSchedHot : MoeSched<true> {
    __device__ __forceinline__ bool next(int i, Unit& u) const { if (!MoeSched<true>::next(i, u)) return false; u.pm &= 3; u.pn = 0; u.e = blke[u.pm]; return true; } };

struct EpiMoeGU {
    static constexpr bool PERM = true; static constexpr int NSIDE = 1;
    unsigned char* ACT; const float* bgu;
    __device__ __forceinline__ const char* side_base(const Unit& u, int) const { return (const char*)(bgu + (size_t)u.e * 2048 + u.pn * HALF); }
    __device__ __forceinline__ unsigned side_voff(int lane, int) const { return (unsigned)((lane & 31) * 16 + (lane >> 5) * 4096); }
    __device__ __forceinline__ void operator()(const f32x4 (&acc)[2][2][4][2], const Unit& u, int wr, int wc, int fr, int fq, const LAS float* sd) const {
        const int row0 = u.pm * BM + wr * 64 + fr, c = u.pn * HALF + wc * 32 + 8 * fq;
        const LAS float* bp = sd + wc * 32 + 8 * fq;
        const f32x4 bg0 = *(const LAS f32x4*)(bp), bg1 = *(const LAS f32x4*)(bp + 4), bu0 = *(const LAS f32x4*)(bp + 128) + 1.0f, bu1 = *(const LAS f32x4*)(bp + 132) + 1.0f;
#pragma unroll
        for (int ai = 0; ai < 2; ++ai)
#pragma unroll
            for (int m = 0; m < 4; ++m) { const size_t row = (size_t)(row0 + ai * HALF + m * 16);
                const f32x4 lim = (f32x4){SWIGLU_LIMIT, SWIGLU_LIMIT, SWIGLU_LIMIT, SWIGLU_LIMIT};
                const f32x4 g0 = __builtin_elementwise_min(acc[ai][0][m][0] * 0.015625f + bg0, lim), g1 = __builtin_elementwise_min(acc[ai][0][m][1] * 0.015625f + bg1, lim);
                const f32x4 u0 = __builtin_elementwise_min(__builtin_elementwise_max(acc[ai][1][m][0] * 0.015625f + bu0, 1.0f - lim), 1.0f + lim), u1 = __builtin_elementwise_min(__builtin_elementwise_max(acc[ai][1][m][1] * 0.015625f + bu1, 1.0f - lim), 1.0f + lim);
                const f32x4 z0 = g0 * (-SWIGLU_ALPHA * 1.4426950408889634f), z1 = g1 * (-SWIGLU_ALPHA * 1.4426950408889634f);
                f32x4 s0, s1;
#pragma unroll
                for (int j = 0; j < 4; ++j) { s0[j] = __builtin_amdgcn_rcpf(1.0f + __builtin_amdgcn_exp2f(z0[j])); s1[j] = __builtin_amdgcn_rcpf(1.0f + __builtin_amdgcn_exp2f(z1[j])); }
                const f32x4 r0 = u0 * (g0 * s0), r1 = u1 * (g1 * s1);
                *(u32x2*)(ACT + row * FF + c) = pack8_fp8(r0, r1);
                __builtin_amdgcn_sched_barrier(0); }
    }
};

struct EpiMoeDN {
    static constexpr bool PERM = true; static constexpr int NSIDE = 2;
    unsigned char* YS; const float* bdn; const LAS int* tab; const float* rw;
    __device__ __forceinline__ const char* side_base(const Unit& u, int i) const { return i == 0 ? (const char*)(rw + (size_t)u.e * VCAP + (size_t)(u.pm - tab[u.e]) * BM) : (const char*)(bdn + (size_t)u.e * 1024 + u.pn * BM); }
    __device__ __forceinline__ unsigned side_voff(int lane, int) const { return (unsigned)(lane * 16); }
    __device__ __forceinline__ void operator()(const f32x4 (&acc)[2][2][4][2], const Unit& u, int wr, int wc, int fr, int fq, const LAS float* sd) const {
        const int row0 = u.pm * BM + wr * 64 + fr, c = u.pn * BM + wc * 32 + 8 * fq;
        const LAS float* bp = sd + 256 + wc * 32 + 8 * fq; const LAS float* wp = sd + wr * 64 + fr;
        f32x4 bb[2][2];
#pragma unroll
        for (int bj = 0; bj < 2; ++bj) { bb[bj][0] = *(const LAS f32x4*)(bp + bj * HALF) * 64.0f; bb[bj][1] = *(const LAS f32x4*)(bp + bj * HALF + 4) * 64.0f; }
#pragma unroll
        for (int ai = 0; ai < 2; ++ai)
#pragma unroll
            for (int m = 0; m < 4; ++m) { const float w = wp[ai * HALF + m * 16] * 0.5f;
                unsigned char* yp = YS + (size_t)(row0 + ai * HALF + m * 16) * D + c;
#pragma unroll
                for (int bj = 0; bj < 2; ++bj) {
                    const f32x4 v0 = (acc[ai][bj][m][0] + bb[bj][0]) * w, v1 = (acc[ai][bj][m][1] + bb[bj][1]) * w;
                    int p0 = 0, p1 = 0;
                    p0 = __builtin_amdgcn_cvt_pk_fp8_f32(__builtin_amdgcn_fmed3f(v0[0], -448.f, 448.f), __builtin_amdgcn_fmed3f(v0[1], -448.f, 448.f), p0, false);
                    p0 = __builtin_amdgcn_cvt_pk_fp8_f32(__builtin_amdgcn_fmed3f(v0[2], -448.f, 448.f), __builtin_amdgcn_fmed3f(v0[3], -448.f, 448.f), p0, true);
                    p1 = __builtin_amdgcn_cvt_pk_fp8_f32(__builtin_amdgcn_fmed3f(v1[0], -448.f, 448.f), __builtin_amdgcn_fmed3f(v1[1], -448.f, 448.f), p1, false);
                    p1 = __builtin_amdgcn_cvt_pk_fp8_f32(__builtin_amdgcn_fmed3f(v1[2], -448.f, 448.f), __builtin_amdgcn_fmed3f(v1[3], -448.f, 448.f), p1, true);
                    u32x2 o; o.x = (unsigned)p0; o.y = (unsigned)p1; *(u32x2*)(yp + bj * HALF) = o; }
                __builtin_amdgcn_sched_barrier(0); }
    }
};
}
typedef const __attribute__((address_space(4))) unsigned long long* KargPtr;
struct InTab { KargPtr p;
    __device__ __forceinline__ const float* operator[](int i) const { KargPtr q = p; asm volatile("" : "+s"(q)); return (const float*)(const GAS float*)q[i]; } };
struct Ctx {
    LAS unsigned char* lds;
    int G, vcu;
    InTab in; float* out; unsigned char* ws;
    __device__ __forceinline__ float* MOD() const { return (float*)(ws + WS_MOD); }
    __device__ __forceinline__ unsigned* ctl() const { return (unsigned*)(ws + WS_CTL); }
};
__device__ __forceinline__ const float* modp(const Ctx& F, int l, int b, int which) { return (const float*)(F.ws + WS_MOD) + ((size_t)(l * NB + b) * 6 + which) * D; }

__device__ const double ROPE_INV_FREQ[32] = {
    1.0, 0.7498942093324559, 0.5623413251903491, 0.4216965034285822, 0.31622776601683794, 0.23713737056616552, 0.1778279410038923, 0.1333521432163324,
    0.1, 0.07498942093324559, 0.05623413251903491, 0.04216965034285822, 0.03162277660168379, 0.023713737056616554, 0.01778279410038923, 0.01333521432163324,
    0.01, 0.007498942093324559, 0.005623413251903491, 0.004216965034285822, 0.0031622776601683794, 0.0023713737056616554, 0.001778279410038923, 0.001333521432163324,
    0.001, 0.0007498942093324559, 0.0005623413251903491, 0.0004216965034285822, 0.00031622776601683794, 0.00023713737056616554, 0.0001778279410038923, 0.0001333521432163324};

__device__ __forceinline__ int map_rows(int maptype, int n0) {
    if (maptype == 1) { return n0 < 1024 ? (n0 >> 7) * 256 + (n0 & 127) : ((n0 - 1024) >> 7) * 256 + 128 + ((n0 - 1024) & 127); }
    if (maptype == 2) { const int h = n0 / QK, d = n0 - h * QK; if (d < NOPE) return h * NOPE + d; const int i = d - NOPE;
                        return 1024 + (h >> 2) * 256 + (i >> 5) * 128 + (h & 3) * 32 + (i & 31); }
    return n0;
}
struct ConvD { const float* src; unsigned char* dst; int N, Kb; };
#define CONV_DEC(Wp, wstride, nmat, K_, N_, dstoff, dstride, mt, f8_) CONV_DECP(Wp, wstride, nmat, K_, N_, N_, dstoff, dstride, mt, f8_)
#define CONV_DECP(Wp, wstride, nmat, K_, N_, pitch_, dstoff, dstride, mt, f8_) do { if ((f8_) == PASS8) { constexpr int KD = (f8_) ? 128 : 64; const int per = ((K_) / KD) * ((N_) / 32), tot = (nmat) * per; \
        if (r < tot) { const int mi = r / per, item = r - mi * per, nblk = (N_) / 32, kb = item / nblk, nb = item - kb * nblk, es = (f8_) ? 1 : 2; \
            d.src = (Wp) + (size_t)mi * (wstride) + (size_t)(KD * kb) * (pitch_) + 32 * nb; d.N = (pitch_); d.Kb = (K_) * es; \
            d.dst = F.ws + (dstoff) + ((size_t)mi * (dstride) + (size_t)map_rows((mt), 32 * nb) * (K_) + KD * kb) * es; return; } r -= tot; } } while (0)
template <int PASS8> __device__ __forceinline__ void conv_decode(const Ctx& F, int it, ConvD& d) {
    int r = it;
    CONV_DEC(F.in[23], (size_t)1024 * 2048, 128, 1024, 2048, WS_WGU, (size_t)2048 * 1024, 1, 1);
    CONV_DEC(F.in[25], (size_t)1024 * 1024, 128, 1024, 1024, WS_WDN, (size_t)1024 * 1024, 0, 1);
    CONV_DECP(F.in[7],        (size_t)1024 * 4096, 2, 1024, 1024, 4096, WS_WIN, (size_t)3072 * 1024, 0, 1);
    CONV_DECP(F.in[7] + 2048, (size_t)1024 * 4096, 2, 1024, 1024, 4096, WS_WIN + (size_t)1024 * 1024, (size_t)3072 * 1024, 0, 1);
    CONV_DECP(F.in[7] + 3072, (size_t)1024 * 4096, 2, 1024, 1024, 4096, WS_WIN + (size_t)2048 * 1024, (size_t)3072 * 1024, 0, 1);
    CONV_DECP(F.in[7] + 1024, (size_t)1024 * 4096, 2, 1024, 1024, 4096, WS_WINF, (size_t)1024 * 1024, 0, 0);
    CONV_DEC(F.in[10], (size_t)1024 * 1024, 2, 1024, 1024, WS_WOUT, (size_t)1024 * 1024, 0, 1);
    CONV_DEC(F.in[14], (size_t)0, 1, 1024, 320, WS_WDKV, (size_t)0, 0, 1);
    CONV_DEC(F.in[16], (size_t)0, 1, 256, 2048, WS_WUKV, (size_t)0, 0, 0);
    CONV_DEC(F.in[17], (size_t)1024 * 384, 2, 1024, 384, WS_WDQ, (size_t)512 * 1024, 0, 1);
    CONV_DEC(F.in[19], (size_t)384 * 1536, 2, 384, 1536, WS_WUQ, (size_t)1536 * 384, 2, 0);
    CONV_DEC(F.in[20], (size_t)1024 * 1024, 2, 1024, 1024, WS_WO, (size_t)1024 * 1024, 0, 1);
    d.src = F.in[20]; d.dst = F.ws + WS_WO; d.N = 1024; d.Kb = 2048;
}
template <int NL> __device__ __forceinline__ void conv_load(const ConvD& d, int lane, float (&wv)[NL]) {
    const float* p = d.src + (size_t)(lane >> 5) * d.N + (lane & 31);
#pragma unroll
    for (int i = 0; i < NL; ++i) wv[i] = p[(size_t)(2 * i) * d.N];
}
template <int NL, int F8> __device__ __forceinline__ void conv_store(const ConvD& d, int lane, LAS float* scr, const float (&wv)[NL]) {
    { LAS float* w = scr + (lane >> 5) * 32; const int n = lane & 31;
#pragma unroll
      for (int i = 0; i < NL; ++i) w[(2 * i) * 32 + (n ^ (i & 24))] = wv[i]; }
    LDS_WAIT(); asm volatile("" ::: "memory");
    const int c = lane & 7;
#pragma unroll
    for (int j = 0; j < 4; ++j) { const int n = (lane >> 3) + 8 * j;
        if constexpr (F8) { const LAS float* s = scr + (16 * c) * 32 + (n ^ (8 * (c & 3)));
            u32x4 o;
#pragma unroll
            for (int q = 0; q < 4; ++q) { int t = 0;
                t = __builtin_amdgcn_cvt_pk_fp8_f32(s[(4 * q) * 32] * 64.f, s[(4 * q + 1) * 32] * 64.f, t, false);
                t = __builtin_amdgcn_cvt_pk_fp8_f32(s[(4 * q + 2) * 32] * 64.f, s[(4 * q + 3) * 32] * 64.f, t, true); o[q] = (unsigned)t; }
            *(u32x4*)(d.dst + (size_t)n * d.Kb + 16 * c) = o; }
        else { const LAS float* s = scr + (8 * c) * 32 + (n ^ (8 * ((c >> 1) & 3)));
            u32x4 o;
#pragma unroll
            for (int q = 0; q < 4; ++q) o[q] = cvt_pk_bf16(s[(2 * q) * 32], s[(2 * q + 1) * 32]);
            *(u32x4*)(d.dst + (size_t)n * d.Kb + 16 * c) = o; } }
    LDS_WAIT(); asm volatile("" ::: "memory");
}
template <int PASS8> __device__ __forceinline__ void conv_pass(const Ctx& F, LAS float* scr, int gw, int NGW, int lane) {
    constexpr int NL = PASS8 ? 64 : 32;
    constexpr int TOTAL = PASS8 ? (128 * 8 * 64 + 128 * 8 * 32 + 3 * 2 * 8 * 32 + 2 * 8 * 32 + 2 * 8 * 32 + 8 * 10 + 2 * 8 * 12) : (2 * 16 * 32 + 4 * 64 + 2 * 6 * 48);
    float wa[NL], wb[NL];
    int it = gw;
    if (it < TOTAL) { ConvD da, db; conv_decode<PASS8>(F, it, da); conv_load<NL>(da, lane, wa);
        for (;;) {
            const int it1 = it + NGW; const bool h1 = it1 < TOTAL;
            if (h1) { conv_decode<PASS8>(F, it1, db); conv_load<NL>(db, lane, wb); }
            conv_store<NL, PASS8>(da, lane, scr, wa);
            if (!h1) break;
            const int it2 = it1 + NGW; const bool h2 = it2 < TOTAL;
            if (h2) { conv_decode<PASS8>(F, it2, da); conv_load<NL>(da, lane, wa); }
            conv_store<NL, PASS8>(db, lane, scr, wb);
            if (!h2) break;
            it = it2;
        } }
}
__device__ __forceinline__ void phase_convert(const Ctx& F) {
    PHASE_IDS;
    LAS float* scr = (LAS float*)(F.lds + wave * 16384);
    const int gw = F.vcu * NWAVES + wave, NGW = F.G * NWAVES;
    conv_pass<1>(F, scr, gw, NGW, lane);
    conv_pass<0>(F, scr, gw, NGW, lane);
    const int gt = (F.vcu * NTHREADS + tid), NGT = F.G * NTHREADS;
    for (int it = gt; it < DEPTH * NE * 128; it += NGT) { const int l = it >> 12, e = (it >> 7) & 31, c = it & 127;
        const float* wp = F.in[21] + (size_t)l * D * NE + (size_t)(8 * c) * NE + e;
        float w[8];
#pragma unroll
        for (int i = 0; i < 8; ++i) w[i] = wp[i * NE];
        u32x4 hi, lo;
#pragma unroll
        for (int q = 0; q < 4; ++q) { const unsigned h = cvt_pk_bf16(w[2 * q], w[2 * q + 1]); hi[q] = h;
            lo[q] = cvt_pk_bf16(w[2 * q] - __uint_as_float(h << 16), w[2 * q + 1] - __uint_as_float(h & 0xffff0000u)); }
        unsigned char* dst = F.ws + WS_WR + (size_t)l * 131072 + (size_t)e * 2048 + 16 * (c ^ (e & 15));
        *(u32x4*)dst = hi; *(u32x4*)(dst + 65536) = lo; }
    for (int i = gt; i < 192 * 1024 / 16; i += NGT) *((u32x4*)(F.ws + WS_WDKV + (size_t)320 * 1024) + i) = (u32x4){0u, 0u, 0u, 0u};
    for (int i = gt; i < 2 * 128 * 1024 / 16; i += NGT) { const int m = i / (128 * 1024 / 16), j = i - m * (128 * 1024 / 16);
        *((u32x4*)(F.ws + WS_WDQ + (size_t)m * 512 * 1024 + (size_t)384 * 1024) + j) = (u32x4){0u, 0u, 0u, 0u}; }
}

__device__ __forceinline__ void phase_mod(const Ctx& F) {
    PHASE_IDS;
    LAS float* cact = (LAS float*)(F.lds);
    LAS float* red = (LAS float*)(F.lds + 65536);
    const float* c = F.in[1];
    for (int i = tid; i < NB * D; i += NTHREADS) { const int b = i / D, k = i - b * D; cact[k * 16 + b] = fsilu(c[i]); }
    __syncthreads();
    constexpr int NTASK = (DEPTH * 6 * D + 2 * D) / 128;
    const int kq = tid >> 7, jj = tid & 127;
    for (int task = F.vcu; task < NTASK; task += F.G) {
        const int gcol = task * 128 + jj;
        const float* W; const float* bias; float* outp; int N, col, l = gcol / (6 * D);
        if (l < DEPTH) { col = gcol - l * 6 * D; N = 6 * D; W = F.in[5] + (size_t)l * D * N; bias = F.in[6] + (size_t)l * N; outp = (float*)(F.ws + WS_MOD) + (size_t)l * NB * N; }
        else { col = gcol - DEPTH * 6 * D; N = 2 * D; W = F.in[12]; bias = F.in[13]; outp = (float*)(F.ws + WS_KVMOD); }
        float acc[16];
#pragma unroll
        for (int b = 0; b < 16; ++b) acc[b] = 0.f;
#pragma unroll 8
        for (int k = kq * 256; k < kq * 256 + 256; ++k) {
            const float w = W[(size_t)k * N + col];
            const LAS f32x4* cp = (const LAS f32x4*)(cact + k * 16);
#pragma unroll
            for (int q = 0; q < 4; ++q) { const f32x4 cv = cp[q]; acc[4 * q] += cv[0] * w; acc[4 * q + 1] += cv[1] * w; acc[4 * q + 2] += cv[2] * w; acc[4 * q + 3] += cv[3] * w; }
        }
#pragma unroll
        for (int q = 0; q < 4; ++q) *(LAS f32x4*)(red + (kq * 128 + jj) * 16 + 4 * q) = (f32x4){acc[4 * q], acc[4 * q + 1], acc[4 * q + 2], acc[4 * q + 3]};
        __syncthreads();
#pragma unroll
        for (int q = 0; q < 4; ++q) { const int o = tid + q * NTHREADS, cj = o >> 4, b = o & 15;
            const float s = red[(0 * 128 + cj) * 16 + b] + red[(1 * 128 + cj) * 16 + b] + red[(2 * 128 + cj) * 16 + b] + red[(3 * 128 + cj) * 16 + b];
            const int oc = (task * 128 + cj) - (l < DEPTH ? l * 6 * D : DEPTH * 6 * D);
            outp[(size_t)b * N + oc] = s + bias[oc]; }
        __syncthreads();
    }
    const int gt = (F.vcu * NTHREADS + tid), NGT = F.G * NTHREADS;
    for (int i = gt; i < D; i += NGT) { const float l0 = F.in[8][i], l1 = F.in[8][D + i];
        ((float*)(F.ws + WS_LB))[i] = 0.f; ((float*)(F.ws + WS_LB))[D + i] = 1.0f / (1.0f + __expf(l0 - l1)); }
    const int* pos = (const int*)F.in[2];
    for (int i = gt; i < T * 32; i += NGT) { const int t = i >> 5, j = i & 31;
        const double rev = (double)pos[t] * ROPE_INV_FREQ[j] * 0.15915494309189535;
        const float fr = (float)(rev - floor(rev));
        float* rp = (float*)(F.ws + WS_ROPE) + (size_t)t * 64 + j;
        rp[0] = __builtin_amdgcn_cosf(fr); rp[32] = __builtin_amdgcn_sinf(fr); }
}

struct Row4 { f32x4 v[4]; };
__device__ __forceinline__ f32x4 bf4lo(const u32x4 w) { return (f32x4){bflo(w.x), bfhi(w.x), bflo(w.y), bfhi(w.y)}; }
__device__ __forceinline__ f32x4 bf4hi(const u32x4 w) { return (f32x4){bflo(w.z), bfhi(w.z), bflo(w.w), bfhi(w.w)}; }
__device__ __forceinline__ int row4_col(int lane, int j) { return 512 * (j >> 1) + 8 * lane + 4 * (j & 1); }
__device__ __forceinline__ Row4 ld_row_f32(const float* p, int lane) { Row4 r; const f32x4* q = (const f32x4*)p + 2 * lane;
#pragma unroll
    for (int j = 0; j < 4; ++j) r.v[j] = q[128 * (j >> 1) + (j & 1)]; return r; }
__device__ __forceinline__ void st_row_f32(float* p, int lane, const Row4& r) { f32x4* q = (f32x4*)p + 2 * lane;
#pragma unroll
    for (int j = 0; j < 4; ++j) q[128 * (j >> 1) + (j & 1)] = r.v[j]; }
__device__ __forceinline__ Row4 ld_row_bf16(const bf16_t* p, int lane) { Row4 r; const u32x4* q = (const u32x4*)p + lane;
#pragma unroll
    for (int jj = 0; jj < 2; ++jj) { const u32x4 w = q[64 * jj]; r.v[2 * jj] = (f32x4){bflo(w.x), bfhi(w.x), bflo(w.y), bfhi(w.y)}; r.v[2 * jj + 1] = (f32x4){bflo(w.z), bfhi(w.z), bflo(w.w), bfhi(w.w)}; } return r; }
__device__ __forceinline__ void st_row_bf16(bf16_t* p, int lane, const Row4& r) { u32x4* q = (u32x4*)p + lane;
#pragma unroll
    for (int jj = 0; jj < 2; ++jj) { u32x4 w; w.x = cvt_pk_bf16(r.v[2 * jj][0], r.v[2 * jj][1]); w.y = cvt_pk_bf16(r.v[2 * jj][2], r.v[2 * jj][3]);
        w.z = cvt_pk_bf16(r.v[2 * jj + 1][0], r.v[2 * jj + 1][1]); w.w = cvt_pk_bf16(r.v[2 * jj + 1][2], r.v[2 * jj + 1][3]); q[64 * jj] = w; } }
__device__ __forceinline__ void st_row_fp8(unsigned char* p, int lane, const Row4& r) { u32x2* q = (u32x2*)p + lane;
#pragma unroll
    for (int jj = 0; jj < 2; ++jj) { int w0 = 0, w1 = 0;
        w0 = __builtin_amdgcn_cvt_pk_fp8_f32(r.v[2 * jj][0], r.v[2 * jj][1], w0, false); w0 = __builtin_amdgcn_cvt_pk_fp8_f32(r.v[2 * jj][2], r.v[2 * jj][3], w0, true);
        w1 = __builtin_amdgcn_cvt_pk_fp8_f32(r.v[2 * jj + 1][0], r.v[2 * jj + 1][1], w1, false); w1 = __builtin_amdgcn_cvt_pk_fp8_f32(r.v[2 * jj + 1][2], r.v[2 * jj + 1][3], w1, true);
        u32x2 o; o.x = (unsigned)w0; o.y = (unsigned)w1; q[64 * jj] = o; } }
__device__ __forceinline__ float row_ssq(const Row4& r) { float s = 0.f;
#pragma unroll
    for (int j = 0; j < 4; ++j) s += (r.v[j][0] * r.v[j][0] + r.v[j][1] * r.v[j][1]) + (r.v[j][2] * r.v[j][2] + r.v[j][3] * r.v[j][3]);
    return wave_sum(s); }
__device__ __forceinline__ Row4 norm_mod(const Row4& x, float rstd, const float* g, const float* sc, const float* sh, int lane) {
    const Row4 gv = ld_row_f32(g, lane), scv = ld_row_f32(sc, lane), shv = ld_row_f32(sh, lane); Row4 h;
#pragma unroll
    for (int j = 0; j < 4; ++j) h.v[j] = (x.v[j] * rstd * gv.v[j]) * (scv.v[j] + 1.0f) + shv.v[j];
    return h; }

template <bool FIRST> struct CombRow;
template <> struct CombRow<true> { f32x4 xf[4]; };
template <> struct CombRow<false> { u32x4 xb[2]; u32x2 ys[4][2]; };
__device__ __forceinline__ f32x4 fp8x4(unsigned w) { const auto lo = __builtin_amdgcn_cvt_pk_f32_fp8((int)w, false), hi = __builtin_amdgcn_cvt_pk_f32_fp8((int)w, true); return (f32x4){lo[0], lo[1], hi[0], hi[1]}; }
template <bool FIRST> __device__ __forceinline__ void comb_load(CombRow<FIRST>& r, const Ctx& F, int m, int lane, int d0, int d1, int d2, int d3) {
    if constexpr (FIRST) { const f32x4* q = (const f32x4*)(F.in[0] + (size_t)m * D) + 2 * lane;
#pragma unroll
        for (int j = 0; j < 4; ++j) r.xf[j] = q[128 * (j >> 1) + (j & 1)]; }
    else { const u32x4* q = (const u32x4*)((const bf16_t*)(F.ws + WS_XB) + (size_t)m * D) + lane; r.xb[0] = q[0]; r.xb[1] = q[64];
#pragma unroll
        for (int s = 0; s < 4; ++s) { const int dr = s == 0 ? d0 : (s == 1 ? d1 : (s == 2 ? d2 : d3));
            const u32x2* y = (const u32x2*)((const unsigned char*)(F.ws + WS_YS) + (size_t)dr * D) + lane; r.ys[s][0] = y[0]; r.ys[s][1] = y[64]; } }
}
template <bool FIRST> __device__ __forceinline__ void phase_combine(const Ctx& F, int l, bool dummy = false) {
    PHASE_IDS;
    const int gw = F.vcu * NWAVES + wave, NGW = F.G * NWAVES;
    bf16_t* XB = (bf16_t*)(F.ws + (dummy ? WS_ACT + (size_t)T * D * 6 : WS_XB));
    float* Xout = dummy ? (float*)(F.ws + WS_ACT) : F.out; bf16_t* Hout = (bf16_t*)(F.ws + (dummy ? WS_ACT + (size_t)T * D * 4 : WS_H));
    for (int ch = gw; ch < T / 32; ch += NGW) {
        const int m0 = ch * 32, b = m0 / SEQ, ln = l + 1;
        Row4 gt, gm, shv;
        if (l >= 0) { gt = ld_row_f32(modp(F, l, b, 5), lane);
#pragma unroll
            for (int j = 0; j < 4; ++j) gt.v[j] *= 0.03125f; }
        if (l == DEPTH - 1) gm = ld_row_f32(F.in[27], lane);
        else { const Row4 g = ld_row_f32(F.in[3] + (size_t)ln * D, lane), sc = ld_row_f32(modp(F, ln, b, 1), lane); shv = ld_row_f32(modp(F, ln, b, 0), lane);
#pragma unroll
            for (int j = 0; j < 4; ++j) gm.v[j] = g.v[j] * (sc.v[j] + 1.0f); }
        CombRow<FIRST> cur, nxt;
        int dv0 = 0, dv1 = 0, dv2 = 0, dv3 = 0;
        if constexpr (!FIRST) { const int4 dd = *(const int4*)((const int*)(F.ws + WS_TKR) + (size_t)(m0 + (lane & 31)) * 4), ee = *(const int4*)((const int*)(F.ws + WS_TKE) + (size_t)(m0 + (lane & 31)) * 4);
            const LAS int* tab = (const LAS int*)(F.lds + LDS_TAB);
            dv0 = tab[ee.x] * MOEB + dd.x; dv1 = tab[ee.y] * MOEB + dd.y; dv2 = tab[ee.z] * MOEB + dd.z; dv3 = tab[ee.w] * MOEB + dd.w; }
#define COMB_D(r_) __shfl(dv0, (r_)), __shfl(dv1, (r_)), __shfl(dv2, (r_)), __shfl(dv3, (r_))
        comb_load<FIRST>(cur, F, m0, lane, COMB_D(0));
        for (int r = 0; r < 32; ++r) {
            const int m = m0 + r;
            if (r + 1 < 32) comb_load<FIRST>(nxt, F, m + 1, lane, COMB_D(r + 1));
            Row4 x;
            if constexpr (FIRST) {
#pragma unroll
                for (int j = 0; j < 4; ++j) x.v[j] = cur.xf[j]; }
            else {
                x.v[0] = bf4lo(cur.xb[0]); x.v[1] = bf4hi(cur.xb[0]); x.v[2] = bf4lo(cur.xb[1]); x.v[3] = bf4hi(cur.xb[1]);
                Row4 y;
                y.v[0] = fp8x4(cur.ys[0][0].x); y.v[1] = fp8x4(cur.ys[0][0].y); y.v[2] = fp8x4(cur.ys[0][1].x); y.v[3] = fp8x4(cur.ys[0][1].y);
#pragma unroll
                for (int s = 1; s < 4; ++s) { y.v[0] += fp8x4(cur.ys[s][0].x); y.v[1] += fp8x4(cur.ys[s][0].y); y.v[2] += fp8x4(cur.ys[s][1].x); y.v[3] += fp8x4(cur.ys[s][1].y); }
#pragma unroll
                for (int j = 0; j < 4; ++j) x.v[j] += gt.v[j] * y.v[j];
            }
            const float rstd = rsqrtf(row_ssq(x) * (1.0f / D) + NORM_EPS);
            if (l == DEPTH - 1) { Row4 o;
#pragma unroll
                for (int j = 0; j < 4; ++j) o.v[j] = x.v[j] * rstd * gm.v[j];
                st_row_f32(Xout + (size_t)m * D, lane, o);
            } else {
                if (l >= 0) st_row_bf16(XB + (size_t)m * D, lane, x);
                Row4 h;
#pragma unroll
                for (int j = 0; j < 4; ++j) h.v[j] = (x.v[j] * rstd) * gm.v[j] + shv.v[j];
                if (ln < NA || dummy) st_row_bf16(Hout + (size_t)m * D, lane, h);
                if (!dummy) st_row_fp8((unsigned char*)(F.ws + WS_H8) + (size_t)m * D, lane, h);
                if (l == NA - 1) {
                    const float* kvm = (const float*)(F.ws + WS_KVMOD) + (size_t)b * 2 * D;
                    const Row4 hk = norm_mod(x, rstd, F.in[11], kvm + D, kvm, lane);
                    st_row_fp8((unsigned char*)(F.ws + WS_HK) + (size_t)m * D, lane, hk);
                }
            }
            if (r + 1 < 32) cur = nxt;
        }
    }
}
__device__ __forceinline__ void phase_final_only(const Ctx& F, bool from_input) {
    PHASE_IDS;
    const int gw = F.vcu * NWAVES + wave, NGW = F.G * NWAVES;
    for (int m = gw; m < T; m += NGW) {
        Row4 x = from_input ? ld_row_f32(F.in[0] + (size_t)m * D, lane) : ld_row_bf16((const bf16_t*)(F.ws + WS_XB) + (size_t)m * D, lane);
        const float rstd = rsqrtf(row_ssq(x) * (1.0f / D) + NORM_EPS);
        const Row4 gv = ld_row_f32(F.in[27], lane); Row4 o;
#pragma unroll
        for (int j = 0; j < 4; ++j) o.v[j] = x.v[j] * rstd * gv.v[j];
        st_row_f32(F.out + (size_t)m * D, lane, o);
    }
}

__device__ __forceinline__ void phase_hgrn_gate(const Ctx& F, int l) {
    PHASE_IDS;
    const int gw = F.vcu * NWAVES + wave, NGW = F.G * NWAVES;
    const bf16_t* OO = (const bf16_t*)(F.ws + WS_OO); const bf16_t* GS = (const bf16_t*)(F.ws + WS_GS); unsigned char* OG = (unsigned char*)(F.ws + WS_OG);
    f32x4 gv[2]; { const float* g = F.in[9] + (size_t)l * HGD + 8 * (lane & 15); gv[0] = *(const f32x4*)g; gv[1] = *(const f32x4*)(g + 4); }
    for (int ch = gw; ch < T / 32; ch += NGW) {
        const u32x4* oq = (const u32x4*)(OO + (size_t)ch * 32 * D) + lane; const u32x4* gq = (const u32x4*)(GS + (size_t)ch * 32 * D) + lane;
        u32x4 co0 = oq[0], co1 = oq[64], cg0 = gq[0], cg1 = gq[64];
        for (int i = 0; i < 32; ++i) {
            u32x4 no0 = co0, no1 = co1, ng0 = cg0, ng1 = cg1;
            if (i + 1 < 32) { no0 = oq[(size_t)(i + 1) * 128]; no1 = oq[(size_t)(i + 1) * 128 + 64]; ng0 = gq[(size_t)(i + 1) * 128]; ng1 = gq[(size_t)(i + 1) * 128 + 64]; }
            Row4 o, g, r; o.v[0] = bf4lo(co0); o.v[1] = bf4hi(co0); o.v[2] = bf4lo(co1); o.v[3] = bf4hi(co1); g.v[0] = bf4lo(cg0); g.v[1] = bf4hi(cg0); g.v[2] = bf4lo(cg1); g.v[3] = bf4hi(cg1);
#pragma unroll
            for (int jh = 0; jh < 2; ++jh) {
                const f32x4 a = o.v[2 * jh], b2 = o.v[2 * jh + 1];
                float s = ((a[0] * a[0] + a[1] * a[1]) + (a[2] * a[2] + a[3] * a[3])) + ((b2[0] * b2[0] + b2[1] * b2[1]) + (b2[2] * b2[2] + b2[3] * b2[3]));
#pragma unroll
                for (int d = 1; d < 16; d <<= 1) s += __shfl_xor(s, d);
                const float rstd = rsqrtf(s * (1.0f / HGD) + NORM_EPS);
                r.v[2 * jh] = (a * rstd * gv[0]) * g.v[2 * jh]; r.v[2 * jh + 1] = (b2 * rstd * gv[1]) * g.v[2 * jh + 1];
            }
            st_row_fp8(OG + ((size_t)ch * 32 + i) * D, lane, r);
            co0 = no0; co1 = no1; cg0 = ng0; cg1 = ng1;
        }
    }
}

__device__ __forceinline__ void phase_kv_rows(const Ctx& F) {
    PHASE_IDS;
    const int gw = F.vcu * NWAVES + wave, NGW = F.G * NWAVES;
    const bf16_t* CKR = (const bf16_t*)(F.ws + WS_CKR); bf16_t* CKV = (bf16_t*)(F.ws + WS_CKV); bf16_t* KB = (bf16_t*)(F.ws + WS_KB);
    const float* rope = (const float*)(F.ws + WS_ROPE);
    const f32x4 gv = *(const f32x4*)(F.in[15] + 4 * lane);
    for (int ch = gw; ch < T / 32; ch += NGW) {
        const int i = lane & 31, hb = (lane >> 5) * 4;
        const bf16_t* rp0 = CKR + (size_t)ch * 32 * 512;
        u32x2 cw = *((const u32x2*)rp0 + lane); unsigned short c1 = rp0[KVRANK + i], c2 = rp0[KVRANK + 32 + i];
        for (int r = 0; r < 32; ++r) {
            const int m = ch * 32 + r; const bf16_t* rpn = rp0 + (size_t)(r + 1) * 512;
            u32x2 nw = cw; unsigned short n1 = c1, n2 = c2;
            if (r + 1 < 32) { nw = *((const u32x2*)rpn + lane); n1 = rpn[KVRANK + i]; n2 = rpn[KVRANK + 32 + i]; }
            const float cs = rope[(size_t)m * 64 + i], sn = rope[(size_t)m * 64 + 32 + i];
            f32x4 v = (f32x4){bflo(cw.x), bfhi(cw.x), bflo(cw.y), bfhi(cw.y)};
            const float ss = wave_sum((v[0] * v[0] + v[1] * v[1]) + (v[2] * v[2] + v[3] * v[3]));
            const float rstd = rsqrtf(ss * (1.0f / KVRANK) + NORM_EPS);
            v = v * rstd * gv;
            u32x2 o; o.x = cvt_pk_bf16(v[0], v[1]); o.y = cvt_pk_bf16(v[2], v[3]);
            *((u32x2*)(CKV + (size_t)m * KVRANK) + lane) = o;
            const float t1 = bf2f(c1), t2 = bf2f(c2);
            const float r1 = t1 * cs - t2 * sn, r2 = t2 * cs + t1 * sn;
            const unsigned short b1 = f2bf(r1), b2 = f2bf(r2);
#pragma unroll
            for (int h = 0; h < 4; ++h) { bf16_t* kp = KB + (size_t)m * (MH * QK) + (hb + h) * QK + NOPE; kp[i] = b1; kp[32 + i] = b2; }
            cw = nw; c1 = n1; c2 = n2;
        }
    }
}

__device__ __forceinline__ void phase_cq_rows(const Ctx& F, int j) {
    PHASE_IDS;
    const int gw = F.vcu * NWAVES + wave, NGW = F.G * NWAVES;
    const bf16_t* CQ = (const bf16_t*)(F.ws + WS_CQ); bf16_t* CQN = (bf16_t*)(F.ws + WS_CQN);
    const float* g = F.in[18] + (size_t)j * QRANK;
    float gq[3][2];
#pragma unroll
    for (int q = 0; q < 3; ++q) { gq[q][0] = g[128 * q + 2 * lane]; gq[q][1] = g[128 * q + 2 * lane + 1]; }
    for (int ch = gw; ch < T / 32; ch += NGW) {
        const unsigned* rp0 = (const unsigned*)(CQ + (size_t)ch * 32 * 512);
        unsigned cwv[3];
#pragma unroll
        for (int q = 0; q < 3; ++q) cwv[q] = rp0[64 * q + lane];
        for (int r = 0; r < 32; ++r) {
            const int m = ch * 32 + r; unsigned nwv[3];
#pragma unroll
            for (int q = 0; q < 3; ++q) nwv[q] = (r + 1 < 32) ? rp0[(size_t)(r + 1) * 256 + 64 * q + lane] : cwv[q];
            float v[3][2]; float s = 0.f;
#pragma unroll
            for (int q = 0; q < 3; ++q) { v[q][0] = bflo(cwv[q]); v[q][1] = bfhi(cwv[q]); s += v[q][0] * v[q][0] + v[q][1] * v[q][1]; }
            const float rstd = rsqrtf(wave_sum(s) * (1.0f / QRANK) + NORM_EPS);
            unsigned* op = (unsigned*)(CQN + (size_t)m * QRANK);
#pragma unroll
            for (int q = 0; q < 3; ++q) op[64 * q + lane] = cvt_pk_bf16(v[q][0] * rstd * gq[q][0], v[q][1] * rstd * gq[q][1]);
#pragma unroll
            for (int q = 0; q < 3; ++q) cwv[q] = nwv[q];
        }
    }
}
__device__ __forceinline__ void phase_router(const Ctx& F, int l, bool dummy = false) {
    PHASE_IDS;
    constexpr int RT0 = LDS_BLKE + NBLK_MAX * 4;
    LAS float* gmt = (LAS float*)(F.lds + RT0);
    LAS float* sht = (LAS float*)(F.lds + RT0 + 4096);
    LAS float* rst = (LAS float*)(F.lds + RT0 + 8192) + wave * 32;
    LAS int* hist = (LAS int*)(F.lds + RT0 + 9216);
    LAS int* basev = (LAS int*)(F.lds + RT0 + 9216 + 128);
    static_assert(RT0 + 9216 + 256 <= LDS_BYTES, "router LDS map");
    LAS float* lgt = (LAS float*)(F.lds) + wave * (32 * 33);
    const unsigned char* Wr = F.ws + WS_WR + (size_t)l * 131072; const float* br = F.in[22] + (size_t)l * NE;
    const bf16_t* X = (const bf16_t*)(F.ws + WS_XB); unsigned char* H = (unsigned char*)(F.ws + (dummy ? WS_ACT : WS_H));
    int* TKE = (int*)(F.ws + (dummy ? WS_YS : WS_TKE)); float* TKW = (float*)(F.ws + (dummy ? WS_YS + 4 * MiB : WS_TKW)); int* TKR = (int*)(F.ws + (dummy ? WS_YS + 8 * MiB : WS_TKR));
    unsigned* cnt = F.ctl() + CW_CNT + l * 64 + (dummy ? 1024 : 0);
    const int r32 = lane & 31, hi = lane >> 5;
    for (int bt = F.vcu; bt < T / 256; bt += F.G) {
        const int b = (bt * 256) / SEQ;
        const float* g = F.in[4] + (size_t)l * D; const float* sc = modp(F, l, b, 4); const float* sh = modp(F, l, b, 3);
        for (int i = tid; i < D; i += NTHREADS) { gmt[i] = g[i] * (1.0f + sc[i]); sht[i] = sh[i]; }
        if (tid < 32) hist[tid] = 0;
        for (int i = tid; i < 131072 / 16; i += NTHREADS) *(LAS u32x4*)(F.lds + 16 * i) = *(const u32x4*)(Wr + 16 * i);
        __syncthreads();
        const int row0 = bt * 256 + wave * 32;
        { const u32x4* xq = (const u32x4*)(X + (size_t)row0 * D) + lane;
          u32x4 c0 = xq[0], c1 = xq[64];
          for (int i = 0; i < 32; ++i) {
            u32x4 n0 = c0, n1 = c1;
            if (i + 1 < 32) { n0 = xq[(size_t)(i + 1) * 128]; n1 = xq[(size_t)(i + 1) * 128 + 64]; }
            Row4 x; x.v[0] = bf4lo(c0); x.v[1] = bf4hi(c0); x.v[2] = bf4lo(c1); x.v[3] = bf4hi(c1);
            const float rstd = rsqrtf(row_ssq(x) * (1.0f / D) + NORM_EPS);
            Row4 h;
#pragma unroll
            for (int j = 0; j < 4; ++j) { const int cc = row4_col(lane, j); const f32x4 gm = *(const LAS f32x4*)(gmt + cc), s4 = *(const LAS f32x4*)(sht + cc); h.v[j] = x.v[j] * rstd * gm + s4; }
            st_row_fp8(H + (size_t)(row0 + i) * D, lane, h);
            if (lane == 0) rst[i] = rstd;
            c0 = n0; c1 = n1;
          } }
        LDS_WAIT(); asm volatile("" ::: "memory");
        f32x16 acc = {};
        { const float rstd = rst[r32]; const bf16_t* xr = X + (size_t)(row0 + r32) * D + 8 * hi; const LAS unsigned char* wb = F.lds + r32 * 2048; const int sw = r32 & 15;
#pragma unroll 2
          for (int j = 0; j < 64; ++j) {
              const u32x4 xw = *(const u32x4*)(xr + 16 * j);
              const f32x4 gm0 = *(const LAS f32x4*)(gmt + 16 * j + 8 * hi), gm1 = *(const LAS f32x4*)(gmt + 16 * j + 8 * hi + 4), s40 = *(const LAS f32x4*)(sht + 16 * j + 8 * hi), s41 = *(const LAS f32x4*)(sht + 16 * j + 8 * hi + 4);
              const f32x4 h0 = bf4lo(xw) * rstd * gm0 + s40, h1 = bf4hi(xw) * rstd * gm1 + s41;
              const int off = 16 * ((2 * j + hi) ^ sw);
              const bf16x8 bh = *(const LAS bf16x8*)(wb + off), bl = *(const LAS bf16x8*)(wb + 65536 + off);
              u32x4 ah, al;
              ah[0] = cvt_pk_bf16(h0[0], h0[1]); ah[1] = cvt_pk_bf16(h0[2], h0[3]); ah[2] = cvt_pk_bf16(h1[0], h1[1]); ah[3] = cvt_pk_bf16(h1[2], h1[3]);
              al[0] = cvt_pk_bf16(h0[0] - __uint_as_float(ah[0] << 16), h0[1] - __uint_as_float(ah[0] & 0xffff0000u)); al[1] = cvt_pk_bf16(h0[2] - __uint_as_float(ah[1] << 16), h0[3] - __uint_as_float(ah[1] & 0xffff0000u));
              al[2] = cvt_pk_bf16(h1[0] - __uint_as_float(ah[2] << 16), h1[1] - __uint_as_float(ah[2] & 0xffff0000u)); al[3] = cvt_pk_bf16(h1[2] - __uint_as_float(ah[3] << 16), h1[3] - __uint_as_float(ah[3] & 0xffff0000u));
              const bf16x8 ahv = __builtin_bit_cast(bf16x8, ah), alv = __builtin_bit_cast(bf16x8, al);
              acc = __builtin_amdgcn_mfma_f32_32x32x16_bf16(ahv, bh, acc, 0, 0, 0);
              acc = __builtin_amdgcn_mfma_f32_32x32x16_bf16(ahv, bl, acc, 0, 0, 0);
              acc = __builtin_amdgcn_mfma_f32_32x32x16_bf16(alv, bh, acc, 0, 0, 0);
          } }
        __syncthreads();
        { const float bias = br[r32];
#pragma unroll
          for (int r = 0; r < 16; ++r) lgt[((r & 3) + 8 * (r >> 2) + 4 * hi) * 33 + r32] = acc[r] + bias; }
        LDS_WAIT(); asm volatile("" ::: "memory");
        int te[4]; float tw[4]; int tr[4];
        if (lane < 32) {
            float v[32];
#pragma unroll
            for (int e = 0; e < 32; ++e) v[e] = lgt[lane * 33 + e];
            float tv[4];
#pragma unroll
            for (int k = 0; k < 4; ++k) { float best = v[0]; int bi = 0;
#pragma unroll
                for (int e = 1; e < 32; ++e) { if (v[e] > best) { best = v[e]; bi = e; } }
                tv[k] = best; te[k] = bi;
#pragma unroll
                for (int e = 0; e < 32; ++e) v[e] = (e == bi) ? -3.0e38f : v[e]; }
            const float e1 = __expf(tv[1] - tv[0]), e2 = __expf(tv[2] - tv[0]), e3 = __expf(tv[3] - tv[0]);
            const float inv = 1.0f / (1.0f + e1 + e2 + e3);
            tw[0] = inv; tw[1] = e1 * inv; tw[2] = e2 * inv; tw[3] = e3 * inv;
#pragma unroll
            for (int k = 0; k < 4; ++k) tr[k] = __hip_atomic_fetch_add(hist + te[k], 1, __ATOMIC_RELAXED, __HIP_MEMORY_SCOPE_WORKGROUP);
        }
        __syncthreads();
        if (tid < 32) basev[tid] = (int)__hip_atomic_fetch_add(cnt + tid, (unsigned)hist[tid], RLX_AGENT);
        __syncthreads();
        if (lane < 32) {
            const int row = row0 + lane;
            int4 ev = make_int4(te[0], te[1], te[2], te[3]); *(int4*)(TKE + (size_t)row * 4) = ev;
            *(f32x4*)(TKW + (size_t)row * 4) = (f32x4){tw[0], tw[1], tw[2], tw[3]};
            int4 rv = make_int4(basev[te[0]] + tr[0], basev[te[1]] + tr[1], basev[te[2]] + tr[2], basev[te[3]] + tr[3]); *(int4*)(TKR + (size_t)row * 4) = rv;
            if (!dummy) { int* RI = (int*)(F.ws + WS_RINFO); float* RW = (float*)(F.ws + WS_RW);
                RI[(size_t)te[0] * VCAP + rv.x] = row * 4 + 0; RI[(size_t)te[1] * VCAP + rv.y] = row * 4 + 1; RI[(size_t)te[2] * VCAP + rv.z] = row * 4 + 2; RI[(size_t)te[3] * VCAP + rv.w] = row * 4 + 3;
                RW[(size_t)te[0] * VCAP + rv.x] = tw[0]; RW[(size_t)te[1] * VCAP + rv.y] = tw[1]; RW[(size_t)te[2] * VCAP + rv.z] = tw[2]; RW[(size_t)te[3] * VCAP + rv.w] = tw[3]; }
        }
        __syncthreads();
    }
}

__device__ __forceinline__ void moe_table(const Ctx& F, int l) {
    PHASE_IDS;
    LAS int* tab = (LAS int*)(F.lds + LDS_TAB);
    if (tid < 32) tab[64 + tid] = (int)__hip_atomic_load(F.ctl() + CW_CNT + l * 64 + tid, RLX_AGENT);
    __syncthreads();
    if (tid == 0) { int s = 0;
        for (int e = 0; e < 32; ++e) { tab[e] = s; s += (tab[64 + e] + MOEB - 1) / MOEB; }
        tab[32] = s; }
    __syncthreads();
    { LAS int* blke = (LAS int*)(F.lds + LDS_BLKE);
      for (int rb = tid; rb < tab[32]; rb += NTHREADS) { int e = 0;
#pragma unroll
          for (int j = 1; j < 32; ++j) e += (tab[j] <= rb) ? 1 : 0;
          blke[rb] = e; } }
    __syncthreads();
}
namespace scan {
constexpr int RS_K = 272, RS_S = 144;
constexpr int O_QT = 0, O_KT = 17408, O_QH = 34816, O_KHT = 52224, O_VT = 70656, O_SS = 79872, O_ST0 = 89088, O_ST1 = 106496, O_SEG = 123904, O_DEC = 125952;
__device__ __forceinline__ bf16x8 ldfrag(const LAS unsigned char* base, int row, int rs, int kb  ) { return *(const LAS bf16x8*)(base + row * rs + kb); }
}
__device__ __forceinline__ void phase_hgrn_scan(const Ctx& F) {
    PHASE_IDS;
    using namespace scan;
    LAS unsigned char* L = F.lds;
    const bf16_t* QH_g = (const bf16_t*)(F.ws + WS_QH); const bf16_t* KK_g = (const bf16_t*)(F.ws + WS_KK); const bf16_t* VV_g = (const bf16_t*)(F.ws + WS_VV);
    const unsigned short* LF_g = (const unsigned short*)(F.ws + WS_LF)  ; bf16_t* OO_g = (bf16_t*)(F.ws + WS_OO);
    const int w = wave, l15 = lane & 15, l4 = lane >> 4;
    const int cg = lane & 3, seg = lane >> 2, kc0 = 16 * w + 4 * cg;
    LAS float* DEC = (LAS float*)(L + O_DEC);
    for (int u = F.vcu; u < NB * HGH * 2; u += F.G) {
        const int vh = u & 1, h = (u >> 1) & 7, b = u >> 4;
        const size_t rowb = (size_t)b * SEQ; const int hk = h * HGD, hv = h * HGD + vh * 64;
        for (int i = tid; i < 64 * RS_K / 16; i += NTHREADS) *(LAS u32x4*)(L + O_ST0 + i * 16) = (u32x4){0u, 0u, 0u, 0u};
        f32x4 sacc[4];
#pragma unroll
        for (int vi = 0; vi < 4; ++vi) sacc[vi] = (f32x4){0.f, 0.f, 0.f, 0.f};
        u32x2 lfr[4]; u32x2 qr[4], kr[4]; u32x4 vw;
#define SCAN_LOAD_LF(c_) do { const size_t base_ = ((size_t)(((b * 64 + (c_)) * 8 + h) * 8 + w)) * 1024 + 4 * lane; \
            _Pragma("unroll") for (int i = 0; i < 4; ++i) lfr[i] = *(const u32x2*)(LF_g + base_ + i * 256); } while (0)
#define SCAN_LOAD_QK(c_) do { const size_t base_ = ((size_t)(((b * 64 + (c_)) * 8 + h) * 8 + w)) * 1024 + 4 * lane; \
            _Pragma("unroll") for (int i = 0; i < 4; ++i) { qr[i] = *(const u32x2*)(QH_g + base_ + i * 256); kr[i] = *(const u32x2*)(KK_g + base_ + i * 256); } } while (0)
#define SCAN_LOAD_V(c_) do { vw = *(const u32x4*)(VV_g + ((size_t)(((b * 64 + (c_)) * 8 + h) * 16 + vh * 8 + w)) * 512 + 8 * lane); } while (0)
#define SCAN_LOAD(c_) do { SCAN_LOAD_LF(c_); SCAN_LOAD_QK(c_); SCAN_LOAD_V(c_); } while (0)
        SCAN_LOAD(0);
        __syncthreads();
#ifdef MK_SCAN_PROBE
#define SP_STAMP(k_) do { if (blockIdx.x == 0 && threadIdx.x == 0) { const unsigned t_ = (unsigned)__builtin_amdgcn_s_memrealtime(); if ((k_) == MK_SCAN_PROBE) *(volatile LAS unsigned*)(F.lds + 147440) += t_ - sp_prev; sp_prev = t_; } } while (0)
        unsigned sp_prev = 0;
#else
#define SP_STAMP(k_) do { } while (0)
#endif
        for (int c = 0; c < SEQ / HGC; ++c) {
            SP_STAMP(0);
            const size_t r0 = rowb + (size_t)c * HGC;
            const LAS unsigned char* STc = L + ((c & 1) ? O_ST1 : O_ST0); LAS unsigned char* STn = L + ((c & 1) ? O_ST0 : O_ST1);
            { float cs[4][4], I[4];
#pragma unroll
              for (int j = 0; j < 4; ++j) { float run = 0.f;
#pragma unroll
                  for (int i = 0; i < 4; ++i) { const unsigned lw_ = (j < 2) ? lfr[i].x : lfr[i].y; run += (j & 1) ? f16hi(lw_) : f16lo(lw_); cs[i][j] = run; }
                  float x = run;
#pragma unroll
                  for (int d = 4; d < 64; d <<= 1) { const float y = __shfl_up(x, d); if (lane >= d) x += y; }
                  I[j] = x; }
              float qv[4][4], kv[4][4];
#pragma unroll
              for (int i = 0; i < 4; ++i) { qv[i][0] = bflo(qr[i].x); qv[i][1] = bfhi(qr[i].x); qv[i][2] = bflo(qr[i].y); qv[i][3] = bfhi(qr[i].y);
                  kv[i][0] = bflo(kr[i].x); kv[i][1] = bfhi(kr[i].x); kv[i][2] = bflo(kr[i].y); kv[i][3] = bfhi(kr[i].y); }
              float qt[4][4], kt[4][4], qh[4][4], kh[4][4];
#pragma unroll
              for (int j = 0; j < 4; ++j) { const float ref = __shfl(I[j], cg + 28), last = __shfl(I[j], cg + 60), P = I[j] - cs[3][j];
                  const float eref = __expf(ref), elr = __expf(last - ref);
                  if (seg == 0) DEC[kc0 + j] = eref * elr;
#pragma unroll
                  for (int i = 0; i < 4; ++i) { const float d = fminf(fmaxf(P + cs[i][j] - ref, -60.f), 60.f); const float E = __expf(d), R = __builtin_amdgcn_rcpf(E);
                      qt[i][j] = qv[i][j] * E; kt[i][j] = kv[i][j] * R; qh[i][j] = qt[i][j] * eref; kh[i][j] = kt[i][j] * elr; } }
#pragma unroll
              for (int i = 0; i < 4; ++i) { const int ro = (4 * seg + i) * RS_K + kc0 * 2; u32x2 o;
                  o.x = cvt_pk_bf16(qt[i][0], qt[i][1]); o.y = cvt_pk_bf16(qt[i][2], qt[i][3]); *(LAS u32x2*)(L + O_QT + ro) = o;
                  o.x = cvt_pk_bf16(kt[i][0], kt[i][1]); o.y = cvt_pk_bf16(kt[i][2], kt[i][3]); *(LAS u32x2*)(L + O_KT + ro) = o;
                  o.x = cvt_pk_bf16(qh[i][0], qh[i][1]); o.y = cvt_pk_bf16(qh[i][2], qh[i][3]); *(LAS u32x2*)(L + O_QH + ro) = o; }
#pragma unroll
              for (int j = 0; j < 4; ++j) { u32x2 o; o.x = cvt_pk_bf16(kh[0][j], kh[1][j]); o.y = cvt_pk_bf16(kh[2][j], kh[3][j]); *(LAS u32x2*)(L + O_KHT + (kc0 + j) * RS_S + seg * 8) = o; }
              LAS unsigned short* vt = (LAS unsigned short*)(L + O_VT + (8 * w) * RS_S) + lane;
              vt[0 * (RS_S / 2)] = (unsigned short)(vw.x & 0xffffu); vt[1 * (RS_S / 2)] = (unsigned short)(vw.x >> 16);
              vt[2 * (RS_S / 2)] = (unsigned short)(vw.y & 0xffffu); vt[3 * (RS_S / 2)] = (unsigned short)(vw.y >> 16);
              vt[4 * (RS_S / 2)] = (unsigned short)(vw.z & 0xffffu); vt[5 * (RS_S / 2)] = (unsigned short)(vw.z >> 16);
              vt[6 * (RS_S / 2)] = (unsigned short)(vw.w & 0xffffu); vt[7 * (RS_S / 2)] = (unsigned short)(vw.w >> 16); }
            SP_STAMP(1);
            __syncthreads();
            SP_STAMP(2);
            if (c + 1 < SEQ / HGC) SCAN_LOAD_LF(c + 1);
#pragma unroll
            for (int q = 0; q < 2; ++q) { const int id = 2 * w + q, si = id >> 2, ti = id & 3;
                f32x4 a = (f32x4){0.f, 0.f, 0.f, 0.f};
                if (si <= ti) {
#pragma unroll
                    for (int ks = 0; ks < 4; ++ks) a = __builtin_amdgcn_mfma_f32_16x16x32_bf16(ldfrag(L + O_KT, si * 16 + l15, RS_K, ks * 64 + l4 * 16), ldfrag(L + O_QT, ti * 16 + l15, RS_K, ks * 64 + l4 * 16), a, 0, 0, 0);
                }
                const int t = ti * 16 + l15, s0 = si * 16 + l4 * 4;
#pragma unroll
                for (int r = 0; r < 4; ++r) a[r] = (s0 + r <= t) ? a[r] : 0.f;
                u32x2 o; o.x = cvt_pk_bf16(a[0], a[1]); o.y = cvt_pk_bf16(a[2], a[3]);
                *(LAS u32x2*)(L + O_SS + t * RS_S + s0 * 2) = o; }
            __syncthreads();
            SP_STAMP(3);
            if (c + 1 < SEQ / HGC) SCAN_LOAD_QK(c + 1);
#pragma unroll
            for (int q = 0; q < 2; ++q) { const int id = 2 * w + q, vi = id >> 2, ti = id & 3;
                f32x4 a = (f32x4){0.f, 0.f, 0.f, 0.f};
#pragma unroll
                for (int ks = 0; ks < 2; ++ks) a = __builtin_amdgcn_mfma_f32_16x16x32_bf16(ldfrag(L + O_VT, vi * 16 + l15, RS_S, ks * 64 + l4 * 16), ldfrag(L + O_SS, ti * 16 + l15, RS_S, ks * 64 + l4 * 16), a, 0, 0, 0);
#pragma unroll
                for (int ks = 0; ks < 4; ++ks) a = __builtin_amdgcn_mfma_f32_16x16x32_bf16(ldfrag(STc, vi * 16 + l15, RS_K, ks * 64 + l4 * 16), ldfrag(L + O_QH, ti * 16 + l15, RS_K, ks * 64 + l4 * 16), a, 0, 0, 0);
                const int t = ti * 16 + l15, v0 = vi * 16 + l4 * 4;
                u32x2 o; o.x = cvt_pk_bf16(a[0], a[1]); o.y = cvt_pk_bf16(a[2], a[3]);
                *(u32x2*)(OO_g + (r0 + t) * D + hv + v0) = o; }
            if (c + 1 < SEQ / HGC) SCAN_LOAD_V(c + 1);
            { const f32x4 dec = *(const LAS f32x4*)(DEC + w * 16 + l4 * 4);
              const bf16x8 ka0 = ldfrag(L + O_KHT, w * 16 + l15, RS_S, l4 * 16), ka1 = ldfrag(L + O_KHT, w * 16 + l15, RS_S, 64 + l4 * 16);
#pragma unroll
              for (int vi = 0; vi < 4; ++vi) { f32x4 a = sacc[vi] * dec;
                  a = __builtin_amdgcn_mfma_f32_16x16x32_bf16(ka0, ldfrag(L + O_VT, vi * 16 + l15, RS_S, l4 * 16), a, 0, 0, 0);
                  a = __builtin_amdgcn_mfma_f32_16x16x32_bf16(ka1, ldfrag(L + O_VT, vi * 16 + l15, RS_S, 64 + l4 * 16), a, 0, 0, 0);
                  sacc[vi] = a;
                  u32x2 o; o.x = cvt_pk_bf16(a[0], a[1]); o.y = cvt_pk_bf16(a[2], a[3]);
                  *(LAS u32x2*)(STn + (vi * 16 + l15) * RS_K + (w * 16 + l4 * 4) * 2) = o; } }
            SP_STAMP(4);
            __syncthreads();
            SP_STAMP(5);
        }
#undef SCAN_LOAD
#undef SCAN_LOAD_LF
#undef SCAN_LOAD_QK
#undef SCAN_LOAD_V
    }
}
namespace mla {
constexpr int QBLK = 32, KVBLK = 64, QB = 256;
constexpr int SHM_V = KVBLK * VD * 2  , SHM_K = KVBLK * QK * 2  ;
constexpr int O_V = 0, O_K = 2 * SHM_V, O_WS = 2 * SHM_V + 2 * SHM_K;
constexpr float SCALE = 0.07216878364870322f;
#define KSWZ192(row, colB) ((row) * 384 + ((colB) ^ (((row) & 7) << 4)))
#define SBAR() __builtin_amdgcn_sched_barrier(0)
__device__ __forceinline__ int v_st(int k, int c) { const int kk = (k & ~0xC) | ((k & 4) << 1) | ((k & 8) >> 1); return ((kk >> 3) * 4 + (c >> 5)) * 512 + ((kk & 7) * 32 + (c & 31)) * 2; }
__device__ __forceinline__ int v_rd_base(int lane) { return ((lane & 3) << 3) | (((lane >> 2) & 3) << 6) | (((lane >> 4) & 1) << 5) | (((lane >> 5) & 1) << 8); }
constexpr int v_rd_off(int d0, int ks, int half) { return d0 * 512 + ks * 4096 + half * 2048; }
__device__ __forceinline__ int crow(int r, int hi) { return (r & 3) + 8 * (r >> 2) + 4 * hi; }
__device__ __forceinline__ void mask_tile(f32x16& p0, f32x16& p1, int dq) {
    const float NEG = -__builtin_inff();
#pragma unroll
    for (int r = 0; r < 16; ++r) { const int c = (r & 3) + 8 * (r >> 2); if (dq - c < 0) p0[r] = NEG; if (dq - c - 32 < 0) p1[r] = NEG; }
}
__device__ __forceinline__ void partialSM(f32x16& p0, f32x16& p1, float& m_reg, float& mn, float& alpha) {
    float pmax = p0[0];
#pragma unroll
    for (int r = 1; r < 16; ++r) pmax = fmaxf(pmax, p0[r]);
#pragma unroll
    for (int r = 0; r < 16; ++r) pmax = fmaxf(pmax, p1[r]);
    { auto rr = __builtin_amdgcn_permlane32_swap(__float_as_uint(pmax), __float_as_uint(pmax), false, false);
      pmax = fmaxf(__uint_as_float(rr[0]), __uint_as_float(rr[1])); }
    constexpr float C2 = 1.4426950408889634f * SCALE;
    constexpr float THR = 8.f;
    if (__builtin_expect(__all((pmax - m_reg) * SCALE <= THR), 1)) { mn = m_reg; alpha = 1.f; }
    else { mn = fmaxf(m_reg, pmax); alpha = __builtin_amdgcn_exp2f((m_reg - mn) * C2); m_reg = mn; }
    const float mnL = -mn * C2;
#pragma unroll
    for (int r = 0; r < 16; ++r) p0[r] = fmaf(p0[r], C2, mnL);
#pragma unroll
    for (int r = 0; r < 16; ++r) p1[r] = fmaf(p1[r], C2, mnL);
#pragma unroll
    for (int r = 0; r < 16; ++r) p0[r] = __builtin_amdgcn_exp2f(p0[r]);
}
__device__ __forceinline__ void finishSM(f32x16& p0, f32x16& p1, float alpha, float& l_reg, bf16x8& pa0, bf16x8& pa1, bf16x8& pa2, bf16x8& pa3) {
#pragma unroll
    for (int r = 0; r < 16; ++r) p1[r] = __builtin_amdgcn_exp2f(p1[r]);
    float ps = 0;
#pragma unroll
    for (int r = 0; r < 16; ++r) ps += p0[r];
#pragma unroll
    for (int r = 0; r < 16; ++r) ps += p1[r];
    { auto rr = __builtin_amdgcn_permlane32_swap(__float_as_uint(ps), __float_as_uint(ps), false, false);
      ps = __uint_as_float(rr[0]) + __uint_as_float(rr[1]); }
    l_reg = l_reg * alpha + ps;
#define PK4(P, B_, OUT) do { unsigned a0 = cvt_pk_bf16(P[B_+0], P[B_+1]), a1 = cvt_pk_bf16(P[B_+2], P[B_+3]);                          \
        unsigned b0 = cvt_pk_bf16(P[B_+4], P[B_+5]), b1 = cvt_pk_bf16(P[B_+6], P[B_+7]);                                             \
        auto r0 = __builtin_amdgcn_permlane32_swap(a0, b0, false, false); auto r1 = __builtin_amdgcn_permlane32_swap(a1, b1, false, false); \
        u32x4 w = {r0[0], r1[0], r0[1], r1[1]}; OUT = *reinterpret_cast<bf16x8*>(&w); } while (0)
    PK4(p0, 0, pa0); PK4(p0, 8, pa1); PK4(p1, 0, pa2); PK4(p1, 8, pa3);
#undef PK4
}
template <int KB>
__device__ __forceinline__ void qkt(f32x16& p0, f32x16& p1, const LAS unsigned char* K_lds, int r32, int hi, const bf16x8* qr) {
    p0 = f32x16{}; p1 = f32x16{};
    const LAS unsigned char* kb[4];
#pragma unroll
    for (int dd = 0; dd < 4; ++dd) kb[dd] = K_lds + KB * SHM_K + KSWZ192(r32, (dd * 16 + hi * 8) * 2);
#pragma unroll
    for (int g = 0; g < 3; ++g) {
        bf16x8 b0[4], b1[4];
#pragma unroll
        for (int dd = 0; dd < 4; ++dd) { const LAS unsigned char* a = kb[dd] + g * 128;
            b0[dd] = *reinterpret_cast<const LAS bf16x8*>(a); b1[dd] = *reinterpret_cast<const LAS bf16x8*>(a + 32 * 384); }
#pragma unroll
        for (int dd = 0; dd < 4; ++dd) {
            p0 = __builtin_amdgcn_mfma_f32_32x32x16_bf16(b0[dd], qr[4 * g + dd], p0, 0, 0, 0);
            p1 = __builtin_amdgcn_mfma_f32_32x32x16_bf16(b1[dd], qr[4 * g + dd], p1, 0, 0, 0); }
        SBAR();
    }
}
template <int KB>
__device__ __forceinline__ void qkt_sm(f32x16& n0, f32x16& n1, const LAS unsigned char* K_lds, int r32, int hi, const bf16x8* qr,
                                       f32x16& p0, f32x16& p1, float& m_reg, float& alpha, float& l_reg, bf16x8& pa0, bf16x8& pa1, bf16x8& pa2, bf16x8& pa3) {
    n0 = f32x16{}; n1 = f32x16{};
    const LAS unsigned char* kb[4];
#pragma unroll
    for (int dd = 0; dd < 4; ++dd) kb[dd] = K_lds + KB * SHM_K + KSWZ192(r32, (dd * 16 + hi * 8) * 2);
    SBAR();
    float pmax = p0[0];
#pragma unroll
    for (int r = 1; r < 16; ++r) pmax = fmaxf(pmax, p0[r]);
#pragma unroll
    for (int r = 0; r < 16; ++r) pmax = fmaxf(pmax, p1[r]);
    { auto rr = __builtin_amdgcn_permlane32_swap(__float_as_uint(pmax), __float_as_uint(pmax), false, false);
      pmax = fmaxf(__uint_as_float(rr[0]), __uint_as_float(rr[1])); }
    constexpr float C2 = 1.4426950408889634f * SCALE;
    constexpr float THR = 8.f;
    const bool keep = __all((pmax - m_reg) * SCALE <= THR);
    const float mn = keep ? m_reg : fmaxf(m_reg, pmax);
    alpha = __builtin_amdgcn_exp2f((m_reg - mn) * C2);
    m_reg = mn;
    const float mnL = -mn * C2;
#pragma unroll
    for (int r = 0; r < 16; ++r) { p0[r] = __builtin_amdgcn_exp2f(fmaf(p0[r], C2, mnL)); p1[r] = __builtin_amdgcn_exp2f(fmaf(p1[r], C2, mnL)); }
    float ps = 0;
#pragma unroll
    for (int r = 0; r < 16; ++r) ps += p0[r] + p1[r];
    { auto rr = __builtin_amdgcn_permlane32_swap(__float_as_uint(ps), __float_as_uint(ps), false, false);
      ps = __uint_as_float(rr[0]) + __uint_as_float(rr[1]); }
    l_reg = l_reg * alpha + ps;
#define PK4(P, B_, OUT) do { unsigned a0 = cvt_pk_bf16(P[B_+0], P[B_+1]), a1 = cvt_pk_bf16(P[B_+2], P[B_+3]);                          \
        unsigned b0 = cvt_pk_bf16(P[B_+4], P[B_+5]), b1 = cvt_pk_bf16(P[B_+6], P[B_+7]);                                             \
        auto r0 = __builtin_amdgcn_permlane32_swap(a0, b0, false, false); auto r1 = __builtin_amdgcn_permlane32_swap(a1, b1, false, false); \
        u32x4 w = {r0[0], r1[0], r0[1], r1[1]}; OUT = *reinterpret_cast<bf16x8*>(&w); } while (0)
    PK4(p0, 0, pa0); PK4(p0, 8, pa1); PK4(p1, 0, pa2); PK4(p1, 8, pa3);
#undef PK4
#pragma unroll
    for (int g = 0; g < 3; ++g) {
#pragma unroll
        for (int hh = 0; hh < 2; ++hh) {
            bf16x8 bq[4];
#pragma unroll
            for (int dd = 0; dd < 4; ++dd) bq[dd] = *reinterpret_cast<const LAS bf16x8*>(kb[dd] + g * 128 + hh * (32 * 384));
#pragma unroll
            for (int dd = 0; dd < 4; ++dd) { if (hh == 0) n0 = __builtin_amdgcn_mfma_f32_32x32x16_bf16(bq[dd], qr[4 * g + dd], n0, 0, 0, 0);
                                             else n1 = __builtin_amdgcn_mfma_f32_32x32x16_bf16(bq[dd], qr[4 * g + dd], n1, 0, 0, 0); } } }
#pragma unroll
    for (int g = 0; g < 6; ++g) {
        __builtin_amdgcn_sched_group_barrier(0x100, 4, 0);
        __builtin_amdgcn_sched_group_barrier(0x402, 8, 0);
#pragma unroll
        for (int i = 0; i < 4; ++i) { __builtin_amdgcn_sched_group_barrier(0x008, 1, 0); __builtin_amdgcn_sched_group_barrier(0x402, 6, 0); }
    }
    SBAR();
}
template <int VB>
__device__ __forceinline__ void pv_tile(f32x16* o, int vb0, bf16x8 pa0, bf16x8 pa1, bf16x8 pa2, bf16x8 pa3) {
#define TRRD(dst, off) asm volatile("ds_read_b64_tr_b16 %0, %1 offset:%2" : "=&v"(dst) : "v"(vb0), "i"(off) : "memory")
#define PV_D0(d0) do { s16x4 l0, l1, l2, l3, h0, h1, h2, h3; constexpr int b_ = VB * SHM_V + v_rd_off(d0, 0, 0); \
        TRRD(l0, b_); TRRD(h0, b_ + 2048); TRRD(l1, b_ + 4096); TRRD(h1, b_ + 6144); TRRD(l2, b_ + 8192); TRRD(h2, b_ + 10240); TRRD(l3, b_ + 12288); TRRD(h3, b_ + 14336); \
        asm volatile("s_waitcnt lgkmcnt(0)" ::: "memory"); SBAR(); \
        o[d0] = __builtin_amdgcn_mfma_f32_32x32x16_bf16(pa0, (bf16x8){l0[0], l0[1], l0[2], l0[3], h0[0], h0[1], h0[2], h0[3]}, o[d0], 0, 0, 0);   \
        o[d0] = __builtin_amdgcn_mfma_f32_32x32x16_bf16(pa1, (bf16x8){l1[0], l1[1], l1[2], l1[3], h1[0], h1[1], h1[2], h1[3]}, o[d0], 0, 0, 0);   \
        o[d0] = __builtin_amdgcn_mfma_f32_32x32x16_bf16(pa2, (bf16x8){l2[0], l2[1], l2[2], l2[3], h2[0], h2[1], h2[2], h2[3]}, o[d0], 0, 0, 0);   \
        o[d0] = __builtin_amdgcn_mfma_f32_32x32x16_bf16(pa3, (bf16x8){l3[0], l3[1], l3[2], l3[3], h3[0], h3[1], h3[2], h3[3]}, o[d0], 0, 0, 0); } while (0)
    PV_D0(0); PV_D0(1); PV_D0(2); PV_D0(3);
#undef PV_D0
#undef TRRD
}
}

__device__ __forceinline__ void attn_block(const Ctx& F, int b, int h, int qb) {
    using namespace mla;
    PHASE_IDS;
    LAS unsigned char* L = F.lds;
    const bf16_t* Qg = (const bf16_t*)(F.ws + WS_QB); const bf16_t* Kg = (const bf16_t*)(F.ws + WS_KB); const bf16_t* Vg = (const bf16_t*)(F.ws + WS_VB); unsigned char* Og = (unsigned char*)(F.ws + WS_AO);
    const int wid = wave, r32 = lane & 31, hi = lane >> 5;
    const size_t rowb = (size_t)b * SEQ; const int P0 = qb * QB;
    const int NT = (P0 + QB) / KVBLK;
    LAS unsigned char* V_lds = L + O_V; LAS unsigned char* K_lds = L + O_K;
    LAS float* wsf = (LAS float*)(L + O_WS) + wid * 64; LAS float* li_l = wsf; LAS float* al_l = wsf + 32;
    const bf16_t* Kh = Kg + rowb * (MH * QK) + h * QK; const bf16_t* Vh = Vg + rowb * D + h * VD;
#define KOFF_(i_) ({ const int p_ = (wid + 8 * (i_)) * 64 + lane, row_ = p_ / 24, cs_ = p_ - row_ * 24, ch_ = cs_ ^ (row_ & 7); (unsigned)(row_ * (MH * QK) + ch_ * 8) * 2u; })
#define VOFF_(i_) ({ const int p_ = (wid + 8 * (i_)) * 64 + lane, sub_ = p_ >> 5, r_ = p_ & 31, kk_ = (sub_ >> 2) * 8 + (r_ >> 2), k_ = (kk_ & ~0xC) | ((kk_ & 4) << 1) | ((kk_ & 8) >> 1), c_ = (sub_ & 3) * 32 + (r_ & 3) * 8; (unsigned)(k_ * D + c_) * 2u; })
    const unsigned koff0 = KOFF_(0), koff1 = KOFF_(1), koff2 = KOFF_(2), voff0 = VOFF_(0), voff1 = VOFF_(1);
#undef KOFF_
#undef VOFF_
    const int vb0 = (int)(uintptr_t)V_lds + v_rd_base(lane);
    bf16x8 qr[12];
    { const bf16_t* qp = Qg + (rowb + P0 + wid * QBLK + r32) * (MH * QK) + h * QK + hi * 8;
#pragma unroll
      for (int d0 = 0; d0 < 12; ++d0) qr[d0] = *(const bf16x8*)(qp + d0 * 16); }
#define DMA(t, bf) do { const char* kp_ = (const char*)(Kh + (size_t)(t) * KVBLK * (MH * QK)); const char* vp_ = (const char*)(Vh + (size_t)(t) * KVBLK * D); \
        glds16s(kp_, koff0, klds0 + (bf) * SHM_K + wid * 1024); glds16s(kp_, koff1, klds0 + (bf) * SHM_K + (wid + 8) * 1024); glds16s(kp_, koff2, klds0 + (bf) * SHM_K + (wid + 16) * 1024); \
        glds16s(vp_, voff0, vlds0 + (bf) * SHM_V + wid * 1024); glds16s(vp_, voff1, vlds0 + (bf) * SHM_V + (wid + 8) * 1024); } while (0)
    const unsigned klds0 = (unsigned)(uintptr_t)K_lds, vlds0 = (unsigned)(uintptr_t)V_lds;
    { const char* kp_ = (const char*)Kh; glds16s(kp_, koff0, klds0 + wid * 1024); glds16s(kp_, koff1, klds0 + (wid + 8) * 1024); glds16s(kp_, koff2, klds0 + (wid + 16) * 1024); } VM_WAIT();
    __syncthreads();
    float m_reg = -1e30f, l_reg = 0.f, mn, alpha; f32x16 o[4] = {}; f32x16 p0, p1; bf16x8 pa0, pa1, pa2, pa3;
    const int qlo = P0 + wid * QBLK, qm = qlo + r32 - 4 * hi;
#define RESC(a) do { if (__any((a) < 1.f)) { if (hi == 0) al_l[r32] = (a); LDS_WAIT(); \
        _Pragma("unroll") for (int d_ = 0; d_ < 4; ++d_) _Pragma("unroll") for (int r = 0; r < 16; ++r) o[d_][r] *= al_l[crow(r, hi)]; } } while (0)
#ifdef MK_ATT_PROBE
#define AT_STAMP(k_) do { if (blockIdx.x == 0 && threadIdx.x == 0) { const unsigned t_ = (unsigned)__builtin_amdgcn_s_memrealtime(); if ((k_) == MK_ATT_PROBE) *(volatile LAS unsigned*)(F.lds + 147440) += t_ - at_prev; at_prev = t_; } } while (0)
    unsigned at_prev = 0;
#else
#define AT_STAMP(k_) do { } while (0)
#endif
#define DMA_K(t, bf) do { const char* kp_ = (const char*)(Kh + (size_t)(t) * KVBLK * (MH * QK)); \
        glds16s(kp_, koff0, klds0 + (bf) * SHM_K + wid * 1024); glds16s(kp_, koff1, klds0 + (bf) * SHM_K + (wid + 8) * 1024); glds16s(kp_, koff2, klds0 + (bf) * SHM_K + (wid + 16) * 1024); } while (0)
#define DMA_V(t, bf) do { const char* vp_ = (const char*)(Vh + (size_t)(t) * KVBLK * D); \
        glds16s(vp_, voff0, vlds0 + (bf) * SHM_V + wid * 1024); glds16s(vp_, voff1, vlds0 + (bf) * SHM_V + (wid + 8) * 1024); } while (0)
#define MASKT(P0_, P1_, t_) do { const int kb_ = (t_) * KVBLK; if (kb_ + KVBLK - 1 > qlo) mask_tile(P0_, P1_, qm - kb_); } while (0)
#define STEPP(s, CB, PN0, PN1, PO0, PO1) do { \
        AT_STAMP(0); \
        if ((s) + 1 < NT) DMA_K((s) + 1, 1 - (CB)); \
        DMA_V((s), (CB)); \
        qkt_sm<CB>(PN0, PN1, K_lds, r32, hi, qr, PO0, PO1, m_reg, alpha, l_reg, pa0, pa1, pa2, pa3); AT_STAMP(1); \
        MASKT(PN0, PN1, (s)); AT_STAMP(2); \
        RESC(alpha); AT_STAMP(3); \
        pv_tile<1 - (CB)>(o, vb0, pa0, pa1, pa2, pa3); AT_STAMP(4); \
        VM_WAIT(); \
        __syncthreads(); AT_STAMP(5); } while (0)
    f32x16 q0, q1;
    { DMA_K(1, 1); DMA_V(0, 0); SBAR(); qkt<0>(p0, p1, K_lds, r32, hi, qr); MASKT(p0, p1, 0); VM_WAIT(); __syncthreads(); }
    for (int s = 1; s + 1 < NT; s += 2) { STEPP(s, 1, q0, q1, p0, p1); STEPP(s + 1, 0, p0, p1, q0, q1); }
    STEPP(NT - 1, 1, q0, q1, p0, p1);
    { partialSM(q0, q1, m_reg, mn, alpha); finishSM(q0, q1, alpha, l_reg, pa0, pa1, pa2, pa3); SBAR(); RESC(alpha); pv_tile<1>(o, vb0, pa0, pa1, pa2, pa3); }
    if (hi == 0) li_l[r32] = l_reg; LDS_WAIT();
    float rli[16];
#pragma unroll
    for (int r = 0; r < 16; ++r) rli[r] = __builtin_amdgcn_rcpf(li_l[crow(r, hi)]);
    unsigned char* Ow = Og + (rowb + P0 + wid * QBLK) * D + h * VD;
#pragma unroll
    for (int r = 0; r < 16; ++r) { const int orow = crow(r, hi);
#pragma unroll
        for (int d0 = 0; d0 < 4; ++d0) { const float v = o[d0][r] * rli[r]; const float vn = __shfl_xor(v, 1);
            if ((r32 & 1) == 0) *(unsigned short*)(Ow + (size_t)orow * D + d0 * 32 + r32) = (unsigned short)__builtin_amdgcn_cvt_pk_fp8_f32(v, vn, 0, false); } }
    __syncthreads();
#undef DMA
#undef DMA_K
#undef DMA_V
#undef MASKT
#undef RESC
#undef STEPP
}
__device__ __forceinline__ void phase_attn(const Ctx& F) {
    constexpr int NQB = SEQ / 256, NITEM = NB * MH * (NQB / 2);
    for (int L = F.vcu; L < NITEM; L += F.G) {
        const int bh = L / (NQB / 2), x = L - bh * (NQB / 2);
        attn_block(F, bh / MH, bh % MH, NQB - 1 - x);
        attn_block(F, bh / MH, bh % MH, x);
    }
}
constexpr int NP = 13, NSTEPS = 2 + DEPTH * NP;
__host__ __device__ constexpr bool step_applies(int st) {
    if (st < 2) return true;
    const int l = (st - 2) / NP, p = (st - 2) % NP;
    if (p == 3) return l >= NA;
    if (p >= 10 || p == 6) return false;
    return true;
}
struct Args { const float* in[28]; float* out; unsigned char* ws; int lo, hi, final_only, pad; };

__global__ void __launch_bounds__(NTHREADS, 2) fwd_kernel(Args args) {
    extern __shared__ __attribute__((aligned(16))) unsigned char lds_raw[];
    Ctx F;
    F.lds = (LAS unsigned char*)lds_raw;
    F.G = gridDim.x; { const int bx = blockIdx.x; F.vcu = (F.G % 8 == 0) ? (bx % 8) * (F.G / 8) + bx / 8 : bx; }
    F.in.p = (KargPtr)__builtin_amdgcn_kernarg_segment_ptr();
    F.out = args.out; F.ws = args.ws;
    volatile LAS unsigned* MISC = (volatile LAS unsigned*)(F.lds + LDS_MISC);
    if (threadIdx.x < 64) MISC[threadIdx.x] = 0u;
    __syncthreads();
#if MK_ONE_LAUNCH
    (void)xcd_barrier_post(F.ctl() + CW_BAR, MISC);
#endif
    const int lo = args.lo, hi = args.hi;
    bool did = false;
#if defined(MK_SCAN_PROBE) || defined(MK_ATT_PROBE)
    if (threadIdx.x == 0) *(volatile LAS unsigned*)(F.lds + 147440) = 0u;
#endif
#ifdef MK_PROBE_MASK
    unsigned long long pr_prev = 0, pr_acc = 0; bool pr_on = false;
#define PR_STAMP(st_) do { if (blockIdx.x == 0 && threadIdx.x == 0) { const unsigned long long t_ = __builtin_amdgcn_s_memrealtime(); if (pr_on) pr_acc += t_ - pr_prev; pr_prev = t_; \
        const int s_ = (st_); int c_ = -1; if (s_ >= 0) { if (s_ < 2) c_ = 26 + s_; else { const int l_ = (s_ - 2) / NP, p_ = (s_ - 2) % NP; c_ = (p_ < 4 && l_ >= NA) ? 13 + p_ : p_; } } \
        pr_on = (c_ >= 0) && (((unsigned long long)(MK_PROBE_MASK) >> c_) & 1ull); } } while (0)
#else
#define PR_STAMP(st_) do { } while (0)
#endif
#if MK_ONE_LAUNCH
#define PHASE_LAUNDER { GAS unsigned char* w_ = (GAS unsigned char*)F.ws; GAS float* o_ = (GAS float*)F.out; int g_ = F.G, v_ = F.vcu; asm volatile("" : "+s"(w_), "+s"(o_), "+s"(g_), "+s"(v_)); F.ws = (unsigned char*)w_; F.out = (float*)o_; F.G = g_; F.vcu = v_; }
#define PHASE_BEGIN(stp) if ((stp) >= lo && (stp) < hi) { if (did) { XcdBarrier b_; b_.bar = F.ctl() + CW_BAR; b_.x = xb_xcc_id(); b_.st = (volatile LAS unsigned*)(F.lds + LDS_MISC); xcd_barrier(b_); } did = true; PR_STAMP(stp); PHASE_LAUNDER
#else
#define PHASE_BEGIN(st) if ((st) >= lo && (st) < hi) { did = true; PHASE_LAUNDER
#endif
#define PHASE_END }

    if (args.final_only) { phase_final_only(F, args.final_only == 1); return; }

    PHASE_BEGIN(0) phase_mod(F); __syncthreads(); phase_convert(F); PHASE_END
    PHASE_BEGIN(1) phase_combine<true>(F, -1); PHASE_END

    { constexpr int l = 0;
    {
        const int sb = 2 + l * NP;
        if (l < NA) {
            PHASE_BEGIN(sb + 0) {
                { pg8::PlainSched S; S.init(T, 3072, F.G, (int)blockIdx.x); S.Bt = (const char*)(F.ws + WS_WIN) + (size_t)l * 3072 * 1024; S.K = 1024;
                  pg8::EpiHgrnIn E{(bf16_t*)(F.ws + WS_QH), (float*)(F.ws + WS_LF), (const float*)(F.ws + WS_LB) + (size_t)l * D, 0x320, 0.015625f};
                  pg8::gemm_phase<true>(F.lds, (const char*)(F.ws + WS_H8), 1024, S, E); }
                { pg8::PlainSched S; S.init(T, 1024, F.G, (int)blockIdx.x); S.Bt = (const char*)(F.ws + WS_WINF) + (size_t)l * 1024 * 1024 * 2; S.K = 2048;
                  pg8::EpiHgrnIn E{(bf16_t*)(F.ws + WS_QH), (float*)(F.ws + WS_LF), (const float*)(F.ws + WS_LB) + (size_t)l * D, 0x1, 1.0f};
                  pg8::gemm_phase<false>(F.lds, (const char*)(F.ws + WS_H), 2048, S, E); } }
            PHASE_END
            PHASE_BEGIN(sb + 1) phase_hgrn_scan(F); PHASE_END
            PHASE_BEGIN(sb + 2) phase_hgrn_gate(F, l); PHASE_END
        } else {
            const int j = l - NA;
            PHASE_BEGIN(sb + 0) {
                if (l == NA) { pg8::PlainSched S; S.init(T, 512, F.G, (int)blockIdx.x); S.Bt = (const char*)(F.ws + WS_WDKV); S.K = 1024;
                    pg8::EpiPlainBf16 E{(bf16_t*)(F.ws + WS_CKR), 512, 0.015625f};
                    pg8::gemm_phase<true>(F.lds, (const char*)(F.ws + WS_HK), 1024, S, E); }
                pg8::PlainSched S; S.init(T, 512, F.G, (int)blockIdx.x); S.Bt = (const char*)(F.ws + WS_WDQ) + (size_t)j * 512 * 1024; S.K = 1024;
                pg8::EpiPlainBf16 E{(bf16_t*)(F.ws + WS_CQ), 512, 0.015625f};
                pg8::gemm_phase<true>(F.lds, (const char*)(F.ws + WS_H8), 1024, S, E); }
            PHASE_END
            PHASE_BEGIN(sb + 1) if (l == NA) phase_kv_rows(F); phase_cq_rows(F, j); PHASE_END
            PHASE_BEGIN(sb + 2) {
                if (l == NA) { pg8::PlainSched S; S.init(T, 2048, F.G, (int)blockIdx.x); S.Bt = (const char*)(F.ws + WS_WUKV); S.K = 512;
                    pg8::EpiKvUp E{(bf16_t*)(F.ws + WS_KB), (bf16_t*)(F.ws + WS_VB)};
                    pg8::gemm_phase<false>(F.lds, (const char*)(F.ws + WS_CKV), 512, S, E); }
                pg8::PlainSched S; S.init(T, 1536, F.G, (int)blockIdx.x); S.Bt = (const char*)(F.ws + WS_WUQ) + (size_t)j * 1536 * 384 * 2; S.K = 768;
                pg8::EpiQUp E{(bf16_t*)(F.ws + WS_QB), (const float*)(F.ws + WS_ROPE)};
                pg8::gemm_phase<false>(F.lds, (const char*)(F.ws + WS_CQN), 768, S, E); }
            PHASE_END
            PHASE_BEGIN(sb + 3) phase_attn(F); PHASE_END
        }
        PHASE_BEGIN(sb + 4) {
            pg8::PlainSched S; S.init(T, 1024, F.G, (int)blockIdx.x); S.K = 1024;
            S.Bt = (l < NA) ? (const char*)(F.ws + WS_WOUT) + (size_t)l * 1024 * 1024 : (const char*)(F.ws + WS_WO) + (size_t)(l - NA) * 1024 * 1024;
            const char* A = (l < NA) ? (const char*)(F.ws + WS_OG) : (const char*)(F.ws + WS_AO);
            pg8::EpiResid E{l == 0 ? F.in[0] : nullptr, (bf16_t*)(F.ws + WS_XB), modp(F, l, 0, 2), 0.015625f, 6 * D};
            pg8::gemm_phase<true>(F.lds, A, 1024, S, E); }
        PHASE_END
        PHASE_BEGIN(sb + 5) phase_router(F, l, args.pad != 0); PHASE_END
        PHASE_BEGIN(sb + 7) {
            moe_table(F, l);
            pg8::MoeSched<true> S{(const LAS int*)(F.lds + LDS_TAB), (const LAS int*)(F.lds + LDS_BLKE), 8, F.G, F.vcu, (const char*)(F.ws + WS_WGU) + (size_t)l * NE * 2048 * 1024, (size_t)2048 * 1024, 1024, (const int*)(F.ws + WS_RINFO)};
            pg8::EpiMoeGU E{(unsigned char*)(F.ws + WS_ACT), F.in[24] + (size_t)l * NE * 2048};
            pg8::gemm_phase<true>(F.lds, (const char*)(F.ws + WS_H), 1024, S, E);
#ifdef MK_GU_EXTRA
            __syncthreads();
#if MK_GU_EXTRA == 3
            { pg8::MoeSchedHot S2{{(const LAS int*)(F.lds + LDS_TAB), (const LAS int*)(F.lds + LDS_BLKE), 8, F.G, F.vcu, (const char*)(F.ws + WS_WGU) + (size_t)l * NE * 2048 * 1024, (size_t)2048 * 1024, 1024, (const int*)(F.ws + WS_RINFO)}};
#else
            { pg8::MoeSched<true> S2{(const LAS int*)(F.lds + LDS_TAB), (const LAS int*)(F.lds + LDS_BLKE), 8, F.G, F.vcu, (const char*)(F.ws + WS_WGU) + (size_t)l * NE * 2048 * 1024, (size_t)2048 * 1024, 1024, (const int*)(F.ws + WS_RINFO)};
#endif
#if MK_GU_EXTRA == 1
              pg8::EpiMoeGU E2{(unsigned char*)(F.ws + WS_YS), F.in[24] + (size_t)l * NE * 2048};
#else
              pg8::EpiNull E2;
#endif
              pg8::gemm_phase<true>(F.lds, (const char*)(F.ws + WS_H), 1024, S2, E2); }
#endif
            }
        PHASE_END
        PHASE_BEGIN(sb + 8) {
            moe_table(F, l);
            pg8::MoeSched<false> S{(const LAS int*)(F.lds + LDS_TAB), (const LAS int*)(F.lds + LDS_BLKE), 4, F.G, F.vcu, (const char*)(F.ws + WS_WDN) + (size_t)l * NE * 1024 * 1024, (size_t)1024 * 1024, 1024, nullptr};
            pg8::EpiMoeDN E{(unsigned char*)(F.ws + WS_YS), F.in[26] + (size_t)l * NE * 1024, (const LAS int*)(F.lds + LDS_TAB), (const float*)(F.ws + WS_RW)};
            pg8::gemm_phase<true>(F.lds, (const char*)(F.ws + WS_ACT), 1024, S, E); }
        PHASE_END
        PHASE_BEGIN(sb + 9) moe_table(F, l); phase_combine<false>(F, l, args.pad != 0); PHASE_END
    }
    }
    { constexpr int l = 1;
    {
        const int sb = 2 + l * NP;
        if (l < NA) {
            PHASE_BEGIN(sb + 0) {
                { pg8::PlainSched S; S.init(T, 3072, F.G, (int)blockIdx.x); S.Bt = (const char*)(F.ws + WS_WIN) + (size_t)l * 3072 * 1024; S.K = 1024;
                  pg8::EpiHgrnIn E{(bf16_t*)(F.ws + WS_QH), (float*)(F.ws + WS_LF), (const float*)(F.ws + WS_LB) + (size_t)l * D, 0x320, 0.015625f};
                  pg8::gemm_phase<true>(F.lds, (const char*)(F.ws + WS_H8), 1024, S, E); }
                { pg8::PlainSched S; S.init(T, 1024, F.G, (int)blockIdx.x); S.Bt = (const char*)(F.ws + WS_WINF) + (size_t)l * 1024 * 1024 * 2; S.K = 2048;
                  pg8::EpiHgrnIn E{(bf16_t*)(F.ws + WS_QH), (float*)(F.ws + WS_LF), (const float*)(F.ws + WS_LB) + (size_t)l * D, 0x1, 1.0f};
                  pg8::gemm_phase<false>(F.lds, (const char*)(F.ws + WS_H), 2048, S, E); } }
            PHASE_END
            PHASE_BEGIN(sb + 1) phase_hgrn_scan(F); PHASE_END
            PHASE_BEGIN(sb + 2) phase_hgrn_gate(F, l); PHASE_END
        } else {
            const int j = l - NA;
            PHASE_BEGIN(sb + 0) {
                if (l == NA) { pg8::PlainSched S; S.init(T, 512, F.G, (int)blockIdx.x); S.Bt = (const char*)(F.ws + WS_WDKV); S.K = 1024;
                    pg8::EpiPlainBf16 E{(bf16_t*)(F.ws + WS_CKR), 512, 0.015625f};
                    pg8::gemm_phase<true>(F.lds, (const char*)(F.ws + WS_HK), 1024, S, E); }
                pg8::PlainSched S; S.init(T, 512, F.G, (int)blockIdx.x); S.Bt = (const char*)(F.ws + WS_WDQ) + (size_t)j * 512 * 1024; S.K = 1024;
                pg8::EpiPlainBf16 E{(bf16_t*)(F.ws + WS_CQ), 512, 0.015625f};
                pg8::gemm_phase<true>(F.lds, (const char*)(F.ws + WS_H8), 1024, S, E); }
            PHASE_END
            PHASE_BEGIN(sb + 1) if (l == NA) phase_kv_rows(F); phase_cq_rows(F, j); PHASE_END
            PHASE_BEGIN(sb + 2) {
                if (l == NA) { pg8::PlainSched S; S.init(T, 2048, F.G, (int)blockIdx.x); S.Bt = (const char*)(F.ws + WS_WUKV); S.K = 512;
                    pg8::EpiKvUp E{(bf16_t*)(F.ws + WS_KB), (bf16_t*)(F.ws + WS_VB)};
                    pg8::gemm_phase<false>(F.lds, (const char*)(F.ws + WS_CKV), 512, S, E); }
                pg8::PlainSched S; S.init(T, 1536, F.G, (int)blockIdx.x); S.Bt = (const char*)(F.ws + WS_WUQ) + (size_t)j * 1536 * 384 * 2; S.K = 768;
                pg8::EpiQUp E{(bf16_t*)(F.ws + WS_QB), (const float*)(F.ws + WS_ROPE)};
                pg8::gemm_phase<false>(F.lds, (const char*)(F.ws + WS_CQN), 768, S, E); }
            PHASE_END
            PHASE_BEGIN(sb + 3) phase_attn(F); PHASE_END
        }
        PHASE_BEGIN(sb + 4) {
            pg8::PlainSched S; S.init(T, 1024, F.G, (int)blockIdx.x); S.K = 1024;
            S.Bt = (l < NA) ? (const char*)(F.ws + WS_WOUT) + (size_t)l * 1024 * 1024 : (const char*)(F.ws + WS_WO) + (size_t)(l - NA) * 1024 * 1024;
            const char* A = (l < NA) ? (const char*)(F.ws + WS_OG) : (const char*)(F.ws + WS_AO);
            pg8::EpiResid E{l == 0 ? F.in[0] : nullptr, (bf16_t*)(F.ws + WS_XB), modp(F, l, 0, 2), 0.015625f, 6 * D};
            pg8::gemm_phase<true>(F.lds, A, 1024, S, E); }
        PHASE_END
        PHASE_BEGIN(sb + 5) phase_router(F, l, args.pad != 0); PHASE_END
        PHASE_BEGIN(sb + 7) {
            moe_table(F, l);
            pg8::MoeSched<true> S{(const LAS int*)(F.lds + LDS_TAB), (const LAS int*)(F.lds + LDS_BLKE), 8, F.G, F.vcu, (const char*)(F.ws + WS_WGU) + (size_t)l * NE * 2048 * 1024, (size_t)2048 * 1024, 1024, (const int*)(F.ws + WS_RINFO)};
            pg8::EpiMoeGU E{(unsigned char*)(F.ws + WS_ACT), F.in[24] + (size_t)l * NE * 2048};
            pg8::gemm_phase<true>(F.lds, (const char*)(F.ws + WS_H), 1024, S, E);
#ifdef MK_GU_EXTRA
            __syncthreads();
#if MK_GU_EXTRA == 3
            { pg8::MoeSchedHot S2{{(const LAS int*)(F.lds + LDS_TAB), (const LAS int*)(F.lds + LDS_BLKE), 8, F.G, F.vcu, (const char*)(F.ws + WS_WGU) + (size_t)l * NE * 2048 * 1024, (size_t)2048 * 1024, 1024, (const int*)(F.ws + WS_RINFO)}};
#else
            { pg8::MoeSched<true> S2{(const LAS int*)(F.lds + LDS_TAB), (const LAS int*)(F.lds + LDS_BLKE), 8, F.G, F.vcu, (const char*)(F.ws + WS_WGU) + (size_t)l * NE * 2048 * 1024, (size_t)2048 * 1024, 1024, (const int*)(F.ws + WS_RINFO)};
#endif
#if MK_GU_EXTRA == 1
              pg8::EpiMoeGU E2{(unsigned char*)(F.ws + WS_YS), F.in[24] + (size_t)l * NE * 2048};
#else
              pg8::EpiNull E2;
#endif
              pg8::gemm_phase<true>(F.lds, (const char*)(F.ws + WS_H), 1024, S2, E2); }
#endif
            }
        PHASE_END
        PHASE_BEGIN(sb + 8) {
            moe_table(F, l);
            pg8::MoeSched<false> S{(const LAS int*)(F.lds + LDS_TAB), (const LAS int*)(F.lds + LDS_BLKE), 4, F.G, F.vcu, (const char*)(F.ws + WS_WDN) + (size_t)l * NE * 1024 * 1024, (size_t)1024 * 1024, 1024, nullptr};
            pg8::EpiMoeDN E{(unsigned char*)(F.ws + WS_YS), F.in[26] + (size_t)l * NE * 1024, (const LAS int*)(F.lds + LDS_TAB), (const float*)(F.ws + WS_RW)};
            pg8::gemm_phase<true>(F.lds, (const char*)(F.ws + WS_ACT), 1024, S, E); }
        PHASE_END
        PHASE_BEGIN(sb + 9) moe_table(F, l); phase_combine<false>(F, l, args.pad != 0); PHASE_END
    }
    }
    { constexpr int l = 2;
    {
        const int sb = 2 + l * NP;
        if (l < NA) {
            PHASE_BEGIN(sb + 0) {
                { pg8::PlainSched S; S.init(T, 3072, F.G, (int)blockIdx.x); S.Bt = (const char*)(F.ws + WS_WIN) + (size_t)l * 3072 * 1024; S.K = 1024;
                  pg8::EpiHgrnIn E{(bf16_t*)(F.ws + WS_QH), (float*)(F.ws + WS_LF), (const float*)(F.ws + WS_LB) + (size_t)l * D, 0x320, 0.015625f};
                  pg8::gemm_phase<true>(F.lds, (const char*)(F.ws + WS_H8), 1024, S, E); }
                { pg8::PlainSched S; S.init(T, 1024, F.G, (int)blockIdx.x); S.Bt = (const char*)(F.ws + WS_WINF) + (size_t)l * 1024 * 1024 * 2; S.K = 2048;
                  pg8::EpiHgrnIn E{(bf16_t*)(F.ws + WS_QH), (float*)(F.ws + WS_LF), (const float*)(F.ws + WS_LB) + (size_t)l * D, 0x1, 1.0f};
                  pg8::gemm_phase<false>(F.lds, (const char*)(F.ws + WS_H), 2048, S, E); } }
            PHASE_END
            PHASE_BEGIN(sb + 1) phase_hgrn_scan(F); PHASE_END
            PHASE_BEGIN(sb + 2) phase_hgrn_gate(F, l); PHASE_END
        } else {
            const int j = l - NA;
            PHASE_BEGIN(sb + 0) {
                if (l == NA) { pg8::PlainSched S; S.init(T, 512, F.G, (int)blockIdx.x); S.Bt = (const char*)(F.ws + WS_WDKV); S.K = 1024;
                    pg8::EpiPlainBf16 E{(bf16_t*)(F.ws + WS_CKR), 512, 0.015625f};
                    pg8::gemm_phase<true>(F.lds, (const char*)(F.ws + WS_HK), 1024, S, E); }
                pg8::PlainSched S; S.init(T, 512, F.G, (int)blockIdx.x); S.Bt = (const char*)(F.ws + WS_WDQ) + (size_t)j * 512 * 1024; S.K = 1024;
                pg8::EpiPlainBf16 E{(bf16_t*)(F.ws + WS_CQ), 512, 0.015625f};
                pg8::gemm_phase<true>(F.lds, (const char*)(F.ws + WS_H8), 1024, S, E); }
            PHASE_END
            PHASE_BEGIN(sb + 1) if (l == NA) phase_kv_rows(F); phase_cq_rows(F, j); PHASE_END
            PHASE_BEGIN(sb + 2) {
                if (l == NA) { pg8::PlainSched S; S.init(T, 2048, F.G, (int)blockIdx.x); S.Bt = (const char*)(F.ws + WS_WUKV); S.K = 512;
                    pg8::EpiKvUp E{(bf16_t*)(F.ws + WS_KB), (bf16_t*)(F.ws + WS_VB)};
                    pg8::gemm_phase<false>(F.lds, (const char*)(F.ws + WS_CKV), 512, S, E); }
                pg8::PlainSched S; S.init(T, 1536, F.G, (int)blockIdx.x); S.Bt = (const char*)(F.ws + WS_WUQ) + (size_t)j * 1536 * 384 * 2; S.K = 768;
                pg8::EpiQUp E{(bf16_t*)(F.ws + WS_QB), (const float*)(F.ws + WS_ROPE)};
                pg8::gemm_phase<false>(F.lds, (const char*)(F.ws + WS_CQN), 768, S, E); }
            PHASE_END
            PHASE_BEGIN(sb + 3) phase_attn(F); PHASE_END
        }
        PHASE_BEGIN(sb + 4) {
            pg8::PlainSched S; S.init(T, 1024, F.G, (int)blockIdx.x); S.K = 1024;
            S.Bt = (l < NA) ? (const char*)(F.ws + WS_WOUT) + (size_t)l * 1024 * 1024 : (const char*)(F.ws + WS_WO) + (size_t)(l - NA) * 1024 * 1024;
            const char* A = (l < NA) ? (const char*)(F.ws + WS_OG) : (const char*)(F.ws + WS_AO);
            pg8::EpiResid E{l == 0 ? F.in[0] : nullptr, (bf16_t*)(F.ws + WS_XB), modp(F, l, 0, 2), 0.015625f, 6 * D};
            pg8::gemm_phase<true>(F.lds, A, 1024, S, E); }
        PHASE_END
        PHASE_BEGIN(sb + 5) phase_router(F, l, args.pad != 0); PHASE_END
        PHASE_BEGIN(sb + 7) {
            moe_table(F, l);
            pg8::MoeSched<true> S{(const LAS int*)(F.lds + LDS_TAB), (const LAS int*)(F.lds + LDS_BLKE), 8, F.G, F.vcu, (const char*)(F.ws + WS_WGU) + (size_t)l * NE * 2048 * 1024, (size_t)2048 * 1024, 1024, (const int*)(F.ws + WS_RINFO)};
            pg8::EpiMoeGU E{(unsigned char*)(F.ws + WS_ACT), F.in[24] + (size_t)l * NE * 2048};
            pg8::gemm_phase<true>(F.lds, (const char*)(F.ws + WS_H), 1024, S, E);
#ifdef MK_GU_EXTRA
            __syncthreads();
#if MK_GU_EXTRA == 3
            { pg8::MoeSchedHot S2{{(const LAS int*)(F.lds + LDS_TAB), (const LAS int*)(F.lds + LDS_BLKE), 8, F.G, F.vcu, (const char*)(F.ws + WS_WGU) + (size_t)l * NE * 2048 * 1024, (size_t)2048 * 1024, 1024, (const int*)(F.ws + WS_RINFO)}};
#else
            { pg8::MoeSched<true> S2{(const LAS int*)(F.lds + LDS_TAB), (const LAS int*)(F.lds + LDS_BLKE), 8, F.G, F.vcu, (const char*)(F.ws + WS_WGU) + (size_t)l * NE * 2048 * 1024, (size_t)2048 * 1024, 1024, (const int*)(F.ws + WS_RINFO)};
#endif
#if MK_GU_EXTRA == 1
              pg8::EpiMoeGU E2{(unsigned char*)(F.ws + WS_YS), F.in[24] + (size_t)l * NE * 2048};
#else
              pg8::EpiNull E2;
#endif
              pg8::gemm_phase<true>(F.lds, (const char*)(F.ws + WS_H), 1024, S2, E2); }
#endif
            }
        PHASE_END
        PHASE_BEGIN(sb + 8) {
            moe_table(F, l);
            pg8::MoeSched<false> S{(const LAS int*)(F.lds + LDS_TAB), (const LAS int*)(F.lds + LDS_BLKE), 4, F.G, F.vcu, (const char*)(F.ws + WS_WDN) + (size_t)l * NE * 1024 * 1024, (size_t)1024 * 1024, 1024, nullptr};
            pg8::EpiMoeDN E{(unsigned char*)(F.ws + WS_YS), F.in[26] + (size_t)l * NE * 1024, (const LAS int*)(F.lds + LDS_TAB), (const float*)(F.ws + WS_RW)};
            pg8::gemm_phase<true>(F.lds, (const char*)(F.ws + WS_ACT), 1024, S, E); }
        PHASE_END
        PHASE_BEGIN(sb + 9) moe_table(F, l); phase_combine<false>(F, l, args.pad != 0); PHASE_END
    }
    }
    { constexpr int l = 3;
    {
        const int sb = 2 + l * NP;
        if (l < NA) {
            PHASE_BEGIN(sb + 0) {
                { pg8::PlainSched S; S.init(T, 3072, F.G, (int)blockIdx.x); S.Bt = (const char*)(F.ws + WS_WIN) + (size_t)l * 3072 * 1024; S.K = 1024;
                  pg8::EpiHgrnIn E{(bf16_t*)(F.ws + WS_QH), (float*)(F.ws + WS_LF), (const float*)(F.ws + WS_LB) + (size_t)l * D, 0x320, 0.015625f};
                  pg8::gemm_phase<true>(F.lds, (const char*)(F.ws + WS_H8), 1024, S, E); }
                { pg8::PlainSched S; S.init(T, 1024, F.G, (int)blockIdx.x); S.Bt = (const char*)(F.ws + WS_WINF) + (size_t)l * 1024 * 1024 * 2; S.K = 2048;
                  pg8::EpiHgrnIn E{(bf16_t*)(F.ws + WS_QH), (float*)(F.ws + WS_LF), (const float*)(F.ws + WS_LB) + (size_t)l * D, 0x1, 1.0f};
                  pg8::gemm_phase<false>(F.lds, (const char*)(F.ws + WS_H), 2048, S, E); } }
            PHASE_END
            PHASE_BEGIN(sb + 1) phase_hgrn_scan(F); PHASE_END
            PHASE_BEGIN(sb + 2) phase_hgrn_gate(F, l); PHASE_END
        } else {
            const int j = l - NA;
            PHASE_BEGIN(sb + 0) {
                if (l == NA) { pg8::PlainSched S; S.init(T, 512, F.G, (int)blockIdx.x); S.Bt = (const char*)(F.ws + WS_WDKV); S.K = 1024;
                    pg8::EpiPlainBf16 E{(bf16_t*)(F.ws + WS_CKR), 512, 0.015625f};
                    pg8::gemm_phase<true>(F.lds, (const char*)(F.ws + WS_HK), 1024, S, E); }
                pg8::PlainSched S; S.init(T, 512, F.G, (int)blockIdx.x); S.Bt = (const char*)(F.ws + WS_WDQ) + (size_t)j * 512 * 1024; S.K = 1024;
                pg8::EpiPlainBf16 E{(bf16_t*)(F.ws + WS_CQ), 512, 0.015625f};
                pg8::gemm_phase<true>(F.lds, (const char*)(F.ws + WS_H8), 1024, S, E); }
            PHASE_END
            PHASE_BEGIN(sb + 1) if (l == NA) phase_kv_rows(F); phase_cq_rows(F, j); PHASE_END
            PHASE_BEGIN(sb + 2) {
                if (l == NA) { pg8::PlainSched S; S.init(T, 2048, F.G, (int)blockIdx.x); S.Bt = (const char*)(F.ws + WS_WUKV); S.K = 512;
                    pg8::EpiKvUp E{(bf16_t*)(F.ws + WS_KB), (bf16_t*)(F.ws + WS_VB)};
                    pg8::gemm_phase<false>(F.lds, (const char*)(F.ws + WS_CKV), 512, S, E); }
                pg8::PlainSched S; S.init(T, 1536, F.G, (int)blockIdx.x); S.Bt = (const char*)(F.ws + WS_WUQ) + (size_t)j * 1536 * 384 * 2; S.K = 768;
                pg8::EpiQUp E{(bf16_t*)(F.ws + WS_QB), (const float*)(F.ws + WS_ROPE)};
                pg8::gemm_phase<false>(F.lds, (const char*)(F.ws + WS_CQN), 768, S, E); }
            PHASE_END
            PHASE_BEGIN(sb + 3) phase_attn(F); PHASE_END
        }
        PHASE_BEGIN(sb + 4) {
            pg8::PlainSched S; S.init(T, 1024, F.G, (int)blockIdx.x); S.K = 1024;
            S.Bt = (l < NA) ? (const char*)(F.ws + WS_WOUT) + (size_t)l * 1024 * 1024 : (const char*)(F.ws + WS_WO) + (size_t)(l - NA) * 1024 * 1024;
            const char* A = (l < NA) ? (const char*)(F.ws + WS_OG) : (const char*)(F.ws + WS_AO);
            pg8::EpiResid E{l == 0 ? F.in[0] : nullptr, (bf16_t*)(F.ws + WS_XB), modp(F, l, 0, 2), 0.015625f, 6 * D};
            pg8::gemm_phase<true>(F.lds, A, 1024, S, E); }
        PHASE_END
        PHASE_BEGIN(sb + 5) phase_router(F, l, args.pad != 0); PHASE_END
        PHASE_BEGIN(sb + 7) {
            moe_table(F, l);
            pg8::MoeSched<true> S{(const LAS int*)(F.lds + LDS_TAB), (const LAS int*)(F.lds + LDS_BLKE), 8, F.G, F.vcu, (const char*)(F.ws + WS_WGU) + (size_t)l * NE * 2048 * 1024, (size_t)2048 * 1024, 1024, (const int*)(F.ws + WS_RINFO)};
            pg8::EpiMoeGU E{(unsigned char*)(F.ws + WS_ACT), F.in[24] + (size_t)l * NE * 2048};
            pg8::gemm_phase<true>(F.lds, (const char*)(F.ws + WS_H), 1024, S, E);
#ifdef MK_GU_EXTRA
            __syncthreads();
#if MK_GU_EXTRA == 3
            { pg8::MoeSchedHot S2{{(const LAS int*)(F.lds + LDS_TAB), (const LAS int*)(F.lds + LDS_BLKE), 8, F.G, F.vcu, (const char*)(F.ws + WS_WGU) + (size_t)l * NE * 2048 * 1024, (size_t)2048 * 1024, 1024, (const int*)(F.ws + WS_RINFO)}};
#else
            { pg8::MoeSched<true> S2{(const LAS int*)(F.lds + LDS_TAB), (const LAS int*)(F.lds + LDS_BLKE), 8, F.G, F.vcu, (const char*)(F.ws + WS_WGU) + (size_t)l * NE * 2048 * 1024, (size_t)2048 * 1024, 1024, (const int*)(F.ws + WS_RINFO)};
#endif
#if MK_GU_EXTRA == 1
              pg8::EpiMoeGU E2{(unsigned char*)(F.ws + WS_YS), F.in[24] + (size_t)l * NE * 2048};
#else
              pg8::EpiNull E2;
#endif
              pg8::gemm_phase<true>(F.lds, (const char*)(F.ws + WS_H), 1024, S2, E2); }
#endif
            }
        PHASE_END
        PHASE_BEGIN(sb + 8) {
            moe_table(F, l);
            pg8::MoeSched<false> S{(const LAS int*)(F.lds + LDS_TAB), (const LAS int*)(F.lds + LDS_BLKE), 4, F.G, F.vcu, (const char*)(F.ws + WS_WDN) + (size_t)l * NE * 1024 * 1024, (size_t)1024 * 1024, 1024, nullptr};
            pg8::EpiMoeDN E{(unsigned char*)(F.ws + WS_YS), F.in[26] + (size_t)l * NE * 1024, (const LAS int*)(F.lds + LDS_TAB), (const float*)(F.ws + WS_RW)};
            pg8::gemm_phase<true>(F.lds, (const char*)(F.ws + WS_ACT), 1024, S, E); }
        PHASE_END
        PHASE_BEGIN(sb + 9) moe_table(F, l); phase_combine<false>(F, l, args.pad != 0); PHASE_END
    }
    }
#ifdef MK_PROBE_MASK
    PR_STAMP(-1);
    if (blockIdx.x == 0 && threadIdx.x == 0) { const unsigned long long t0 = __builtin_amdgcn_s_memrealtime(); while (__builtin_amdgcn_s_memrealtime() - t0 < 4ull * pr_acc) __builtin_amdgcn_s_sleep(8); }
#endif
#if defined(MK_SCAN_PROBE) || defined(MK_ATT_PROBE)
    if (blockIdx.x == 0 && threadIdx.x == 0) { const unsigned long long acc_ = *(volatile LAS unsigned*)(F.lds + 147440); const unsigned long long t0 = __builtin_amdgcn_s_memrealtime(); while (__builtin_amdgcn_s_memrealtime() - t0 < 4ull * acc_) __builtin_amdgcn_s_sleep(8); }
#endif
#undef PHASE_BEGIN
#undef PHASE_END
}

extern "C" void kernel_launch(void* const* d_in, const int* in_sizes, int n_in, void* d_out, int out_size, void* d_ws, size_t ws_size, hipStream_t stream) {
    static int grid = 0;
    if (grid == 0) {
        if (n_in != 28 || in_sizes[0] != T * D || out_size != T * D || ws_size < WS_END) {
            fprintf(stderr, "kernel_launch: shape mismatch: n_in %d in0 %d out %d ws %zu (need %zu)\n", n_in, n_in > 0 ? in_sizes[0] : -1, out_size, ws_size, (size_t)WS_END); grid = -1; return; }
        int dev = 0, cus = 0, per_cu = 0;
        if (hipGetDevice(&dev) != hipSuccess || hipDeviceGetAttribute(&cus, hipDeviceAttributeMultiprocessorCount, dev) != hipSuccess) { fprintf(stderr, "kernel_launch: device query failed\n"); grid = -1; return; }
        if (hipFuncSetAttribute((const void*)fwd_kernel, hipFuncAttributeMaxDynamicSharedMemorySize, LDS_BYTES) != hipSuccess) { fprintf(stderr, "kernel_launch: hipFuncSetAttribute failed\n"); grid = -1; return; }
        if (hipOccupancyMaxActiveBlocksPerMultiprocessor(&per_cu, (const void*)fwd_kernel, NTHREADS, LDS_BYTES) != hipSuccess || per_cu < 1)
            fprintf(stderr, "kernel_launch: note: occupancy query reports %d workgroups per CU\n", per_cu);
        (void)hipGetLastError();
        grid = cus;
    }
    if (grid < 0) return;
    if (hipMemsetAsync((char*)d_ws + WS_CTL, 0, CTL_ZERO_BYTES, stream) != hipSuccess) { fprintf(stderr, "kernel_launch: memset failed\n"); return; }
    Args a{};
    for (int i = 0; i < 28; ++i) a.in[i] = (const float*)d_in[i];
    a.out = (float*)d_out; a.ws = (unsigned char*)d_ws; a.final_only = 0; a.pad = 0;
    constexpr int LAST = (MK_LAST_STEP < NSTEPS) ? MK_LAST_STEP : NSTEPS;
#if MK_ONE_LAUNCH
    a.lo = 0; a.hi = LAST;
    hipLaunchKernelGGL(fwd_kernel, dim3(grid), dim3(NTHREADS), LDS_BYTES, stream, a);
#else
    for (int st = 0; st < LAST; ++st) { if (!step_applies(st)) continue;
#ifdef MK_SKIP_LO
        if (st >= MK_SKIP_LO && st < MK_SKIP_HI) continue;
#endif
        a.lo = st; a.hi = st + 1;
        hipLaunchKernelGGL(fwd_kernel, dim3(grid), dim3(NTHREADS), LDS_BYTES, stream, a);
#ifdef MK_REPEAT_LO
        if (st >= MK_REPEAT_LO && st < MK_REPEAT_HI) { a.pad = 1; hipLaunchKernelGGL(fwd_kernel, dim3(grid), dim3(NTHREADS), LDS_BYTES, stream, a); a.pad = 0; }
#endif
    }
#endif
    if (LAST < NSTEPS) {
        a.lo = 0; a.hi = 0; a.final_only = (LAST <= 2 + 4) ? 1 : 2;
        hipLaunchKernelGGL(fwd_kernel, dim3(grid), dim3(NTHREADS), LDS_BYTES, stream, a);
    }
    const hipError_t le = hipPeekAtLastError();
    if (le != hipSuccess) fprintf(stderr, "kernel_launch: launch failed: %s\n", hipGetErrorName(le));
}
```

```cpp
#define MK_ONE_LAUNCH 1
#define MK_LAST_STEP 9999
#include <hip/hip_runtime.h>
#include <cstdio>
#include <cstdint>

#ifndef MK_ONE_LAUNCH
#define MK_ONE_LAUNCH 1
#endif
#ifndef MK_LAST_STEP
#define MK_LAST_STEP 9999
#endif

#define GAS __attribute__((address_space(1)))
#define LAS __attribute__((address_space(3)))
typedef unsigned short bf16_t;
typedef short bf16x8 __attribute__((ext_vector_type(8)));
typedef short s16x4 __attribute__((ext_vector_type(4)));
typedef float f32x4 __attribute__((ext_vector_type(4)));
typedef float f32x2 __attribute__((ext_vector_type(2)));
typedef float f32x16 __attribute__((ext_vector_type(16)));
typedef unsigned u32x4 __attribute__((ext_vector_type(4)));
typedef unsigned u32x2 __attribute__((ext_vector_type(2)));

constexpr int NB = 16, SEQ = 4096, D = 1024, T = NB * SEQ;
constexpr int DEPTH = 4, NA = 2;
constexpr int HGH = 8, HGD = 128, HGC = 64;
constexpr int MH = 8, NOPE = 128, ROPE = 64, VD = 128, QK = NOPE + ROPE;
constexpr int QRANK = 384, KVRANK = 256;
constexpr int NE = 32, TOPK = 4, FF = 1024, MOEB = 256;
constexpr int NASSIGN = T * TOPK;
constexpr int NROWS_MAX = NASSIGN + NE * MOEB;
constexpr int NBLK_MAX = NROWS_MAX / MOEB;
constexpr float NORM_EPS = 1e-6f;
constexpr float SWIGLU_LIMIT = 7.0f, SWIGLU_ALPHA = 1.702f;
constexpr int NWAVES = 8, NTHREADS = 512;

constexpr size_t MiB = 1u << 20;
constexpr size_t al256(size_t x) { return (x + 255) & ~(size_t)255; }
constexpr size_t WS_CTL = 0, CTL_ZERO_BYTES = 1 * MiB;
constexpr int CW_BAR = 4096;
constexpr int CW_CNT = 16384;
constexpr size_t WS_MOD   = 1 * MiB;
constexpr size_t WS_KVMOD = WS_MOD + al256((size_t)DEPTH * NB * 6 * D * 4);
constexpr size_t WS_LB    = WS_KVMOD + al256((size_t)NB * 2 * D * 4);
constexpr size_t WS_ROPE  = WS_LB + al256((size_t)NA * D * 4);
constexpr size_t WS_TKE   = WS_ROPE + al256((size_t)T * 64 * 4);
constexpr size_t WS_TKW   = WS_TKE + al256((size_t)T * 4 * 4);
constexpr size_t WS_TKR   = WS_TKW + al256((size_t)T * 4 * 4);
constexpr int VCAP = T;
constexpr size_t WS_RINFO = WS_TKR + al256((size_t)T * 4 * 4);
constexpr size_t WS_RW    = WS_RINFO + al256((size_t)NE * VCAP * 4);
constexpr size_t WS_WR    = al256(WS_RW + (size_t)NE * VCAP * 4 + MiB);
constexpr size_t WS_WIN   = al256(WS_WR + (size_t)DEPTH * 131072);
constexpr size_t WS_WINF  = WS_WIN + (size_t)NA * 3072 * 1024;
constexpr size_t WS_WOUT  = WS_WIN + (size_t)NA * 4096 * 1024 * 2;
constexpr size_t WS_WDKV  = WS_WOUT + (size_t)NA * 1024 * 1024 * 2;
constexpr size_t WS_WUKV  = WS_WDKV + (size_t)512 * 1024 * 2;
constexpr size_t WS_WDQ   = WS_WUKV + (size_t)2048 * 256 * 2;
constexpr size_t WS_WUQ   = WS_WDQ + (size_t)2 * 512 * 1024 * 2;
constexpr size_t WS_WO    = WS_WUQ + (size_t)2 * 1536 * 384 * 2;
constexpr size_t WS_WGU   = al256(WS_WO + (size_t)2 * 1024 * 1024 * 2);
constexpr size_t WS_WDN   = WS_WGU + (size_t)DEPTH * NE * 2048 * 1024 * 2;
constexpr size_t WS_H     = WS_WDN + (size_t)DEPTH * NE * 1024 * 1024 * 2;
constexpr size_t WS_HK    = WS_H + (size_t)T * D * 2;
constexpr size_t WS_XB    = WS_HK + (size_t)T * D * 2;
constexpr size_t WS_H8    = WS_XB + (size_t)T * D * 2;
constexpr size_t WS_ACT   = WS_H8 + (size_t)T * D;
constexpr size_t WS_YS    = WS_ACT + (size_t)NROWS_MAX * FF * 2;
constexpr size_t WS_MIX   = WS_YS + (size_t)NROWS_MAX * D * 2;
constexpr size_t WS_QH = WS_MIX;
constexpr size_t WS_KK = WS_QH + (size_t)T * D * 2;
constexpr size_t WS_VV = WS_KK + (size_t)T * D * 2;
constexpr size_t WS_GS = WS_VV + (size_t)T * D * 2;
constexpr size_t WS_LF = WS_GS + (size_t)T * D * 2;
constexpr size_t WS_OO = WS_LF + (size_t)T * D * 4;
constexpr size_t WS_OG = WS_OO + (size_t)T * D * 2;
constexpr size_t WS_MIX_END_A = WS_OG + (size_t)T * D * 2;
constexpr size_t WS_KB  = WS_MIX;
constexpr size_t WS_VB  = WS_KB + (size_t)T * MH * QK * 2;
constexpr size_t WS_QB  = WS_VB + (size_t)T * D * 2;
constexpr size_t WS_CKR = WS_QB + (size_t)T * MH * QK * 2;
constexpr size_t WS_CKV = WS_CKR + (size_t)T * 512 * 2;
constexpr size_t WS_CQ  = WS_CKV + (size_t)T * 256 * 2;
constexpr size_t WS_CQN = WS_CQ + (size_t)T * 512 * 2;
constexpr size_t WS_AO  = WS_CQN + (size_t)T * 384 * 2;
constexpr size_t WS_MIX_END_B = WS_AO + (size_t)T * D * 2;
constexpr size_t WS_END = (WS_MIX_END_A > WS_MIX_END_B ? WS_MIX_END_A : WS_MIX_END_B);
static_assert(WS_END < (size_t)4200 * MiB / 1 && WS_END < 4294967296ull, "workspace map must fit 4 x largest tensor");

constexpr int RING_BYTES = 131072;
constexpr int LDS_TAB = RING_BYTES;
constexpr int LDS_BLKE = RING_BYTES + 1024;
constexpr int LDS_MISC = RING_BYTES + 512;
constexpr int LDS_SIDE = LDS_BLKE + NBLK_MAX * 4;
static_assert(LDS_SIDE % 16 == 0 && LDS_SIDE + 3 * 2048 <= 147456, "LDS map");
constexpr int LDS_BYTES = 147456;

#define RLX_AGENT __ATOMIC_RELAXED, __HIP_MEMORY_SCOPE_AGENT
#define LDS_WAIT() asm volatile("s_waitcnt lgkmcnt(0)" ::: "memory")
#define VM_WAIT() asm volatile("s_waitcnt vmcnt(0)" ::: "memory")
typedef __bf16 bf16x2_t __attribute__((ext_vector_type(2)));
__device__ __forceinline__ unsigned cvt_pk_bf16(float lo, float hi) { f32x2 v = {lo, hi}; bf16x2_t b = __builtin_convertvector(v, bf16x2_t); return __builtin_bit_cast(unsigned, b); }
__device__ __forceinline__ float bf2f(unsigned short b) { return __uint_as_float(((unsigned)b) << 16); }
__device__ __forceinline__ float bflo(unsigned w) { return __uint_as_float(w << 16); }
__device__ __forceinline__ float bfhi(unsigned w) { return __uint_as_float(w & 0xffff0000u); }
__device__ __forceinline__ unsigned short f2bf(float f) { return (unsigned short)(cvt_pk_bf16(f, 0.f) & 0xffffu); }
__device__ __forceinline__ float wave_sum(float v) {
#pragma unroll
    for (int o = 1; o < 64; o <<= 1) v += __shfl_xor(v, o);
    return v;
}
__device__ __forceinline__ void glds16s(const void* sbase, unsigned voff, unsigned lds_dst) {
    asm volatile("s_mov_b32 m0, %2\n\ts_nop 0\n\tglobal_load_lds_dwordx4 %0, %1" :: "v"(voff), "s"(sbase), "s"(lds_dst) : "memory", "m0"); }
__device__ __forceinline__ int opaque_v(int x) { asm volatile("" : "+v"(x)); return x; }
#define PHASE_IDS const int tid = opaque_v((int)threadIdx.x), lane = tid & 63, wave = __builtin_amdgcn_readfirstlane(tid >> 6); (void)lane; (void)wave
typedef _Float16 f16x2_t __attribute__((ext_vector_type(2)));
__device__ __forceinline__ unsigned pk_f16(float a, float b) { return __builtin_bit_cast(unsigned, __builtin_amdgcn_cvt_pkrtz(a, b)); }
__device__ __forceinline__ float f16lo(unsigned u) { return (float)__builtin_bit_cast(f16x2_t, u)[0]; }
__device__ __forceinline__ float f16hi(unsigned u) { return (float)__builtin_bit_cast(f16x2_t, u)[1]; }
__device__ __forceinline__ float fsigmoid(float x) { return __builtin_amdgcn_rcpf(1.0f + __expf(-x)); }
__device__ __forceinline__ float fsilu(float x) { return x * __builtin_amdgcn_rcpf(1.0f + __expf(-x)); }

#define XB_TMO      128
#define XB_XCNT(j)  (256  + 64 * (j))
#define XB_XSUB(j)  (1280 + 64 * (j))
#define XB_XGEN(j)  (2304 + 64 * (j))
#define XB_TOP      3328
#define XB_TOPGEN   3392
#define XCD_BAR_WORDS 3456
#define XB_SPIN_CAP (1u << 23)
__device__ __forceinline__ unsigned xb_ld(unsigned* p)              { return __hip_atomic_load(p, __ATOMIC_RELAXED, __HIP_MEMORY_SCOPE_AGENT); }
__device__ __forceinline__ unsigned xb_add(unsigned* p, unsigned v) { return __hip_atomic_fetch_add(p, v, __ATOMIC_RELAXED, __HIP_MEMORY_SCOPE_AGENT); }
__device__ __forceinline__ unsigned xb_xcc_id() { return (unsigned)__builtin_amdgcn_s_getreg((3 << 11) | 20) & 0xFu; }
#define XB_SPIN(cond, bar) do { unsigned _sp = 0; while (cond) { __builtin_amdgcn_s_sleep(1); \
    if ((++_sp & 255u) == 0u) { if (xb_ld(&(bar)[XB_TMO])) break; if (_sp > XB_SPIN_CAP) { atomicAdd(&(bar)[XB_TMO], 1u); break; } } } } while (0)
struct XcdBarrier { unsigned* bar; unsigned x; volatile LAS unsigned* st; };
__device__ __forceinline__ XcdBarrier xcd_barrier_post(unsigned* bar, volatile LAS unsigned* st) {
    XcdBarrier b; b.bar = bar; b.x = xb_xcc_id(); b.st = st;
    if (threadIdx.x == 0) (void)xb_add(&bar[XB_XCNT(b.x)], 1u);
    return b;
}
__device__ __forceinline__ void xcd_barrier_complete(unsigned* bar, unsigned x, unsigned& nloc, unsigned& nx) {
    const unsigned G = gridDim.x * gridDim.y * gridDim.z;
    unsigned sum, cnt, mine, sp = 0u;
    for (;;) {
        sum = 0u; cnt = 0u; mine = 0u;
#pragma unroll
        for (unsigned j = 0; j < 16; ++j) { const unsigned c = xb_ld(&bar[XB_XCNT(j)]); sum += c; cnt += (c > 0u) ? 1u : 0u; mine = (j == x) ? c : mine; }
        if (sum == G) break;
        __builtin_amdgcn_s_sleep(1);
        if ((++sp & 255u) == 0u) { if (xb_ld(&bar[XB_TMO])) break; if (sp > XB_SPIN_CAP) { atomicAdd(&bar[XB_TMO], 1u); break; } }
    }
    nloc = mine > 0u ? mine : 1u; nx = cnt > 0u ? cnt : 1u;
}
__device__ __forceinline__ void xcd_barrier(const XcdBarrier& b) {
    asm volatile("s_waitcnt vmcnt(0)" ::: "memory");
    __syncthreads();
    if (threadIdx.x == 0) {
        unsigned* bar = b.bar;
        __builtin_amdgcn_s_waitcnt(0);
        unsigned nloc = b.st[0], nx = b.st[1];
        if (nloc == 0u) { xcd_barrier_complete(bar, b.x, nloc, nx); b.st[0] = nloc; b.st[1] = nx; }
        const unsigned old = xb_add(&bar[XB_XSUB(b.x)], 1u);
        const unsigned gen = old / nloc;
        if (old + 1u == (gen + 1u) * nloc) {
            __builtin_amdgcn_fence(__ATOMIC_RELEASE, "agent");
            asm volatile("s_waitcnt vmcnt(0)" ::: "memory");
            const unsigned og = xb_add(&bar[XB_TOP], 1u);
            const unsigned tg = og / nx;
            if (og + 1u == (tg + 1u) * nx) xb_add(&bar[XB_TOPGEN], 1u);
            else XB_SPIN(xb_ld(&bar[XB_TOPGEN]) == tg, bar);
            __builtin_amdgcn_fence(__ATOMIC_ACQUIRE, "agent");
            xb_add(&bar[XB_XGEN(b.x)], 1u);
            asm volatile("s_waitcnt vmcnt(0)" ::: "memory");
        } else {
            XB_SPIN(xb_ld(&bar[XB_XGEN(b.x)]) == gen, bar);
            __builtin_amdgcn_fence(__ATOMIC_ACQUIRE, "agent");
            asm volatile("s_waitcnt vmcnt(0)" ::: "memory");
        }
    }
    __syncthreads();
}
namespace pg8 {
constexpr int BM = 256, BK = 64, HALF = 128, HTB = HALF * BK * 2, STAGE_BYTES = 8 * HTB, NXCD = 8, WGM = 8;
__host__ __device__ __forceinline__ int lds_byte(int r, int c) { const int st = (r >> 4) * 2 + (c >> 5), rr = r & 15, cc = c & 31, ob = rr * 64 + cc * 2; return st * 1024 + (ob ^ (((ob >> 9) & 1) << 5)); }
__host__ __device__ __forceinline__ void stage_rc(int b, int& R, int& C) { const int st = b / 1024, sb = b % 1024, swz = sb ^ (((sb >> 9) & 1) << 5); R = (st >> 1) * 16 + swz / 64; C = (st & 1) * 32 + (swz % 64) / 2; }
__host__ __device__ __forceinline__ int perm32(int rho) { const int n = rho >> 4, i = rho & 15; return 8 * (i >> 2) + 4 * n + (i & 3); }

struct Unit { int pm, pn, e; };

struct StaticOrder {
    int nM, nN, nwg, G, c;
    __device__ void init(int M, int N, int G_, int c_) { nM = M / BM; nN = N / BM; nwg = nM * nN; G = G_; c = c_; }
    __device__ bool next(int i, Unit& u) const {
        const long L = (long)i * G + c; if (L >= nwg) return false;
        int wgid = (int)L; { const int q = nwg / NXCD, r = nwg % NXCD, xcd = wgid % NXCD, off = wgid / NXCD; wgid = (xcd < r ? xcd * (q + 1) : r * (q + 1) + (xcd - r) * q) + off; }
        const int nig = WGM * nN, gid = wgid / nig, fm = gid * WGM, gsz = (nM - fm) < WGM ? (nM - fm) : WGM;
        u.pm = fm + ((wgid % nig) % gsz); u.pn = (wgid % nig) / gsz; u.e = 0; return true;
    }
};

struct PlainSched : StaticOrder {
    static constexpr bool GATHER = false;
    const char* Bt; int K;
    __device__ __forceinline__ const char* bptr(const Unit& u) const { return Bt + (size_t)u.pn * BM * K; }
    __device__ __forceinline__ unsigned adelta(const Unit& a, const Unit& b) const { return (unsigned)((b.pm - a.pm) * BM * K); }
    __device__ __forceinline__ void aoffs(const Unit& u, unsigned (&o)[2][2]) const {
        int R0, C0, R1, C1; { const int t_ = opaque_v((int)threadIdx.x); stage_rc(t_ * 16, R0, C0); stage_rc(t_ * 16 + 8192, R1, C1); C0 *= 2; C1 *= 2; }
#pragma unroll
        for (int h = 0; h < 2; ++h) { o[h][0] = (unsigned)((u.pm * BM + h * HALF + R0) * K + C0); o[h][1] = (unsigned)((u.pm * BM + h * HALF + R1) * K + C1); }
    }
};

#define PG8_SA(b, h) (((b) * 2 + (h)) * HTB)
#define PG8_SB(b, h) ((4 + (b) * 2 + (h)) * HTB)
#define PG8_STAGE_B(bufoff, gbase) do { glds16s((gbase), voffB, lds0 + (bufoff) + ldsw); glds16s((gbase) + r64, voffB, lds0 + (bufoff) + ldsw + 8192u); } while (0)
#define PG8_STAGE_A(bufoff, gbase, h) do { if constexpr (Sched::GATHER) { glds16s((gbase), vc[h][0], lds0 + (bufoff) + ldsw); glds16s((gbase), vc[h][1], lds0 + (bufoff) + ldsw + 8192u); } \
        else { glds16s((gbase) + (h) * hstep, vc[0][0], lds0 + (bufoff) + ldsw); glds16s((gbase) + (h) * hstep + r64, vc[0][0], lds0 + (bufoff) + ldsw + 8192u); } } while (0)
#define PG8_LDA(dst, b, h) do { _Pragma("unroll") for (int m = 0; m < 4; ++m) _Pragma("unroll") for (int k = 0; k < 2; ++k) dst[m][k] = *(const LAS bf16x8*)(lds + PG8_SA(b, h) + aoff + m * 2048 + k * 1024); } while (0)
#define PG8_LDB(dst, b, h) do { _Pragma("unroll") for (int n = 0; n < 2; ++n) _Pragma("unroll") for (int k = 0; k < 2; ++k) dst[n][k] = *(const LAS bf16x8*)(lds + PG8_SB(b, h) + boff + n * 2048 + k * 1024); } while (0)
#define PG8_MMA(ai, bj, At, Bt) do { __builtin_amdgcn_s_setprio(1); _Pragma("unroll") for (int m = 0; m < 4; ++m) _Pragma("unroll") for (int n = 0; n < 2; ++n) _Pragma("unroll") for (int k = 0; k < 2; ++k) \
        acc[ai][bj][m][n] = __builtin_amdgcn_mfma_f32_16x16x32_bf16(Bt[n][k], At[m][k], acc[ai][bj][m][n], 0, 0, 0); __builtin_amdgcn_s_setprio(0); } while (0)
#define PG8_WAIT_V(n) asm volatile("s_waitcnt vmcnt(" #n ")" ::: "memory")
#define PG8_WAIT_L(n) asm volatile("s_waitcnt lgkmcnt(" #n ")" ::: "memory")
#define PG8_BAR __builtin_amdgcn_s_barrier()
#define PG8_SCHED __builtin_amdgcn_sched_barrier(0)

typedef int i32x4v __attribute__((ext_vector_type(4)));
typedef int i32x8v __attribute__((ext_vector_type(8)));
__device__ __forceinline__ i32x8v cat8(bf16x8 a, bf16x8 b) { const i32x4v x = __builtin_bit_cast(i32x4v, a), y = __builtin_bit_cast(i32x4v, b); return __builtin_shufflevector(x, y, 0, 1, 2, 3, 4, 5, 6, 7); }
#define PG8_MFMA8(accv, b8, a8) asm volatile("v_mfma_f32_16x16x128_f8f6f4 %0, %1, %2, %0" : "+v"(accv) : "v"(b8), "v"(a8))
#define PG8_MFMA_DRAIN() asm volatile("s_nop 15\n\ts_nop 15\n\ts_nop 15\n\ts_nop 15" ::: "memory")
#define PG8_MMA8(ai, bj, At, Bt) do { __builtin_amdgcn_s_setprio(1); _Pragma("unroll") for (int m = 0; m < 4; ++m) _Pragma("unroll") for (int n = 0; n < 2; ++n) \
        PG8_MFMA8(acc[ai][bj][m][n], Bt##8[n], At##8[m]); __builtin_amdgcn_s_setprio(0); } while (0)
#define PG8_MM(ai, bj, At, Bt) do { if constexpr (FP8) PG8_MMA8(ai, bj, At, Bt); else PG8_MMA(ai, bj, At, Bt); } while (0)
#define PG8_LDA8(dst, b, h) do { _Pragma("unroll") for (int m = 0; m < 4; ++m) dst##8[m] = cat8(*(const LAS bf16x8*)(lds + PG8_SA(b, h) + aoff + m * 2048), *(const LAS bf16x8*)(lds + PG8_SA(b, h) + aoff + m * 2048 + 1024)); } while (0)
#define PG8_LDB8(dst, b, h) do { _Pragma("unroll") for (int n = 0; n < 2; ++n) dst##8[n] = cat8(*(const LAS bf16x8*)(lds + PG8_SB(b, h) + boff + n * 2048), *(const LAS bf16x8*)(lds + PG8_SB(b, h) + boff + n * 2048 + 1024)); } while (0)
#define PG8_LA(dst, b, h) do { if constexpr (FP8) PG8_LDA8(dst, b, h); else PG8_LDA(dst, b, h); } while (0)
#define PG8_LB(dst, b, h) do { if constexpr (FP8) PG8_LDB8(dst, b, h); else PG8_LDB(dst, b, h); } while (0)
template <bool FP8, class Epi, class Sched>
__device__ __forceinline__ void gemm_phase(LAS unsigned char* lds, const char* A0, int K, const Sched& S, const Epi& E) {
    asm volatile("" : "+s"(K));
    const int tid = opaque_v((int)threadIdx.x), wid = __builtin_amdgcn_readfirstlane(tid >> 6), lane = tid & 63, wr = wid >> 2, wc = wid & 3, fr = lane & 15, fq = lane >> 4;
    const int nt = K / (BK * 2);
    unsigned voffB;
    { int R0, C0; stage_rc(tid * 16, R0, C0); C0 *= 2;
      const int Rb0 = Epi::PERM ? ((R0 & ~31) + perm32(R0 & 31)) : R0;
      voffB = (unsigned)(Rb0 * K + C0); }
    const size_t r64 = (size_t)64 * K;
    const size_t kstep = (size_t)(BK * 2);
    const size_t hstep = (size_t)HALF * K;
    const unsigned ldsw = (unsigned)wid * 1024u, lds0 = (unsigned)(uintptr_t)lds;
    const int aoff = lds_byte(wr * 64 + fr, fq * 8), boff = lds_byte(wc * 32 + fr, fq * 8);
    Unit cur, nxt; int ui = 0;
    if (!S.next(0, cur)) return;
    f32x4 acc[2][2][4][2];
    float zz_ = 0.f; asm volatile("" : "+v"(zz_));
#pragma unroll
    for (int a = 0; a < 2; ++a)
#pragma unroll
        for (int b = 0; b < 2; ++b)
#pragma unroll
            for (int m = 0; m < 4; ++m)
#pragma unroll
                for (int n = 0; n < 2; ++n) acc[a][b][m][n] = (f32x4){zz_, zz_, zz_, zz_};
    bf16x8 At[4][2], B0[2][2], B1[2][2];
    i32x8v At8[4], B08[2], B18[2];
    unsigned vc[2][2], vn[2][2];
    int rcA = 0; if constexpr (Sched::GATHER) { int R0_, C0_; stage_rc(tid * 16, R0_, C0_); rcA = (R0_ << 8) | (C0_ * 2); }
    S.aoffs(cur, vc);
    const char* cB = S.bptr(cur);
    int sbc = 0;
#define PG8_SIDE(u_, buf_) do { if constexpr (Epi::NSIDE > 0) { _Pragma("unroll") for (int i_ = 0; i_ < Epi::NSIDE; ++i_) if (wid == i_) { const int ln_ = opaque_v((int)threadIdx.x) & 63; \
        const unsigned long long sp_ = (unsigned long long)(uintptr_t)E.side_base((u_), i_); const unsigned lo_ = __builtin_amdgcn_readfirstlane((unsigned)sp_), hi_ = __builtin_amdgcn_readfirstlane((unsigned)(sp_ >> 32)); \
        glds16s((const void*)(uintptr_t)(((unsigned long long)hi_ << 32) | lo_), E.side_voff(ln_, i_), lds0 + (unsigned)LDS_SIDE + (unsigned)(buf_) * 2048u + (unsigned)i_ * 1024u); } } } while (0)
    PG8_SIDE(cur, 0);
    PG8_STAGE_B(PG8_SB(0, 0), cB); PG8_STAGE_B(PG8_SB(0, 1), cB + hstep); PG8_STAGE_A(PG8_SA(0, 0), A0, 0); PG8_STAGE_A(PG8_SA(0, 1), A0, 1);
    if (wr == 1) PG8_BAR;
    PG8_WAIT_V(2); PG8_BAR;
    PG8_STAGE_B(PG8_SB(1, 0), cB + kstep); PG8_STAGE_A(PG8_SA(1, 0), A0 + kstep, 0); PG8_STAGE_B(PG8_SB(1, 1), cB + hstep + kstep);
    PG8_WAIT_V(6); PG8_BAR;
#pragma unroll 1
    for (;;) {
        const bool has_next = S.next(ui + 1, nxt);
        const char* nB = cB; unsigned dlt = 0u;
        if constexpr (Sched::GATHER) {
            if (has_next) { S.aload(nxt, vn, rcA); nB = S.bptr(nxt); }
        } else { if (has_next) { dlt = S.adelta(cur, nxt); nB = S.bptr(nxt); } }
        const int sbn = (sbc == 2) ? 0 : sbc + 1;
        if (has_next) PG8_SIDE(nxt, sbn);
#pragma unroll 1
        for (int t = 0; t < nt; t += 2) {
            const bool last = (t == nt - 2);
            const char* a1 = A0 + (size_t)(t + 1) * kstep;
            const char* a2 = last ? A0 : A0 + (size_t)(t + 2) * kstep; const char* b2 = last ? nB : cB + (size_t)(t + 2) * kstep;
            const char* a3 = a2 + kstep; const char* b3 = b2 + kstep;
            PG8_LB(B0, 0, 0); PG8_LB(B1, 0, 1); PG8_SCHED; PG8_LA(At, 0, 0); PG8_STAGE_A(PG8_SA(1, 1), a1, 1);
            PG8_WAIT_V(8); PG8_WAIT_L(0); PG8_BAR;
            if (last) {
                if constexpr (Sched::GATHER) { if (has_next) {
#pragma unroll
                    for (int h = 0; h < 2; ++h) { vc[h][0] = (unsigned)opaque_v((int)vn[h][0]); vc[h][1] = (unsigned)opaque_v((int)vn[h][1]); }
                    S.aconv(vc, rcA); } }
                else vc[0][0] += dlt; }
            PG8_MM(0, 0, At, B0); PG8_MM(0, 1, At, B1); PG8_BAR; PG8_SCHED;
            PG8_LA(At, 0, 1); PG8_STAGE_B(PG8_SB(0, 0), b2); PG8_STAGE_B(PG8_SB(0, 1), b2 + hstep); PG8_STAGE_A(PG8_SA(0, 0), a2, 0);
            PG8_WAIT_V(8); PG8_WAIT_L(0); PG8_BAR; PG8_MM(1, 0, At, B0); PG8_MM(1, 1, At, B1); PG8_BAR; PG8_SCHED;
            PG8_LB(B0, 1, 0); PG8_LB(B1, 1, 1); PG8_SCHED; PG8_LA(At, 1, 0); PG8_STAGE_A(PG8_SA(0, 1), a2, 1);
            PG8_WAIT_V(8); PG8_WAIT_L(0); PG8_BAR; PG8_MM(0, 0, At, B0); PG8_MM(0, 1, At, B1); PG8_BAR; PG8_SCHED;
            PG8_LA(At, 1, 1); PG8_STAGE_B(PG8_SB(1, 0), b3); PG8_STAGE_B(PG8_SB(1, 1), b3 + hstep); PG8_STAGE_A(PG8_SA(1, 0), a3, 0);
            PG8_WAIT_V(8); PG8_WAIT_L(0); PG8_BAR; PG8_MM(1, 0, At, B0); PG8_MM(1, 1, At, B1); PG8_BAR; PG8_SCHED;
        }
        if (wr == 0) PG8_BAR;
        if constexpr (FP8) PG8_MFMA_DRAIN();
        { const int l_ = opaque_v((int)threadIdx.x) & 63; E(acc, cur, wr, wc, l_ & 15, l_ >> 4, (const LAS float*)(lds + LDS_SIDE + sbc * 2048)); }
        if (!has_next) break;
        zz_ = 0.f; asm volatile("" : "+v"(zz_));
#pragma unroll
        for (int a = 0; a < 2; ++a)
#pragma unroll
            for (int b = 0; b < 2; ++b)
#pragma unroll
                for (int m = 0; m < 4; ++m)
#pragma unroll
                    for (int n = 0; n < 2; ++n) acc[a][b][m][n] = (f32x4){zz_, zz_, zz_, zz_};
        cur = nxt; cB = nB; ++ui; sbc = sbn;
        if (wr == 1) PG8_BAR;
    }
    PG8_WAIT_V(0);
    PG8_BAR;
}
}
namespace pg8 {
__device__ __forceinline__ u32x2 pack8_fp8(const f32x4 a, const f32x4 b) { int w0 = 0, w1 = 0;
    w0 = __builtin_amdgcn_cvt_pk_fp8_f32(a[0], a[1], w0, false); w0 = __builtin_amdgcn_cvt_pk_fp8_f32(a[2], a[3], w0, true);
    w1 = __builtin_amdgcn_cvt_pk_fp8_f32(b[0], b[1], w1, false); w1 = __builtin_amdgcn_cvt_pk_fp8_f32(b[2], b[3], w1, true); u32x2 r; r.x = (unsigned)w0; r.y = (unsigned)w1; return r; }
__device__ __forceinline__ u32x4 pack8(const f32x4 a, const f32x4 b) { u32x4 w; w.x = cvt_pk_bf16(a[0], a[1]); w.y = cvt_pk_bf16(a[2], a[3]); w.z = cvt_pk_bf16(b[0], b[1]); w.w = cvt_pk_bf16(b[2], b[3]); return w; }

struct EpiNull { static constexpr bool PERM = true; static constexpr int NSIDE = 0;
    __device__ __forceinline__ void operator()(const f32x4 (&acc)[2][2][4][2], const Unit& u, int wr, int wc, int fr, int fq, const LAS float* sd) const {} };
struct EpiPlainBf16 {
    static constexpr bool PERM = true; static constexpr int NSIDE = 0;
    bf16_t* O; int ldc; float sc;
    __device__ __forceinline__ void operator()(const f32x4 (&acc)[2][2][4][2], const Unit& u, int wr, int wc, int fr, int fq, const LAS float* sd) const {
        const int row0 = u.pm * BM + wr * 64 + fr, col0 = u.pn * BM + wc * 32 + 8 * fq;
#pragma unroll
        for (int ai = 0; ai < 2; ++ai)
#pragma unroll
            for (int m = 0; m < 4; ++m) { bf16_t* rowp = O + (size_t)(row0 + ai * HALF + m * 16) * ldc + col0;
#pragma unroll
                for (int bj = 0; bj < 2; ++bj) *(u32x4*)(rowp + bj * HALF) = pack8(acc[ai][bj][m][0] * sc, acc[ai][bj][m][1] * sc);
                __builtin_amdgcn_sched_barrier(0); }
    }
};

struct EpiHgrnIn {
    static constexpr bool PERM = true; static constexpr int NSIDE = 0;
    bf16_t* P; float* LF; const float* lb;
    int segmap; float scale;
    __device__ __forceinline__ void operator()(const f32x4 (&acc)[2][2][4][2], const Unit& u, int wr, int wc, int fr, int fq, const LAS float* sd) const {
        const int seg = (segmap >> (4 * (u.pn >> 2))) & 15;
        const int col0 = (u.pn & 3) * BM + wc * 32 + 8 * fq;
        const size_t ub = (size_t)((u.pm * 4 + wr) * 8 + (u.pn & 3) * 2) * 8192;
        const size_t base_t = ub + (size_t)(((2 * wc + (fq >> 1)) * 64 + (fr & 3) * 16 + (fr >> 2)) * 16 + 8 * (fq & 1));
        if (seg == 1) {
            float lbv[2][8];
#pragma unroll
            for (int bj = 0; bj < 2; ++bj) { const f32x4 a = *(const f32x4*)(lb + col0 + bj * HALF), b = *(const f32x4*)(lb + col0 + bj * HALF + 4);
                lbv[bj][0] = a[0]; lbv[bj][1] = a[1]; lbv[bj][2] = a[2]; lbv[bj][3] = a[3]; lbv[bj][4] = b[0]; lbv[bj][5] = b[1]; lbv[bj][6] = b[2]; lbv[bj][7] = b[3]; }
#pragma unroll
            for (int ai = 0; ai < 2; ++ai)
#pragma unroll
                for (int m = 0; m < 4; ++m) { const size_t off = base_t + (size_t)ai * 131072 + m * 64;
#pragma unroll
                    for (int bj = 0; bj < 2; ++bj) { float lf[8], ky[8];
#pragma unroll
                        for (int j = 0; j < 8; ++j) { const float f = acc[ai][bj][m][j >> 2][j & 3], l = lbv[bj][j];
                            const float sg = fsigmoid(f); const float fg = l + (1.0f - l) * sg;
                            lf[j] = __builtin_amdgcn_logf(fmaxf(fg, 1e-30f));        ky[j] = (1.0f - l) * (1.0f - sg); }
                        { u32x4 lw; lw.x = pk_f16(lf[0], lf[1]); lw.y = pk_f16(lf[2], lf[3]); lw.z = pk_f16(lf[4], lf[5]); lw.w = pk_f16(lf[6], lf[7]); *(u32x4*)((unsigned short*)LF + off + bj * 8192) = lw; }
                        u32x4 w; w.x = cvt_pk_bf16(ky[0], ky[1]); w.y = cvt_pk_bf16(ky[2], ky[3]); w.z = cvt_pk_bf16(ky[4], ky[5]); w.w = cvt_pk_bf16(ky[6], ky[7]);
                        *(u32x4*)(P + (size_t)T * D + off + bj * 8192) = w; }
                    __builtin_amdgcn_sched_barrier(0); }
        } else {
            bf16_t* O = P + (size_t)seg * T * D;
            const bool act = (seg != 2);
            size_t base = base_t; int SB = 8192, SM = 64;
            if (seg == 2) { base = ub + (size_t)(((4 * wc + fq) * 64 + fr) * 8); SM = 128; }
            if (seg == 3) { base = (size_t)(u.pm * BM + wr * 64 + fr) * D + col0; SB = HALF; SM = 16 * D; }
#pragma unroll
            for (int ai = 0; ai < 2; ++ai)
#pragma unroll
                for (int m = 0; m < 4; ++m) { const size_t off = base + (size_t)ai * 131072 + (size_t)(m * SM);
#pragma unroll
                    for (int bj = 0; bj < 2; ++bj) { f32x4 a = acc[ai][bj][m][0] * scale, b = acc[ai][bj][m][1] * scale;
                        asm volatile("" : "+v"(a), "+v"(b));
                        if (act) {
#pragma unroll
                            for (int j = 0; j < 4; ++j) { a[j] = fsilu(a[j]); b[j] = fsilu(b[j]); } }
                        *(u32x4*)(O + off + bj * SB) = pack8(a, b);
                        __builtin_amdgcn_sched_barrier(0); } }
        }
    }
};

struct EpiResid {
    static constexpr bool PERM = true; static constexpr int NSIDE = 0;
    const float* Xf; bf16_t* Xb; const float* gate; float sc;
    int gstride;
    __device__ __forceinline__ void operator()(const f32x4 (&acc)[2][2][4][2], const Unit& u, int wr, int wc, int fr, int fq, const LAS float* sd) const {
        const int row0 = u.pm * BM + wr * 64 + fr, col0 = u.pn * BM + wc * 32 + 8 * fq;
        const float* g = gate + (size_t)((u.pm * BM) / SEQ) * gstride;
        f32x4 gv[2][2];
#pragma unroll
        for (int bj = 0; bj < 2; ++bj)
#pragma unroll
            for (int n = 0; n < 2; ++n) gv[bj][n] = *(const f32x4*)(g + col0 + bj * HALF + n * 4) * sc;
#pragma unroll
        for (int ai = 0; ai < 2; ++ai) {
            if (Xf) {
#pragma unroll
                for (int mp = 0; mp < 2; ++mp) { f32x4 xin[2][2][2];
#pragma unroll
                    for (int mm = 0; mm < 2; ++mm) { const size_t off = (size_t)(row0 + ai * HALF + (2 * mp + mm) * 16) * D + col0;
#pragma unroll
                        for (int bj = 0; bj < 2; ++bj) { xin[mm][bj][0] = *(const f32x4*)(Xf + off + bj * HALF); xin[mm][bj][1] = *(const f32x4*)(Xf + off + bj * HALF + 4); } }
#pragma unroll
                    for (int mm = 0; mm < 2; ++mm) { const int m = 2 * mp + mm; const size_t off = (size_t)(row0 + ai * HALF + m * 16) * D + col0;
#pragma unroll
                        for (int bj = 0; bj < 2; ++bj) *(u32x4*)(Xb + off + bj * HALF) = pack8(xin[mm][bj][0] + gv[bj][0] * acc[ai][bj][m][0], xin[mm][bj][1] + gv[bj][1] * acc[ai][bj][m][1]); }
                    __builtin_amdgcn_sched_barrier(0); }
            } else if (ai == 0) {
                u32x4 xw[2][4][2];
#pragma unroll
                for (int a2 = 0; a2 < 2; ++a2)
#pragma unroll
                    for (int m = 0; m < 4; ++m) { const size_t off = (size_t)(row0 + a2 * HALF + m * 16) * D + col0;
#pragma unroll
                        for (int bj = 0; bj < 2; ++bj) xw[a2][m][bj] = *(const u32x4*)(Xb + off + bj * HALF); }
#pragma unroll
                for (int a2 = 0; a2 < 2; ++a2) {
#pragma unroll
                    for (int m = 0; m < 4; ++m) { const size_t off = (size_t)(row0 + a2 * HALF + m * 16) * D + col0;
#pragma unroll
                        for (int bj = 0; bj < 2; ++bj) { const u32x4 w = xw[a2][m][bj];
                            const f32x4 x0 = (f32x4){bflo(w.x), bfhi(w.x), bflo(w.y), bfhi(w.y)}, x1 = (f32x4){bflo(w.z), bfhi(w.z), bflo(w.w), bfhi(w.w)};
                            *(u32x4*)(Xb + off + bj * HALF) = pack8(x0 + gv[bj][0] * acc[a2][bj][m][0], x1 + gv[bj][1] * acc[a2][bj][m][1]); } }
                    __builtin_amdgcn_sched_barrier(0); }
                __builtin_amdgcn_sched_barrier(0); } }
    }
};

struct EpiKvUp {
    static constexpr bool PERM = true; static constexpr int NSIDE = 0;
    bf16_t *Kb, *Vb;
    __device__ __forceinline__ void operator()(const f32x4 (&acc)[2][2][4][2], const Unit& u, int wr, int wc, int fr, int fq, const LAS float* sd) const {
        const int row0 = u.pm * BM + wr * 64 + fr, c = wc * 32 + 8 * fq, h = u.pn;
#pragma unroll
        for (int ai = 0; ai < 2; ++ai)
#pragma unroll
            for (int m = 0; m < 4; ++m) { const size_t row = (size_t)(row0 + ai * HALF + m * 16);
                *(u32x4*)(Kb + row * (MH * QK) + h * QK + c) = pack8(acc[ai][0][m][0], acc[ai][0][m][1]);
                *(u32x4*)(Vb + row * D + h * VD + c) = pack8(acc[ai][1][m][0], acc[ai][1][m][1]);
                __builtin_amdgcn_sched_barrier(0); }
    }
};

struct EpiQUp {
    static constexpr bool PERM = true; static constexpr int NSIDE = 0;
    bf16_t* Qb; const float* rope;
    __device__ __forceinline__ void operator()(const f32x4 (&acc)[2][2][4][2], const Unit& u, int wr, int wc, int fr, int fq, const LAS float* sd) const {
        const int row0 = u.pm * BM + wr * 64 + fr, c = wc * 32 + 8 * fq;
        if (u.pn < 4) {
#pragma unroll
            for (int ai = 0; ai < 2; ++ai)
#pragma unroll
                for (int m = 0; m < 4; ++m) { const size_t row = (size_t)(row0 + ai * HALF + m * 16);
#pragma unroll
                    for (int bj = 0; bj < 2; ++bj) *(u32x4*)(Qb + row * (MH * QK) + (2 * u.pn + bj) * QK + c) = pack8(acc[ai][bj][m][0], acc[ai][bj][m][1]);
                    __builtin_amdgcn_sched_barrier(0); }
        } else {
            const int h = 4 * (u.pn - 4) + wc, i0 = 8 * fq;
#pragma unroll
            for (int ai = 0; ai < 2; ++ai)
#pragma unroll
              for (int mp = 0; mp < 2; ++mp) {
                f32x4 cs[2][4];
#pragma unroll
                for (int mm = 0; mm < 2; ++mm) { const float* rp = rope + (size_t)(row0 + ai * HALF + (2 * mp + mm) * 16) * 64 + i0;
                    cs[mm][0] = *(const f32x4*)(rp); cs[mm][1] = *(const f32x4*)(rp + 4); cs[mm][2] = *(const f32x4*)(rp + 32); cs[mm][3] = *(const f32x4*)(rp + 36); }
#pragma unroll
                for (int mm = 0; mm < 2; ++mm) { const int m = 2 * mp + mm; const size_t row = (size_t)(row0 + ai * HALF + m * 16);
                    const f32x4 c0 = cs[mm][0], c1 = cs[mm][1], s0 = cs[mm][2], s1 = cs[mm][3];
                    const f32x4 a0 = acc[ai][0][m][0], a1 = acc[ai][0][m][1], b0 = acc[ai][1][m][0], b1 = acc[ai][1][m][1];
                    const f32x4 o10 = a0 * c0 - b0 * s0, o11 = a1 * c1 - b1 * s1, o20 = b0 * c0 + a0 * s0, o21 = b1 * c1 + a1 * s1;
                    bf16_t* qp = Qb + row * (MH * QK) + h * QK + NOPE + i0;
                    *(u32x4*)(qp) = pack8(o10, o11); *(u32x4*)(qp + 32) = pack8(o20, o21); }
                __builtin_amdgcn_sched_barrier(0); }
        }
    }
};

template <bool GATHER_> struct MoeSched {
    static constexpr bool GATHER = GATHER_;
    const LAS int* tab;
    const LAS int* blke;
    int NT, G, c;
    const char* Bt; size_t estride; int K;
    const int* rinfo;
    __device__ __forceinline__ unsigned adelta(const Unit& a, const Unit& b) const { return (unsigned)((b.pm - a.pm) * BM * K); }
    __device__ __forceinline__ bool next(int i, Unit& u) const {
        const int L = i * G + c; const int rb = L / NT;
        if (rb >= tab[32]) return false;
        u.pm = rb; u.pn = L - rb * NT; u.e = blke[rb]; return true;
    }
    __device__ __forceinline__ const char* bptr(const Unit& u) const { return Bt + (size_t)u.e * estride + (size_t)u.pn * BM * K; }
    __device__ __forceinline__ void aload(const Unit& u, unsigned (&raw)[2][2], int rc) const {
        const int R0 = rc >> 8; const int lb = (u.pm - tab[u.e]) * BM; const int lim = tab[64 + u.e] - lb;
        const int* rp = rinfo + (size_t)u.e * VCAP + lb;
#pragma unroll
        for (int h = 0; h < 2; ++h) { const int r0 = h * HALF + R0, r1 = r0 + 64; const int a = rp[r0 < lim ? r0 : 0], b = rp[r1 < lim ? r1 : 0];
            raw[h][0] = (unsigned)(r0 < lim ? a : -1); raw[h][1] = (unsigned)(r1 < lim ? b : -1); }
    }
    __device__ __forceinline__ void aconv(unsigned (&o)[2][2], int rc) const {
        const int C0 = rc & 255;
#pragma unroll
        for (int h = 0; h < 2; ++h) { const int i0 = (int)o[h][0], i1 = (int)o[h][1]; const int t0 = (i0 < 0 ? 0 : i0) >> 2, t1 = (i1 < 0 ? 0 : i1) >> 2;
            o[h][0] = (unsigned)(t0 * K + C0); o[h][1] = (unsigned)(t1 * K + C0); }
    }
    __device__ __forceinline__ void aoffs(const Unit& u, unsigned (&o)[2][2]) const {
        int R0, C0, R1, C1; { const int t_ = opaque_v((int)threadIdx.x); stage_rc(t_ * 16, R0, C0); stage_rc(t_ * 16 + 8192, R1, C1); C0 *= 2; C1 *= 2; }
        if constexpr (GATHER_) { const int rc = (R0 << 8) | C0; aload(u, o, rc); aconv(o, rc); }
        else {
#pragma unroll
            for (int h = 0; h < 2; ++h) { o[h][0] = (unsigned)((u.pm * BM + h * HALF + R0) * K + C0); o[h][1] = (unsigned)((u.pm * BM + h * HALF + R1) * K + C1); }
        }
    }
};

struct MoeSchedHot : MoeSched<true> {
    __device__ __forceinline__ bool next(int i, Unit& u) const { if (!MoeSched<true>::next(i, u)) return false; u.pm &= 3; u.pn = 0; u.e = blke[u.pm]; return true; } };

struct EpiMoeGU {
    static constexpr bool PERM = true; static constexpr int NSIDE = 1;
    unsigned char* ACT; const float* bgu;
    __device__ __forceinline__ const char* side_base(const Unit& u, int) const { return (const char*)(bgu + (size_t)u.e * 2048 + u.pn * HALF); }
    __device__ __forceinline__ unsigned side_voff(int lane, int) const { return (unsigned)((lane & 31) * 16 + (lane >> 5) * 4096); }
    __device__ __forceinline__ void operator()(const f32x4 (&acc)[2][2][4][2], const Unit& u, int wr, int wc, int fr, int fq, const LAS float* sd) const {
        const int row0 = u.pm * BM + wr * 64 + fr, c = u.pn * HALF + wc * 32 + 8 * fq;
        const LAS float* bp = sd + wc * 32 + 8 * fq;
        const f32x4 bg0 = *(const LAS f32x4*)(bp), bg1 = *(const LAS f32x4*)(bp + 4), bu0 = *(const LAS f32x4*)(bp + 128) + 1.0f, bu1 = *(const LAS f32x4*)(bp + 132) + 1.0f;
#pragma unroll
        for (int ai = 0; ai < 2; ++ai)
#pragma unroll
            for (int m = 0; m < 4; ++m) { const size_t row = (size_t)(row0 + ai * HALF + m * 16);
                const f32x4 lim = (f32x4){SWIGLU_LIMIT, SWIGLU_LIMIT, SWIGLU_LIMIT, SWIGLU_LIMIT};
                const f32x4 g0 = __builtin_elementwise_min(acc[ai][0][m][0] * 0.015625f + bg0, lim), g1 = __builtin_elementwise_min(acc[ai][0][m][1] * 0.015625f + bg1, lim);
                const f32x4 u0 = __builtin_elementwise_min(__builtin_elementwise_max(acc[ai][1][m][0] * 0.015625f + bu0, 1.0f - lim), 1.0f + lim), u1 = __builtin_elementwise_min(__builtin_elementwise_max(acc[ai][1][m][1] * 0.015625f + bu1, 1.0f - lim), 1.0f + lim);
                const f32x4 z0 = g0 * (-SWIGLU_ALPHA * 1.4426950408889634f), z1 = g1 * (-SWIGLU_ALPHA * 1.4426950408889634f);
                f32x4 s0, s1;
#pragma unroll
                for (int j = 0; j < 4; ++j) { s0[j] = __builtin_amdgcn_rcpf(1.0f + __builtin_amdgcn_exp2f(z0[j])); s1[j] = __builtin_amdgcn_rcpf(1.0f + __builtin_amdgcn_exp2f(z1[j])); }
                const f32x4 r0 = u0 * (g0 * s0), r1 = u1 * (g1 * s1);
                *(u32x2*)(ACT + row * FF + c) = pack8_fp8(r0, r1);
                __builtin_amdgcn_sched_barrier(0); }
    }
};

struct EpiMoeDN {
    static constexpr bool PERM = true; static constexpr int NSIDE = 2;
    unsigned char* YS; const float* bdn; const LAS int* tab; const float* rw;
    __device__ __forceinline__ const char* side_base(const Unit& u, int i) const { return i == 0 ? (const char*)(rw + (size_t)u.e * VCAP + (size_t)(u.pm - tab[u.e]) * BM) : (const char*)(bdn + (size_t)u.e * 1024 + u.pn * BM); }
    __device__ __forceinline__ unsigned side_voff(int lane, int) const { return (unsigned)(lane * 16); }
    __device__ __forceinline__ void operator()(const f32x4 (&acc)[2][2][4][2], const Unit& u, int wr, int wc, int fr, int fq, const LAS float* sd) const {
        const int row0 = u.pm * BM + wr * 64 + fr, c = u.pn * BM + wc * 32 + 8 * fq;
        const LAS float* bp = sd + 256 + wc * 32 + 8 * fq; const LAS float* wp = sd + wr * 64 + fr;
        f32x4 bb[2][2];
#pragma unroll
        for (int bj = 0; bj < 2; ++bj) { bb[bj][0] = *(const LAS f32x4*)(bp + bj * HALF) * 64.0f; bb[bj][1] = *(const LAS f32x4*)(bp + bj * HALF + 4) * 64.0f; }
#pragma unroll
        for (int ai = 0; ai < 2; ++ai)
#pragma unroll
            for (int m = 0; m < 4; ++m) { const float w = wp[ai * HALF + m * 16] * 0.5f;
                unsigned char* yp = YS + (size_t)(row0 + ai * HALF + m * 16) * D + c;
#pragma unroll
                for (int bj = 0; bj < 2; ++bj) {
                    const f32x4 v0 = (acc[ai][bj][m][0] + bb[bj][0]) * w, v1 = (acc[ai][bj][m][1] + bb[bj][1]) * w;
                    int p0 = 0, p1 = 0;
                    p0 = __builtin_amdgcn_cvt_pk_fp8_f32(__builtin_amdgcn_fmed3f(v0[0], -448.f, 448.f), __builtin_amdgcn_fmed3f(v0[1], -448.f, 448.f), p0, false);
                    p0 = __builtin_amdgcn_cvt_pk_fp8_f32(__builtin_amdgcn_fmed3f(v0[2], -448.f, 448.f), __builtin_amdgcn_fmed3f(v0[3], -448.f, 448.f), p0, true);
                    p1 = __builtin_amdgcn_cvt_pk_fp8_f32(__builtin_amdgcn_fmed3f(v1[0], -448.f, 448.f), __builtin_amdgcn_fmed3f(v1[1], -448.f, 448.f), p1, false);
                    p1 = __builtin_amdgcn_cvt_pk_fp8_f32(__builtin_amdgcn_fmed3f(v1[2], -448.f, 448.f), __builtin_amdgcn_fmed3f(v1[3], -448.f, 448.f), p1, true);
                    u32x2 o; o.x = (unsigned)p0; o.y = (unsigned)p1; *(u32x2*)(yp + bj * HALF) = o; }
                __builtin_amdgcn_sched_barrier(0); }
    }
};
}
typedef const __attribute__((address_space(4))) unsigned long long* KargPtr;
struct InTab { KargPtr p;
    __device__ __forceinline__ const float* operator[](int i) const { KargPtr q = p; asm volatile("" : "+s"(q)); return (const float*)(const GAS float*)q[i]; } };
struct Ctx {
    LAS unsigned char* lds;
    int G, vcu;
    InTab in; float* out; unsigned char* ws;
    __device__ __forceinline__ float* MOD() const { return (float*)(ws + WS_MOD); }
    __device__ __forceinline__ unsigned* ctl() const { return (unsigned*)(ws + WS_CTL); }
};
__device__ __forceinline__ const float* modp(const Ctx& F, int l, int b, int which) { return (const float*)(F.ws + WS_MOD) + ((size_t)(l * NB + b) * 6 + which) * D; }

__device__ const double ROPE_INV_FREQ[32] = {
    1.0, 0.7498942093324559, 0.5623413251903491, 0.4216965034285822, 0.31622776601683794, 0.23713737056616552, 0.1778279410038923, 0.1333521432163324,
    0.1, 0.07498942093324559, 0.05623413251903491, 0.04216965034285822, 0.03162277660168379, 0.023713737056616554, 0.01778279410038923, 0.01333521432163324,
    0.01, 0.007498942093324559, 0.005623413251903491, 0.004216965034285822, 0.0031622776601683794, 0.0023713737056616554, 0.001778279410038923, 0.001333521432163324,
    0.001, 0.0007498942093324559, 0.0005623413251903491, 0.0004216965034285822, 0.00031622776601683794, 0.00023713737056616554, 0.0001778279410038923, 0.0001333521432163324};

__device__ __forceinline__ int map_rows(int maptype, int n0) {
    if (maptype == 1) { return n0 < 1024 ? (n0 >> 7) * 256 + (n0 & 127) : ((n0 - 1024) >> 7) * 256 + 128 + ((n0 - 1024) & 127); }
    if (maptype == 2) { const int h = n0 / QK, d = n0 - h * QK; if (d < NOPE) return h * NOPE + d; const int i = d - NOPE;
                        return 1024 + (h >> 2) * 256 + (i >> 5) * 128 + (h & 3) * 32 + (i & 31); }
    return n0;
}
struct ConvD { const float* src; unsigned char* dst; int N, Kb; };
#define CONV_DEC(Wp, wstride, nmat, K_, N_, dstoff, dstride, mt, f8_) CONV_DECP(Wp, wstride, nmat, K_, N_, N_, dstoff, dstride, mt, f8_)
#define CONV_DECP(Wp, wstride, nmat, K_, N_, pitch_, dstoff, dstride, mt, f8_) do { if ((f8_) == PASS8) { constexpr int KD = (f8_) ? 128 : 64; const int per = ((K_) / KD) * ((N_) / 32), tot = (nmat) * per; \
        if (r < tot) { const int mi = r / per, item = r - mi * per, nblk = (N_) / 32, kb = item / nblk, nb = item - kb * nblk, es = (f8_) ? 1 : 2; \
            d.src = (Wp) + (size_t)mi * (wstride) + (size_t)(KD * kb) * (pitch_) + 32 * nb; d.N = (pitch_); d.Kb = (K_) * es; \
            d.dst = F.ws + (dstoff) + ((size_t)mi * (dstride) + (size_t)map_rows((mt), 32 * nb) * (K_) + KD * kb) * es; return; } r -= tot; } } while (0)
template <int PASS8> __device__ __forceinline__ void conv_decode(const Ctx& F, int it, ConvD& d) {
    int r = it;
    CONV_DEC(F.in[23], (size_t)1024 * 2048, 128, 1024, 2048, WS_WGU, (size_t)2048 * 1024, 1, 1);
    CONV_DEC(F.in[25], (size_t)1024 * 1024, 128, 1024, 1024, WS_WDN, (size_t)1024 * 1024, 0, 1);
    CONV_DECP(F.in[7],        (size_t)1024 * 4096, 2, 1024, 1024, 4096, WS_WIN, (size_t)3072 * 1024, 0, 1);
    CONV_DECP(F.in[7] + 2048, (size_t)1024 * 4096, 2, 1024, 1024, 4096, WS_WIN + (size_t)1024 * 1024, (size_t)3072 * 1024, 0, 1);
    CONV_DECP(F.in[7] + 3072, (size_t)1024 * 4096, 2, 1024, 1024, 4096, WS_WIN + (size_t)2048 * 1024, (size_t)3072 * 1024, 0, 1);
    CONV_DECP(F.in[7] + 1024, (size_t)1024 * 4096, 2, 1024, 1024, 4096, WS_WINF, (size_t)1024 * 1024, 0, 0);
    CONV_DEC(F.in[10], (size_t)1024 * 1024, 2, 1024, 1024, WS_WOUT, (size_t)1024 * 1024, 0, 1);
    CONV_DEC(F.in[14], (size_t)0, 1, 1024, 320, WS_WDKV, (size_t)0, 0, 1);
    CONV_DEC(F.in[16], (size_t)0, 1, 256, 2048, WS_WUKV, (size_t)0, 0, 0);
    CONV_DEC(F.in[17], (size_t)1024 * 384, 2, 1024, 384, WS_WDQ, (size_t)512 * 1024, 0, 1);
    CONV_DEC(F.in[19], (size_t)384 * 1536, 2, 384, 1536, WS_WUQ, (size_t)1536 * 384, 2, 0);
    CONV_DEC(F.in[20], (size_t)1024 * 1024, 2, 1024, 1024, WS_WO, (size_t)1024 * 1024, 0, 1);
    d.src = F.in[20]; d.dst = F.ws + WS_WO; d.N = 1024; d.Kb = 2048;
}
template <int NL> __device__ __forceinline__ void conv_load(const ConvD& d, int lane, float (&wv)[NL]) {
    const float* p = d.src + (size_t)(lane >> 5) * d.N + (lane & 31);
#pragma unroll
    for (int i = 0; i < NL; ++i) wv[i] = p[(size_t)(2 * i) * d.N];
}
template <int NL, int F8> __device__ __forceinline__ void conv_store(const ConvD& d, int lane, LAS float* scr, const float (&wv)[NL]) {
    { LAS float* w = scr + (lane >> 5) * 32; const int n = lane & 31;
#pragma unroll
      for (int i = 0; i < NL; ++i) w[(2 * i) * 32 + (n ^ (i & 24))] = wv[i]; }
    LDS_WAIT(); asm volatile("" ::: "memory");
    const int c = lane & 7;
#pragma unroll
    for (int j = 0; j < 4; ++j) { const int n = (lane >> 3) + 8 * j;
        if constexpr (F8) { const LAS float* s = scr + (16 * c) * 32 + (n ^ (8 * (c & 3)));
            u32x4 o;
#pragma unroll
            for (int q = 0; q < 4; ++q) { int t = 0;
                t = __builtin_amdgcn_cvt_pk_fp8_f32(s[(4 * q) * 32] * 64.f, s[(4 * q + 1) * 32] * 64.f, t, false);
                t = __builtin_amdgcn_cvt_pk_fp8_f32(s[(4 * q + 2) * 32] * 64.f, s[(4 * q + 3) * 32] * 64.f, t, true); o[q] = (unsigned)t; }
            *(u32x4*)(d.dst + (size_t)n * d.Kb + 16 * c) = o; }
        else { const LAS float* s = scr + (8 * c) * 32 + (n ^ (8 * ((c >> 1) & 3)));
            u32x4 o;
#pragma unroll
            for (int q = 0; q < 4; ++q) o[q] = cvt_pk_bf16(s[(2 * q) * 32], s[(2 * q + 1) * 32]);
            *(u32x4*)(d.dst + (size_t)n * d.Kb + 16 * c) = o; } }
    LDS_WAIT(); asm volatile("" ::: "memory");
}
template <int PASS8> __device__ __forceinline__ void conv_pass(const Ctx& F, LAS float* scr, int gw, int NGW, int lane) {
    constexpr int NL = PASS8 ? 64 : 32;
    constexpr int TOTAL = PASS8 ? (128 * 8 * 64 + 128 * 8 * 32 + 3 * 2 * 8 * 32 + 2 * 8 * 32 + 2 * 8 * 32 + 8 * 10 + 2 * 8 * 12) : (2 * 16 * 32 + 4 * 64 + 2 * 6 * 48);
    float wa[NL], wb[NL];
    int it = gw;
    if (it < TOTAL) { ConvD da, db; conv_decode<PASS8>(F, it, da); conv_load<NL>(da, lane, wa);
        for (;;) {
            const int it1 = it + NGW; const bool h1 = it1 < TOTAL;
            if (h1) { conv_decode<PASS8>(F, it1, db); conv_load<NL>(db, lane, wb); }
            conv_store<NL, PASS8>(da, lane, scr, wa);
            if (!h1) break;
            const int it2 = it1 + NGW; const bool h2 = it2 < TOTAL;
            if (h2) { conv_decode<PASS8>(F, it2, da); conv_load<NL>(da, lane, wa); }
            conv_store<NL, PASS8>(db, lane, scr, wb);
            if (!h2) break;
            it = it2;
        } }
}
__device__ __forceinline__ void phase_convert(const Ctx& F) {
    PHASE_IDS;
    LAS float* scr = (LAS float*)(F.lds + wave * 16384);
    const int gw = F.vcu * NWAVES + wave, NGW = F.G * NWAVES;
    conv_pass<1>(F, scr, gw, NGW, lane);
    conv_pass<0>(F, scr, gw, NGW, lane);
    const int gt = (F.vcu * NTHREADS + tid), NGT = F.G * NTHREADS;
    for (int it = gt; it < DEPTH * NE * 128; it += NGT) { const int l = it >> 12, e = (it >> 7) & 31, c = it & 127;
        const float* wp = F.in[21] + (size_t)l * D * NE + (size_t)(8 * c) * NE + e;
        float w[8];
#pragma unroll
        for (int i = 0; i < 8; ++i) w[i] = wp[i * NE];
        u32x4 hi, lo;
#pragma unroll
        for (int q = 0; q < 4; ++q) { const unsigned h = cvt_pk_bf16(w[2 * q], w[2 * q + 1]); hi[q] = h;
            lo[q] = cvt_pk_bf16(w[2 * q] - __uint_as_float(h << 16), w[2 * q + 1] - __uint_as_float(h & 0xffff0000u)); }
        unsigned char* dst = F.ws + WS_WR + (size_t)l * 131072 + (size_t)e * 2048 + 16 * (c ^ (e & 15));
        *(u32x4*)dst = hi; *(u32x4*)(dst + 65536) = lo; }
    for (int i = gt; i < 192 * 1024 / 16; i += NGT) *((u32x4*)(F.ws + WS_WDKV + (size_t)320 * 1024) + i) = (u32x4){0u, 0u, 0u, 0u};
    for (int i = gt; i < 2 * 128 * 1024 / 16; i += NGT) { const int m = i / (128 * 1024 / 16), j = i - m * (128 * 1024 / 16);
        *((u32x4*)(F.ws + WS_WDQ + (size_t)m * 512 * 1024 + (size_t)384 * 1024) + j) = (u32x4){0u, 0u, 0u, 0u}; }
}

__device__ __forceinline__ void phase_mod(const Ctx& F) {
    PHASE_IDS;
    LAS float* cact = (LAS float*)(F.lds);
    LAS float* red = (LAS float*)(F.lds + 65536);
    const float* c = F.in[1];
    for (int i = tid; i < NB * D; i += NTHREADS) { const int b = i / D, k = i - b * D; cact[k * 16 + b] = fsilu(c[i]); }
    __syncthreads();
    constexpr int NTASK = (DEPTH * 6 * D + 2 * D) / 128;
    const int kq = tid >> 7, jj = tid & 127;
    for (int task = F.vcu; task < NTASK; task += F.G) {
        const int gcol = task * 128 + jj;
        const float* W; const float* bias; float* outp; int N, col, l = gcol / (6 * D);
        if (l < DEPTH) { col = gcol - l * 6 * D; N = 6 * D; W = F.in[5] + (size_t)l * D * N; bias = F.in[6] + (size_t)l * N; outp = (float*)(F.ws + WS_MOD) + (size_t)l * NB * N; }
        else { col = gcol - DEPTH * 6 * D; N = 2 * D; W = F.in[12]; bias = F.in[13]; outp = (float*)(F.ws + WS_KVMOD); }
        float acc[16];
#pragma unroll
        for (int b = 0; b < 16; ++b) acc[b] = 0.f;
#pragma unroll 8
        for (int k = kq * 256; k < kq * 256 + 256; ++k) {
            const float w = W[(size_t)k * N + col];
            const LAS f32x4* cp = (const LAS f32x4*)(cact + k * 16);
#pragma unroll
            for (int q = 0; q < 4; ++q) { const f32x4 cv = cp[q]; acc[4 * q] += cv[0] * w; acc[4 * q + 1] += cv[1] * w; acc[4 * q + 2] += cv[2] * w; acc[4 * q + 3] += cv[3] * w; }
        }
#pragma unroll
        for (int q = 0; q < 4; ++q) *(LAS f32x4*)(red + (kq * 128 + jj) * 16 + 4 * q) = (f32x4){acc[4 * q], acc[4 * q + 1], acc[4 * q + 2], acc[4 * q + 3]};
        __syncthreads();
#pragma unroll
        for (int q = 0; q < 4; ++q) { const int o = tid + q * NTHREADS, cj = o >> 4, b = o & 15;
            const float s = red[(0 * 128 + cj) * 16 + b] + red[(1 * 128 + cj) * 16 + b] + red[(2 * 128 + cj) * 16 + b] + red[(3 * 128 + cj) * 16 + b];
            const int oc = (task * 128 + cj) - (l < DEPTH ? l * 6 * D : DEPTH * 6 * D);
            outp[(size_t)b * N + oc] = s + bias[oc]; }
        __syncthreads();
    }
    const int gt = (F.vcu * NTHREADS + tid), NGT = F.G * NTHREADS;
    for (int i = gt; i < D; i += NGT) { const float l0 = F.in[8][i], l1 = F.in[8][D + i];
        ((float*)(F.ws + WS_LB))[i] = 0.f; ((float*)(F.ws + WS_LB))[D + i] = 1.0f / (1.0f + __expf(l0 - l1)); }
    const int* pos = (const int*)F.in[2];
    for (int i = gt; i < T * 32; i += NGT) { const int t = i >> 5, j = i & 31;
        const double rev = (double)pos[t] * ROPE_INV_FREQ[j] * 0.15915494309189535;
        const float fr = (float)(rev - floor(rev));
        float* rp = (float*)(F.ws + WS_ROPE) + (size_t)t * 64 + j;
        rp[0] = __builtin_amdgcn_cosf(fr); rp[32] = __builtin_amdgcn_sinf(fr); }
}

struct Row4 { f32x4 v[4]; };
__device__ __forceinline__ f32x4 bf4lo(const u32x4 w) { return (f32x4){bflo(w.x), bfhi(w.x), bflo(w.y), bfhi(w.y)}; }
__device__ __forceinline__ f32x4 bf4hi(const u32x4 w) { return (f32x4){bflo(w.z), bfhi(w.z), bflo(w.w), bfhi(w.w)}; }
__device__ __forceinline__ int row4_col(int lane, int j) { return 512 * (j >> 1) + 8 * lane + 4 * (j & 1); }
__device__ __forceinline__ Row4 ld_row_f32(const float* p, int lane) { Row4 r; const f32x4* q = (const f32x4*)p + 2 * lane;
#pragma unroll
    for (int j = 0; j < 4; ++j) r.v[j] = q[128 * (j >> 1) + (j & 1)]; return r; }
__device__ __forceinline__ void st_row_f32(float* p, int lane, const Row4& r) { f32x4* q = (f32x4*)p + 2 * lane;
#pragma unroll
    for (int j = 0; j < 4; ++j) q[128 * (j >> 1) + (j & 1)] = r.v[j]; }
__device__ __forceinline__ Row4 ld_row_bf16(const bf16_t* p, int lane) { Row4 r; const u32x4* q = (const u32x4*)p + lane;
#pragma unroll
    for (int jj = 0; jj < 2; ++jj) { const u32x4 w = q[64 * jj]; r.v[2 * jj] = (f32x4){bflo(w.x), bfhi(w.x), bflo(w.y), bfhi(w.y)}; r.v[2 * jj + 1] = (f32x4){bflo(w.z), bfhi(w.z), bflo(w.w), bfhi(w.w)}; } return r; }
__device__ __forceinline__ void st_row_bf16(bf16_t* p, int lane, const Row4& r) { u32x4* q = (u32x4*)p + lane;
#pragma unroll
    for (int jj = 0; jj < 2; ++jj) { u32x4 w; w.x = cvt_pk_bf16(r.v[2 * jj][0], r.v[2 * jj][1]); w.y = cvt_pk_bf16(r.v[2 * jj][2], r.v[2 * jj][3]);
        w.z = cvt_pk_bf16(r.v[2 * jj + 1][0], r.v[2 * jj + 1][1]); w.w = cvt_pk_bf16(r.v[2 * jj + 1][2], r.v[2 * jj + 1][3]); q[64 * jj] = w; } }
__device__ __forceinline__ void st_row_fp8(unsigned char* p, int lane, const Row4& r) { u32x2* q = (u32x2*)p + lane;
#pragma unroll
    for (int jj = 0; jj < 2; ++jj) { int w0 = 0, w1 = 0;
        w0 = __builtin_amdgcn_cvt_pk_fp8_f32(r.v[2 * jj][0], r.v[2 * jj][1], w0, false); w0 = __builtin_amdgcn_cvt_pk_fp8_f32(r.v[2 * jj][2], r.v[2 * jj][3], w0, true);
        w1 = __builtin_amdgcn_cvt_pk_fp8_f32(r.v[2 * jj + 1][0], r.v[2 * jj + 1][1], w1, false); w1 = __builtin_amdgcn_cvt_pk_fp8_f32(r.v[2 * jj + 1][2], r.v[2 * jj + 1][3], w1, true);
        u32x2 o; o.x = (unsigned)w0; o.y = (unsigned)w1; q[64 * jj] = o; } }
__device__ __forceinline__ float row_ssq(const Row4& r) { float s = 0.f;
#pragma unroll
    for (int j = 0; j < 4; ++j) s += (r.v[j][0] * r.v[j][0] + r.v[j][1] * r.v[j][1]) + (r.v[j][2] * r.v[j][2] + r.v[j][3] * r.v[j][3]);
    return wave_sum(s); }
__device__ __forceinline__ Row4 norm_mod(const Row4& x, float rstd, const float* g, const float* sc, const float* sh, int lane) {
    const Row4 gv = ld_row_f32(g, lane), scv = ld_row_f32(sc, lane), shv = ld_row_f32(sh, lane); Row4 h;
#pragma unroll
    for (int j = 0; j < 4; ++j) h.v[j] = (x.v[j] * rstd * gv.v[j]) * (scv.v[j] + 1.0f) + shv.v[j];
    return h; }

template <bool FIRST> struct CombRow;
template <> struct CombRow<true> { f32x4 xf[4]; };
template <> struct CombRow<false> { u32x4 xb[2]; u32x2 ys[4][2]; };
__device__ __forceinline__ f32x4 fp8x4(unsigned w) { const auto lo = __builtin_amdgcn_cvt_pk_f32_fp8((int)w, false), hi = __builtin_amdgcn_cvt_pk_f32_fp8((int)w, true); return (f32x4){lo[0], lo[1], hi[0], hi[1]}; }
template <bool FIRST> __device__ __forceinline__ void comb_load(CombRow<FIRST>& r, const Ctx& F, int m, int lane, int d0, int d1, int d2, int d3) {
    if constexpr (FIRST) { const f32x4* q = (const f32x4*)(F.in[0] + (size_t)m * D) + 2 * lane;
#pragma unroll
        for (int j = 0; j < 4; ++j) r.xf[j] = q[128 * (j >> 1) + (j & 1)]; }
    else { const u32x4* q = (const u32x4*)((const bf16_t*)(F.ws + WS_XB) + (size_t)m * D) + lane; r.xb[0] = q[0]; r.xb[1] = q[64];
#pragma unroll
        for (int s = 0; s < 4; ++s) { const int dr = s == 0 ? d0 : (s == 1 ? d1 : (s == 2 ? d2 : d3));
            const u32x2* y = (const u32x2*)((const unsigned char*)(F.ws + WS_YS) + (size_t)dr * D) + lane; r.ys[s][0] = y[0]; r.ys[s][1] = y[64]; } }
}
template <bool FIRST> __device__ __forceinline__ void phase_combine(const Ctx& F, int l, bool dummy = false) {
    PHASE_IDS;
    const int gw = F.vcu * NWAVES + wave, NGW = F.G * NWAVES;
    bf16_t* XB = (bf16_t*)(F.ws + (dummy ? WS_ACT + (size_t)T * D * 6 : WS_XB));
    float* Xout = dummy ? (float*)(F.ws + WS_ACT) : F.out; bf16_t* Hout = (bf16_t*)(F.ws + (dummy ? WS_ACT + (size_t)T * D * 4 : WS_H));
    for (int ch = gw; ch < T / 32; ch += NGW) {
        const int m0 = ch * 32, b = m0 / SEQ, ln = l + 1;
        Row4 gt, gm, shv;
        if (l >= 0) { gt = ld_row_f32(modp(F, l, b, 5), lane);
#pragma unroll
            for (int j = 0; j < 4; ++j) gt.v[j] *= 0.03125f; }
        if (l == DEPTH - 1) gm = ld_row_f32(F.in[27], lane);
        else { const Row4 g = ld_row_f32(F.in[3] + (size_t)ln * D, lane), sc = ld_row_f32(modp(F, ln, b, 1), lane); shv = ld_row_f32(modp(F, ln, b, 0), lane);
#pragma unroll
            for (int j = 0; j < 4; ++j) gm.v[j] = g.v[j] * (sc.v[j] + 1.0f); }
        CombRow<FIRST> cur, nxt;
        int dv0 = 0, dv1 = 0, dv2 = 0, dv3 = 0;
        if constexpr (!FIRST) { const int4 dd = *(const int4*)((const int*)(F.ws + WS_TKR) + (size_t)(m0 + (lane & 31)) * 4), ee = *(const int4*)((const int*)(F.ws + WS_TKE) + (size_t)(m0 + (lane & 31)) * 4);
            const LAS int* tab = (const LAS int*)(F.lds + LDS_TAB);
            dv0 = tab[ee.x] * MOEB + dd.x; dv1 = tab[ee.y] * MOEB + dd.y; dv2 = tab[ee.z] * MOEB + dd.z; dv3 = tab[ee.w] * MOEB + dd.w; }
#define COMB_D(r_) __shfl(dv0, (r_)), __shfl(dv1, (r_)), __shfl(dv2, (r_)), __shfl(dv3, (r_))
        comb_load<FIRST>(cur, F, m0, lane, COMB_D(0));
        for (int r = 0; r < 32; ++r) {
            const int m = m0 + r;
            if (r + 1 < 32) comb_load<FIRST>(nxt, F, m + 1, lane, COMB_D(r + 1));
            Row4 x;
            if constexpr (FIRST) {
#pragma unroll
                for (int j = 0; j < 4; ++j) x.v[j] = cur.xf[j]; }
            else {
                x.v[0] = bf4lo(cur.xb[0]); x.v[1] = bf4hi(cur.xb[0]); x.v[2] = bf4lo(cur.xb[1]); x.v[3] = bf4hi(cur.xb[1]);
                Row4 y;
                y.v[0] = fp8x4(cur.ys[0][0].x); y.v[1] = fp8x4(cur.ys[0][0].y); y.v[2] = fp8x4(cur.ys[0][1].x); y.v[3] = fp8x4(cur.ys[0][1].y);
#pragma unroll
                for (int s = 1; s < 4; ++s) { y.v[0] += fp8x4(cur.ys[s][0].x); y.v[1] += fp8x4(cur.ys[s][0].y); y.v[2] += fp8x4(cur.ys[s][1].x); y.v[3] += fp8x4(cur.ys[s][1].y); }
#pragma unroll
                for (int j = 0; j < 4; ++j) x.v[j] += gt.v[j] * y.v[j];
            }
            const float rstd = rsqrtf(row_ssq(x) * (1.0f / D) + NORM_EPS);
            if (l == DEPTH - 1) { Row4 o;
#pragma unroll
                for (int j = 0; j < 4; ++j) o.v[j] = x.v[j] * rstd * gm.v[j];
                st_row_f32(Xout + (size_t)m * D, lane, o);
            } else {
                if (l >= 0) st_row_bf16(XB + (size_t)m * D, lane, x);
                Row4 h;
#pragma unroll
                for (int j = 0; j < 4; ++j) h.v[j] = (x.v[j] * rstd) * gm.v[j] + shv.v[j];
                if (ln < NA || dummy) st_row_bf16(Hout + (size_t)m * D, lane, h);
                if (!dummy) st_row_fp8((unsigned char*)(F.ws + WS_H8) + (size_t)m * D, lane, h);
                if (l == NA - 1) {
                    const float* kvm = (const float*)(F.ws + WS_KVMOD) + (size_t)b * 2 * D;
                    const Row4 hk = norm_mod(x, rstd, F.in[11], kvm + D, kvm, lane);
                    st_row_fp8((unsigned char*)(F.ws + WS_HK) + (size_t)m * D, lane, hk);
                }
            }
            if (r + 1 < 32) cur = nxt;
        }
    }
}
__device__ __forceinline__ void phase_final_only(const Ctx& F, bool from_input) {
    PHASE_IDS;
    const int gw = F.vcu * NWAVES + wave, NGW = F.G * NWAVES;
    for (int m = gw; m < T; m += NGW) {
        Row4 x = from_input ? ld_row_f32(F.in[0] + (size_t)m * D, lane) : ld_row_bf16((const bf16_t*)(F.ws + WS_XB) + (size_t)m * D, lane);
        const float rstd = rsqrtf(row_ssq(x) * (1.0f / D) + NORM_EPS);
        const Row4 gv = ld_row_f32(F.in[27], lane); Row4 o;
#pragma unroll
        for (int j = 0; j < 4; ++j) o.v[j] = x.v[j] * rstd * gv.v[j];
        st_row_f32(F.out + (size_t)m * D, lane, o);
    }
}

__device__ __forceinline__ void phase_hgrn_gate(const Ctx& F, int l) {
    PHASE_IDS;
    const int gw = F.vcu * NWAVES + wave, NGW = F.G * NWAVES;
    const bf16_t* OO = (const bf16_t*)(F.ws + WS_OO); const bf16_t* GS = (const bf16_t*)(F.ws + WS_GS); unsigned char* OG = (unsigned char*)(F.ws + WS_OG);
    f32x4 gv[2]; { const float* g = F.in[9] + (size_t)l * HGD + 8 * (lane & 15); gv[0] = *(const f32x4*)g; gv[1] = *(const f32x4*)(g + 4); }
    for (int ch = gw; ch < T / 32; ch += NGW) {
        const u32x4* oq = (const u32x4*)(OO + (size_t)ch * 32 * D) + lane; const u32x4* gq = (const u32x4*)(GS + (size_t)ch * 32 * D) + lane;
        u32x4 co0 = oq[0], co1 = oq[64], cg0 = gq[0], cg1 = gq[64];
        for (int i = 0; i < 32; ++i) {
            u32x4 no0 = co0, no1 = co1, ng0 = cg0, ng1 = cg1;
            if (i + 1 < 32) { no0 = oq[(size_t)(i + 1) * 128]; no1 = oq[(size_t)(i + 1) * 128 + 64]; ng0 = gq[(size_t)(i + 1) * 128]; ng1 = gq[(size_t)(i + 1) * 128 + 64]; }
            Row4 o, g, r; o.v[0] = bf4lo(co0); o.v[1] = bf4hi(co0); o.v[2] = bf4lo(co1); o.v[3] = bf4hi(co1); g.v[0] = bf4lo(cg0); g.v[1] = bf4hi(cg0); g.v[2] = bf4lo(cg1); g.v[3] = bf4hi(cg1);
#pragma unroll
            for (int jh = 0; jh < 2; ++jh) {
                const f32x4 a = o.v[2 * jh], b2 = o.v[2 * jh + 1];
                float s = ((a[0] * a[0] + a[1] * a[1]) + (a[2] * a[2] + a[3] * a[3])) + ((b2[0] * b2[0] + b2[1] * b2[1]) + (b2[2] * b2[2] + b2[3] * b2[3]));
#pragma unroll
                for (int d = 1; d < 16; d <<= 1) s += __shfl_xor(s, d);
                const float rstd = rsqrtf(s * (1.0f / HGD) + NORM_EPS);
                r.v[2 * jh] = (a * rstd * gv[0]) * g.v[2 * jh]; r.v[2 * jh + 1] = (b2 * rstd * gv[1]) * g.v[2 * jh + 1];
            }
            st_row_fp8(OG + ((size_t)ch * 32 + i) * D, lane, r);
            co0 = no0; co1 = no1; cg0 = ng0; cg1 = ng1;
        }
    }
}

__device__ __forceinline__ void phase_kv_rows(const Ctx& F) {
    PHASE_IDS;
    const int gw = F.vcu * NWAVES + wave, NGW = F.G * NWAVES;
    const bf16_t* CKR = (const bf16_t*)(F.ws + WS_CKR); bf16_t* CKV = (bf16_t*)(F.ws + WS_CKV); bf16_t* KB = (bf16_t*)(F.ws + WS_KB);
    const float* rope = (const float*)(F.ws + WS_ROPE);
    const f32x4 gv = *(const f32x4*)(F.in[15] + 4 * lane);
    for (int ch = gw; ch < T / 32; ch += NGW) {
        const int i = lane & 31, hb = (lane >> 5) * 4;
        const bf16_t* rp0 = CKR + (size_t)ch * 32 * 512;
        u32x2 cw = *((const u32x2*)rp0 + lane); unsigned short c1 = rp0[KVRANK + i], c2 = rp0[KVRANK + 32 + i];
        for (int r = 0; r < 32; ++r) {
            const int m = ch * 32 + r; const bf16_t* rpn = rp0 + (size_t)(r + 1) * 512;
            u32x2 nw = cw; unsigned short n1 = c1, n2 = c2;
            if (r + 1 < 32) { nw = *((const u32x2*)rpn + lane); n1 = rpn[KVRANK + i]; n2 = rpn[KVRANK + 32 + i]; }
            const float cs = rope[(size_t)m * 64 + i], sn = rope[(size_t)m * 64 + 32 + i];
            f32x4 v = (f32x4){bflo(cw.x), bfhi(cw.x), bflo(cw.y), bfhi(cw.y)};
            const float ss = wave_sum((v[0] * v[0] + v[1] * v[1]) + (v[2] * v[2] + v[3] * v[3]));
            const float rstd = rsqrtf(ss * (1.0f / KVRANK) + NORM_EPS);
            v = v * rstd * gv;
            u32x2 o; o.x = cvt_pk_bf16(v[0], v[1]); o.y = cvt_pk_bf16(v[2], v[3]);
            *((u32x2*)(CKV + (size_t)m * KVRANK) + lane) = o;
            const float t1 = bf2f(c1), t2 = bf2f(c2);
            const float r1 = t1 * cs - t2 * sn, r2 = t2 * cs + t1 * sn;
            const unsigned short b1 = f2bf(r1), b2 = f2bf(r2);
#pragma unroll
            for (int h = 0; h < 4; ++h) { bf16_t* kp = KB + (size_t)m * (MH * QK) + (hb + h) * QK + NOPE; kp[i] = b1; kp[32 + i] = b2; }
            cw = nw; c1 = n1; c2 = n2;
        }
    }
}

__device__ __forceinline__ void phase_cq_rows(const Ctx& F, int j) {
    PHASE_IDS;
    const int gw = F.vcu * NWAVES + wave, NGW = F.G * NWAVES;
    const bf16_t* CQ = (const bf16_t*)(F.ws + WS_CQ); bf16_t* CQN = (bf16_t*)(F.ws + WS_CQN);
    const float* g = F.in[18] + (size_t)j * QRANK;
    float gq[3][2];
#pragma unroll
    for (int q = 0; q < 3; ++q) { gq[q][0] = g[128 * q + 2 * lane]; gq[q][1] = g[128 * q + 2 * lane + 1]; }
    for (int ch = gw; ch < T / 32; ch += NGW) {
        const unsigned* rp0 = (const unsigned*)(CQ + (size_t)ch * 32 * 512);
        unsigned cwv[3];
#pragma unroll
        for (int q = 0; q < 3; ++q) cwv[q] = rp0[64 * q + lane];
        for (int r = 0; r < 32; ++r) {
            const int m = ch * 32 + r; unsigned nwv[3];
#pragma unroll
            for (int q = 0; q < 3; ++q) nwv[q] = (r + 1 < 32) ? rp0[(size_t)(r + 1) * 256 + 64 * q + lane] : cwv[q];
            float v[3][2]; float s = 0.f;
#pragma unroll
            for (int q = 0; q < 3; ++q) { v[q][0] = bflo(cwv[q]); v[q][1] = bfhi(cwv[q]); s += v[q][0] * v[q][0] + v[q][1] * v[q][1]; }
            const float rstd = rsqrtf(wave_sum(s) * (1.0f / QRANK) + NORM_EPS);
            unsigned* op = (unsigned*)(CQN + (size_t)m * QRANK);
#pragma unroll
            for (int q = 0; q < 3; ++q) op[64 * q + lane] = cvt_pk_bf16(v[q][0] * rstd * gq[q][0], v[q][1] * rstd * gq[q][1]);
#pragma unroll
            for (int q = 0; q < 3; ++q) cwv[q] = nwv[q];
        }
    }
}
__device__ __forceinline__ void phase_router(const Ctx& F, int l, bool dummy = false) {
    PHASE_IDS;
    constexpr int RT0 = LDS_BLKE + NBLK_MAX * 4;
    LAS float* gmt = (LAS float*)(F.lds + RT0);
    LAS float* sht = (LAS float*)(F.lds + RT0 + 4096);
    LAS float* rst = (LAS float*)(F.lds + RT0 + 8192) + wave * 32;
    LAS int* hist = (LAS int*)(F.lds + RT0 + 9216);
    LAS int* basev = (LAS int*)(F.lds + RT0 + 9216 + 128);
    static_assert(RT0 + 9216 + 256 <= LDS_BYTES, "router LDS map");
    LAS float* lgt = (LAS float*)(F.lds) + wave * (32 * 33);
    const unsigned char* Wr = F.ws + WS_WR + (size_t)l * 131072; const float* br = F.in[22] + (size_t)l * NE;
    const bf16_t* X = (const bf16_t*)(F.ws + WS_XB); unsigned char* H = (unsigned char*)(F.ws + (dummy ? WS_ACT : WS_H));
    int* TKE = (int*)(F.ws + (dummy ? WS_YS : WS_TKE)); float* TKW = (float*)(F.ws + (dummy ? WS_YS + 4 * MiB : WS_TKW)); int* TKR = (int*)(F.ws + (dummy ? WS_YS + 8 * MiB : WS_TKR));
    unsigned* cnt = F.ctl() + CW_CNT + l * 64 + (dummy ? 1024 : 0);
    const int r32 = lane & 31, hi = lane >> 5;
    for (int bt = F.vcu; bt < T / 256; bt += F.G) {
        const int b = (bt * 256) / SEQ;
        const float* g = F.in[4] + (size_t)l * D; const float* sc = modp(F, l, b, 4); const float* sh = modp(F, l, b, 3);
        for (int i = tid; i < D; i += NTHREADS) { gmt[i] = g[i] * (1.0f + sc[i]); sht[i] = sh[i]; }
        if (tid < 32) hist[tid] = 0;
        for (int i = tid; i < 131072 / 16; i += NTHREADS) *(LAS u32x4*)(F.lds + 16 * i) = *(const u32x4*)(Wr + 16 * i);
        __syncthreads();
        const int row0 = bt * 256 + wave * 32;
        { const u32x4* xq = (const u32x4*)(X + (size_t)row0 * D) + lane;
          u32x4 c0 = xq[0], c1 = xq[64];
          for (int i = 0; i < 32; ++i) {
            u32x4 n0 = c0, n1 = c1;
            if (i + 1 < 32) { n0 = xq[(size_t)(i + 1) * 128]; n1 = xq[(size_t)(i + 1) * 128 + 64]; }
            Row4 x; x.v[0] = bf4lo(c0); x.v[1] = bf4hi(c0); x.v[2] = bf4lo(c1); x.v[3] = bf4hi(c1);
            const float rstd = rsqrtf(row_ssq(x) * (1.0f / D) + NORM_EPS);
            Row4 h;
#pragma unroll
            for (int j = 0; j < 4; ++j) { const int cc = row4_col(lane, j); const f32x4 gm = *(const LAS f32x4*)(gmt + cc), s4 = *(const LAS f32x4*)(sht + cc); h.v[j] = x.v[j] * rstd * gm + s4; }
            st_row_fp8(H + (size_t)(row0 + i) * D, lane, h);
            if (lane == 0) rst[i] = rstd;
            c0 = n0; c1 = n1;
          } }
        LDS_WAIT(); asm volatile("" ::: "memory");
        f32x16 acc = {};
        { const float rstd = rst[r32]; const bf16_t* xr = X + (size_t)(row0 + r32) * D + 8 * hi; const LAS unsigned char* wb = F.lds + r32 * 2048; const int sw = r32 & 15;
#pragma unroll 2
          for (int j = 0; j < 64; ++j) {
              const u32x4 xw = *(const u32x4*)(xr + 16 * j);
              const f32x4 gm0 = *(const LAS f32x4*)(gmt + 16 * j + 8 * hi), gm1 = *(const LAS f32x4*)(gmt + 16 * j + 8 * hi + 4), s40 = *(const LAS f32x4*)(sht + 16 * j + 8 * hi), s41 = *(const LAS f32x4*)(sht + 16 * j + 8 * hi + 4);
              const f32x4 h0 = bf4lo(xw) * rstd * gm0 + s40, h1 = bf4hi(xw) * rstd * gm1 + s41;
              const int off = 16 * ((2 * j + hi) ^ sw);
              const bf16x8 bh = *(const LAS bf16x8*)(wb + off), bl = *(const LAS bf16x8*)(wb + 65536 + off);
              u32x4 ah, al;
              ah[0] = cvt_pk_bf16(h0[0], h0[1]); ah[1] = cvt_pk_bf16(h0[2], h0[3]); ah[2] = cvt_pk_bf16(h1[0], h1[1]); ah[3] = cvt_pk_bf16(h1[2], h1[3]);
              al[0] = cvt_pk_bf16(h0[0] - __uint_as_float(ah[0] << 16), h0[1] - __uint_as_float(ah[0] & 0xffff0000u)); al[1] = cvt_pk_bf16(h0[2] - __uint_as_float(ah[1] << 16), h0[3] - __uint_as_float(ah[1] & 0xffff0000u));
              al[2] = cvt_pk_bf16(h1[0] - __uint_as_float(ah[2] << 16), h1[1] - __uint_as_float(ah[2] & 0xffff0000u)); al[3] = cvt_pk_bf16(h1[2] - __uint_as_float(ah[3] << 16), h1[3] - __uint_as_float(ah[3] & 0xffff0000u));
              const bf16x8 ahv = __builtin_bit_cast(bf16x8, ah), alv = __builtin_bit_cast(bf16x8, al);
              acc = __builtin_amdgcn_mfma_f32_32x32x16_bf16(ahv, bh, acc, 0, 0, 0);
              acc = __builtin_amdgcn_mfma_f32_32x32x16_bf16(ahv, bl, acc, 0, 0, 0);
              acc = __builtin_amdgcn_mfma_f32_32x32x16_bf16(alv, bh, acc, 0, 0, 0);
          } }
        __syncthreads();
        { const float bias = br[r32];
#pragma unroll
          for (int r = 0; r < 16; ++r) lgt[((r & 3) + 8 * (r >> 2) + 4 * hi) * 33 + r32] = acc[r] + bias; }
        LDS_WAIT(); asm volatile("" ::: "memory");
        int te[4]; float tw[4]; int tr[4];
        if (lane < 32) {
            float v[32];
#pragma unroll
            for (int e = 0; e < 32; ++e) v[e] = lgt[lane * 33 + e];
            float tv[4];
#pragma unroll
            for (int k = 0; k < 4; ++k) { float best = v[0]; int bi = 0;
#pragma unroll
                for (int e = 1; e < 32; ++e) { if (v[e] > best) { best = v[e]; bi = e; } }
                tv[k] = best; te[k] = bi;
#pragma unroll
                for (int e = 0; e < 32; ++e) v[e] = (e == bi) ? -3.0e38f : v[e]; }
            const float e1 = __expf(tv[1] - tv[0]), e2 = __expf(tv[2] - tv[0]), e3 = __expf(tv[3] - tv[0]);
            const float inv = 1.0f / (1.0f + e1 + e2 + e3);
            tw[0] = inv; tw[1] = e1 * inv; tw[2] = e2 * inv; tw[3] = e3 * inv;
#pragma unroll
            for (int k = 0; k < 4; ++k) tr[k] = __hip_atomic_fetch_add(hist + te[k], 1, __ATOMIC_RELAXED, __HIP_MEMORY_SCOPE_WORKGROUP);
        }
        __syncthreads();
        if (tid < 32) basev[tid] = (int)__hip_atomic_fetch_add(cnt + tid, (unsigned)hist[tid], RLX_AGENT);
        __syncthreads();
        if (lane < 32) {
            const int row = row0 + lane;
            int4 ev = make_int4(te[0], te[1], te[2], te[3]); *(int4*)(TKE + (size_t)row * 4) = ev;
            *(f32x4*)(TKW + (size_t)row * 4) = (f32x4){tw[0], tw[1], tw[2], tw[3]};
            int4 rv = make_int4(basev[te[0]] + tr[0], basev[te[1]] + tr[1], basev[te[2]] + tr[2], basev[te[3]] + tr[3]); *(int4*)(TKR + (size_t)row * 4) = rv;
            if (!dummy) { int* RI = (int*)(F.ws + WS_RINFO); float* RW = (float*)(F.ws + WS_RW);
                RI[(size_t)te[0] * VCAP + rv.x] = row * 4 + 0; RI[(size_t)te[1] * VCAP + rv.y] = row * 4 + 1; RI[(size_t)te[2] * VCAP + rv.z] = row * 4 + 2; RI[(size_t)te[3] * VCAP + rv.w] = row * 4 + 3;
                RW[(size_t)te[0] * VCAP + rv.x] = tw[0]; RW[(size_t)te[1] * VCAP + rv.y] = tw[1]; RW[(size_t)te[2] * VCAP + rv.z] = tw[2]; RW[(size_t)te[3] * VCAP + rv.w] = tw[3]; }
        }
        __syncthreads();
    }
}

__device__ __forceinline__ void moe_table(const Ctx& F, int l) {
    PHASE_IDS;
    LAS int* tab = (LAS int*)(F.lds + LDS_TAB);
    if (tid < 32) tab[64 + tid] = (int)__hip_atomic_load(F.ctl() + CW_CNT + l * 64 + tid, RLX_AGENT);
    __syncthreads();
    if (tid == 0) { int s = 0;
        for (int e = 0; e < 32; ++e) { tab[e] = s; s += (tab[64 + e] + MOEB - 1) / MOEB; }
        tab[32] = s; }
    __syncthreads();
    { LAS int* blke = (LAS int*)(F.lds + LDS_BLKE);
      for (int rb = tid; rb < tab[32]; rb += NTHREADS) { int e = 0;
#pragma unroll
          for (int j = 1; j < 32; ++j) e += (tab[j] <= rb) ? 1 : 0;
          blke[rb] = e; } }
    __syncthreads();
}
namespace scan {
constexpr int RS_K = 272, RS_S = 144;
constexpr int O_QT = 0, O_KT = 17408, O_QH = 34816, O_KHT = 52224, O_VT = 70656, O_SS = 79872, O_ST0 = 89088, O_ST1 = 106496, O_SEG = 123904, O_DEC = 125952;
__device__ __forceinline__ bf16x8 ldfrag(const LAS unsigned char* base, int row, int rs, int kb  ) { return *(const LAS bf16x8*)(base + row * rs + kb); }
}
__device__ __forceinline__ void phase_hgrn_scan(const Ctx& F) {
    PHASE_IDS;
    using namespace scan;
    LAS unsigned char* L = F.lds;
    const bf16_t* QH_g = (const bf16_t*)(F.ws + WS_QH); const bf16_t* KK_g = (const bf16_t*)(F.ws + WS_KK); const bf16_t* VV_g = (const bf16_t*)(F.ws + WS_VV);
    const unsigned short* LF_g = (const unsigned short*)(F.ws + WS_LF)  ; bf16_t* OO_g = (bf16_t*)(F.ws + WS_OO);
    const int w = wave, l15 = lane & 15, l4 = lane >> 4;
    const int cg = lane & 3, seg = lane >> 2, kc0 = 16 * w + 4 * cg;
    LAS float* DEC = (LAS float*)(L + O_DEC);
    for (int u = F.vcu; u < NB * HGH * 2; u += F.G) {
        const int vh = u & 1, h = (u >> 1) & 7, b = u >> 4;
        const size_t rowb = (size_t)b * SEQ; const int hk = h * HGD, hv = h * HGD + vh * 64;
        for (int i = tid; i < 64 * RS_K / 16; i += NTHREADS) *(LAS u32x4*)(L + O_ST0 + i * 16) = (u32x4){0u, 0u, 0u, 0u};
        f32x4 sacc[4];
#pragma unroll
        for (int vi = 0; vi < 4; ++vi) sacc[vi] = (f32x4){0.f, 0.f, 0.f, 0.f};
        u32x2 lfr[4]; u32x2 qr[4], kr[4]; u32x4 vw;
#define SCAN_LOAD_LF(c_) do { const size_t base_ = ((size_t)(((b * 64 + (c_)) * 8 + h) * 8 + w)) * 1024 + 4 * lane; \
            _Pragma("unroll") for (int i = 0; i < 4; ++i) lfr[i] = *(const u32x2*)(LF_g + base_ + i * 256); } while (0)
#define SCAN_LOAD_QK(c_) do { const size_t base_ = ((size_t)(((b * 64 + (c_)) * 8 + h) * 8 + w)) * 1024 + 4 * lane; \
            _Pragma("unroll") for (int i = 0; i < 4; ++i) { qr[i] = *(const u32x2*)(QH_g + base_ + i * 256); kr[i] = *(const u32x2*)(KK_g + base_ + i * 256); } } while (0)
#define SCAN_LOAD_V(c_) do { vw = *(const u32x4*)(VV_g + ((size_t)(((b * 64 + (c_)) * 8 + h) * 16 + vh * 8 + w)) * 512 + 8 * lane); } while (0)
#define SCAN_LOAD(c_) do { SCAN_LOAD_LF(c_); SCAN_LOAD_QK(c_); SCAN_LOAD_V(c_); } while (0)
        SCAN_LOAD(0);
        __syncthreads();
#ifdef MK_SCAN_PROBE
#define SP_STAMP(k_) do { if (blockIdx.x == 0 && threadIdx.x == 0) { const unsigned t_ = (unsigned)__builtin_amdgcn_s_memrealtime(); if ((k_) == MK_SCAN_PROBE) *(volatile LAS unsigned*)(F.lds + 147440) += t_ - sp_prev; sp_prev = t_; } } while (0)
        unsigned sp_prev = 0;
#else
#define SP_STAMP(k_) do { } while (0)
#endif
        for (int c = 0; c < SEQ / HGC; ++c) {
            SP_STAMP(0);
            const size_t r0 = rowb + (size_t)c * HGC;
            const LAS unsigned char* STc = L + ((c & 1) ? O_ST1 : O_ST0); LAS unsigned char* STn = L + ((c & 1) ? O_ST0 : O_ST1);
            { float cs[4][4], I[4];
#pragma unroll
              for (int j = 0; j < 4; ++j) { float run = 0.f;
#pragma unroll
                  for (int i = 0; i < 4; ++i) { const unsigned lw_ = (j < 2) ? lfr[i].x : lfr[i].y; run += (j & 1) ? f16hi(lw_) : f16lo(lw_); cs[i][j] = run; }
                  float x = run;
#pragma unroll
                  for (int d = 4; d < 64; d <<= 1) { const float y = __shfl_up(x, d); if (lane >= d) x += y; }
                  I[j] = x; }
              float qv[4][4], kv[4][4];
#pragma unroll
              for (int i = 0; i < 4; ++i) { qv[i][0] = bflo(qr[i].x); qv[i][1] = bfhi(qr[i].x); qv[i][2] = bflo(qr[i].y); qv[i][3] = bfhi(qr[i].y);
                  kv[i][0] = bflo(kr[i].x); kv[i][1] = bfhi(kr[i].x); kv[i][2] = bflo(kr[i].y); kv[i][3] = bfhi(kr[i].y); }
              float qt[4][4], kt[4][4], qh[4][4], kh[4][4];
#pragma unroll
              for (int j = 0; j < 4; ++j) { const float ref = __shfl(I[j], cg + 28), last = __shfl(I[j], cg + 60), P = I[j] - cs[3][j];
                  const float eref = __builtin_amdgcn_exp2f(ref), elr = __builtin_amdgcn_exp2f(last - ref);
                  if (seg == 0) DEC[kc0 + j] = eref * elr;
#pragma unroll
                  for (int i = 0; i < 4; ++i) { const float d = fminf(fmaxf(P + cs[i][j] - ref, -86.56170245f), 86.56170245f); const float E = __builtin_amdgcn_exp2f(d), R = __builtin_amdgcn_rcpf(E);
                      qt[i][j] = qv[i][j] * E; kt[i][j] = kv[i][j] * R; qh[i][j] = qt[i][j] * eref; kh[i][j] = kt[i][j] * elr; } }
#pragma unroll
              for (int i = 0; i < 4; ++i) { const int ro = (4 * seg + i) * RS_K + kc0 * 2; u32x2 o;
                  o.x = cvt_pk_bf16(qt[i][0], qt[i][1]); o.y = cvt_pk_bf16(qt[i][2], qt[i][3]); *(LAS u32x2*)(L + O_QT + ro) = o;
                  o.x = cvt_pk_bf16(kt[i][0], kt[i][1]); o.y = cvt_pk_bf16(kt[i][2], kt[i][3]); *(LAS u32x2*)(L + O_KT + ro) = o;
                  o.x = cvt_pk_bf16(qh[i][0], qh[i][1]); o.y = cvt_pk_bf16(qh[i][2], qh[i][3]); *(LAS u32x2*)(L + O_QH + ro) = o; }
#pragma unroll
              for (int j = 0; j < 4; ++j) { u32x2 o; o.x = cvt_pk_bf16(kh[0][j], kh[1][j]); o.y = cvt_pk_bf16(kh[2][j], kh[3][j]); *(LAS u32x2*)(L + O_KHT + (kc0 + j) * RS_S + seg * 8) = o; }
              LAS unsigned short* vt = (LAS unsigned short*)(L + O_VT + (8 * w) * RS_S) + lane;
              vt[0 * (RS_S / 2)] = (unsigned short)(vw.x & 0xffffu); vt[1 * (RS_S / 2)] = (unsigned short)(vw.x >> 16);
              vt[2 * (RS_S / 2)] = (unsigned short)(vw.y & 0xffffu); vt[3 * (RS_S / 2)] = (unsigned short)(vw.y >> 16);
              vt[4 * (RS_S / 2)] = (unsigned short)(vw.z & 0xffffu); vt[5 * (RS_S / 2)] = (unsigned short)(vw.z >> 16);
              vt[6 * (RS_S / 2)] = (unsigned short)(vw.w & 0xffffu); vt[7 * (RS_S / 2)] = (unsigned short)(vw.w >> 16); }
            SP_STAMP(1);
            __syncthreads();
            SP_STAMP(2);
            if (c + 1 < SEQ / HGC) SCAN_LOAD_LF(c + 1);
#pragma unroll
            for (int q = 0; q < 2; ++q) { const int id = 2 * w + q, si = id >> 2, ti = id & 3;
                f32x4 a = (f32x4){0.f, 0.f, 0.f, 0.f};
                if (si <= ti) {
#pragma unroll
                    for (int ks = 0; ks < 4; ++ks) a = __builtin_amdgcn_mfma_f32_16x16x32_bf16(ldfrag(L + O_KT, si * 16 + l15, RS_K, ks * 64 + l4 * 16), ldfrag(L + O_QT, ti * 16 + l15, RS_K, ks * 64 + l4 * 16), a, 0, 0, 0);
                }
                const int t = ti * 16 + l15, s0 = si * 16 + l4 * 4;
#pragma unroll
                for (int r = 0; r < 4; ++r) a[r] = (s0 + r <= t) ? a[r] : 0.f;
                u32x2 o; o.x = cvt_pk_bf16(a[0], a[1]); o.y = cvt_pk_bf16(a[2], a[3]);
                *(LAS u32x2*)(L + O_SS + t * RS_S + s0 * 2) = o; }
            __syncthreads();
            SP_STAMP(3);
            if (c + 1 < SEQ / HGC) SCAN_LOAD_QK(c + 1);
#pragma unroll
            for (int q = 0; q < 2; ++q) { const int id = 2 * w + q, vi = id >> 2, ti = id & 3;
                f32x4 a = (f32x4){0.f, 0.f, 0.f, 0.f};
#pragma unroll
                for (int ks = 0; ks < 2; ++ks) a = __builtin_amdgcn_mfma_f32_16x16x32_bf16(ldfrag(L + O_VT, vi * 16 + l15, RS_S, ks * 64 + l4 * 16), ldfrag(L + O_SS, ti * 16 + l15, RS_S, ks * 64 + l4 * 16), a, 0, 0, 0);
#pragma unroll
                for (int ks = 0; ks < 4; ++ks) a = __builtin_amdgcn_mfma_f32_16x16x32_bf16(ldfrag(STc, vi * 16 + l15, RS_K, ks * 64 + l4 * 16), ldfrag(L + O_QH, ti * 16 + l15, RS_K, ks * 64 + l4 * 16), a, 0, 0, 0);
                const int t = ti * 16 + l15, v0 = vi * 16 + l4 * 4;
                u32x2 o; o.x = cvt_pk_bf16(a[0], a[1]); o.y = cvt_pk_bf16(a[2], a[3]);
                *(u32x2*)(OO_g + (r0 + t) * D + hv + v0) = o; }
            if (c + 1 < SEQ / HGC) SCAN_LOAD_V(c + 1);
            { const f32x4 dec = *(const LAS f32x4*)(DEC + w * 16 + l4 * 4);
              const bf16x8 ka0 = ldfrag(L + O_KHT, w * 16 + l15, RS_S, l4 * 16), ka1 = ldfrag(L + O_KHT, w * 16 + l15, RS_S, 64 + l4 * 16);
#pragma unroll
              for (int vi = 0; vi < 4; ++vi) { f32x4 a = sacc[vi] * dec;
                  a = __builtin_amdgcn_mfma_f32_16x16x32_bf16(ka0, ldfrag(L + O_VT, vi * 16 + l15, RS_S, l4 * 16), a, 0, 0, 0);
                  a = __builtin_amdgcn_mfma_f32_16x16x32_bf16(ka1, ldfrag(L + O_VT, vi * 16 + l15, RS_S, 64 + l4 * 16), a, 0, 0, 0);
                  sacc[vi] = a;
                  u32x2 o; o.x = cvt_pk_bf16(a[0], a[1]); o.y = cvt_pk_bf16(a[2], a[3]);
                  *(LAS u32x2*)(STn + (vi * 16 + l15) * RS_K + (w * 16 + l4 * 4) * 2) = o; } }
            SP_STAMP(4);
            __syncthreads();
            SP_STAMP(5);
        }
#undef SCAN_LOAD
#undef SCAN_LOAD_LF
#undef SCAN_LOAD_QK
#undef SCAN_LOAD_V
    }
}
namespace mla {
constexpr int QBLK = 32, KVBLK = 64, QB = 256;
constexpr int SHM_V = KVBLK * VD * 2  , SHM_K = KVBLK * QK * 2  ;
constexpr int O_V = 0, O_K = 2 * SHM_V, O_WS = 2 * SHM_V + 2 * SHM_K;
constexpr float SCALE = 0.07216878364870322f;
#define KSWZ192(row, colB) ((row) * 384 + ((colB) ^ (((row) & 7) << 4)))
#define SBAR() __builtin_amdgcn_sched_barrier(0)
__device__ __forceinline__ int v_st(int k, int c) { const int kk = (k & ~0xC) | ((k & 4) << 1) | ((k & 8) >> 1); return ((kk >> 3) * 4 + (c >> 5)) * 512 + ((kk & 7) * 32 + (c & 31)) * 2; }
__device__ __forceinline__ int v_rd_base(int lane) { return ((lane & 3) << 3) | (((lane >> 2) & 3) << 6) | (((lane >> 4) & 1) << 5) | (((lane >> 5) & 1) << 8); }
constexpr int v_rd_off(int d0, int ks, int half) { return d0 * 512 + ks * 4096 + half * 2048; }
__device__ __forceinline__ int crow(int r, int hi) { return (r & 3) + 8 * (r >> 2) + 4 * hi; }
__device__ __forceinline__ void mask_tile(f32x16& p0, f32x16& p1, int dq) {
    const float NEG = -__builtin_inff();
#pragma unroll
    for (int r = 0; r < 16; ++r) { const int c = (r & 3) + 8 * (r >> 2); if (dq - c < 0) p0[r] = NEG; if (dq - c - 32 < 0) p1[r] = NEG; }
}
__device__ __forceinline__ void partialSM(f32x16& p0, f32x16& p1, float& m_reg, float& mn, float& alpha) {
    float pmax = p0[0];
#pragma unroll
    for (int r = 1; r < 16; ++r) pmax = fmaxf(pmax, p0[r]);
#pragma unroll
    for (int r = 0; r < 16; ++r) pmax = fmaxf(pmax, p1[r]);
    { auto rr = __builtin_amdgcn_permlane32_swap(__float_as_uint(pmax), __float_as_uint(pmax), false, false);
      pmax = fmaxf(__uint_as_float(rr[0]), __uint_as_float(rr[1])); }
    constexpr float C2 = 1.4426950408889634f * SCALE;
    constexpr float THR = 8.f;
    if (__builtin_expect(__all((pmax - m_reg) * SCALE <= THR), 1)) { mn = m_reg; alpha = 1.f; }
    else { mn = fmaxf(m_reg, pmax); alpha = __builtin_amdgcn_exp2f((m_reg - mn) * C2); m_reg = mn; }
    const float mnL = -mn * C2;
#pragma unroll
    for (int r = 0; r < 16; ++r) p0[r] = fmaf(p0[r], C2, mnL);
#pragma unroll
    for (int r = 0; r < 16; ++r) p1[r] = fmaf(p1[r], C2, mnL);
#pragma unroll
    for (int r = 0; r < 16; ++r) p0[r] = __builtin_amdgcn_exp2f(p0[r]);
}
__device__ __forceinline__ void finishSM(f32x16& p0, f32x16& p1, float alpha, float& l_reg, bf16x8& pa0, bf16x8& pa1, bf16x8& pa2, bf16x8& pa3) {
#pragma unroll
    for (int r = 0; r < 16; ++r) p1[r] = __builtin_amdgcn_exp2f(p1[r]);
    float ps = 0;
#pragma unroll
    for (int r = 0; r < 16; ++r) ps += p0[r];
#pragma unroll
    for (int r = 0; r < 16; ++r) ps += p1[r];
    { auto rr = __builtin_amdgcn_permlane32_swap(__float_as_uint(ps), __float_as_uint(ps), false, false);
      ps = __uint_as_float(rr[0]) + __uint_as_float(rr[1]); }
    l_reg = l_reg * alpha + ps;
#define PK4(P, B_, OUT) do { unsigned a0 = cvt_pk_bf16(P[B_+0], P[B_+1]), a1 = cvt_pk_bf16(P[B_+2], P[B_+3]);                          \
        unsigned b0 = cvt_pk_bf16(P[B_+4], P[B_+5]), b1 = cvt_pk_bf16(P[B_+6], P[B_+7]);                                             \
        auto r0 = __builtin_amdgcn_permlane32_swap(a0, b0, false, false); auto r1 = __builtin_amdgcn_permlane32_swap(a1, b1, false, false); \
        u32x4 w = {r0[0], r1[0], r0[1], r1[1]}; OUT = *reinterpret_cast<bf16x8*>(&w); } while (0)
    PK4(p0, 0, pa0); PK4(p0, 8, pa1); PK4(p1, 0, pa2); PK4(p1, 8, pa3);
#undef PK4
}
template <int KB>
__device__ __forceinline__ void qkt(f32x16& p0, f32x16& p1, const LAS unsigned char* K_lds, int r32, int hi, const bf16x8* qr) {
    p0 = f32x16{}; p1 = f32x16{};
    const LAS unsigned char* kb[4];
#pragma unroll
    for (int dd = 0; dd < 4; ++dd) kb[dd] = K_lds + KB * SHM_K + KSWZ192(r32, (dd * 16 + hi * 8) * 2);
#pragma unroll
    for (int g = 0; g < 3; ++g) {
        bf16x8 b0[4], b1[4];
#pragma unroll
        for (int dd = 0; dd < 4; ++dd) { const LAS unsigned char* a = kb[dd] + g * 128;
            b0[dd] = *reinterpret_cast<const LAS bf16x8*>(a); b1[dd] = *reinterpret_cast<const LAS bf16x8*>(a + 32 * 384); }
#pragma unroll
        for (int dd = 0; dd < 4; ++dd) {
            p0 = __builtin_amdgcn_mfma_f32_32x32x16_bf16(b0[dd], qr[4 * g + dd], p0, 0, 0, 0);
            p1 = __builtin_amdgcn_mfma_f32_32x32x16_bf16(b1[dd], qr[4 * g + dd], p1, 0, 0, 0); }
        SBAR();
    }
}
template <int KB>
__device__ __forceinline__ void qkt_sm(f32x16& n0, f32x16& n1, const LAS unsigned char* K_lds, int r32, int hi, const bf16x8* qr,
                                       f32x16& p0, f32x16& p1, float& m_reg, float& alpha, float& l_reg, bf16x8& pa0, bf16x8& pa1, bf16x8& pa2, bf16x8& pa3) {
    n0 = f32x16{}; n1 = f32x16{};
    const LAS unsigned char* kb[4];
#pragma unroll
    for (int dd = 0; dd < 4; ++dd) kb[dd] = K_lds + KB * SHM_K + KSWZ192(r32, (dd * 16 + hi * 8) * 2);
    SBAR();
    float pmax = p0[0];
#pragma unroll
    for (int r = 1; r < 16; ++r) pmax = fmaxf(pmax, p0[r]);
#pragma unroll
    for (int r = 0; r < 16; ++r) pmax = fmaxf(pmax, p1[r]);
    { auto rr = __builtin_amdgcn_permlane32_swap(__float_as_uint(pmax), __float_as_uint(pmax), false, false);
      pmax = fmaxf(__uint_as_float(rr[0]), __uint_as_float(rr[1])); }
    constexpr float C2 = 1.4426950408889634f * SCALE;
    constexpr float THR = 8.f;
    const bool keep = __all((pmax - m_reg) * SCALE <= THR);
    const float mn = keep ? m_reg : fmaxf(m_reg, pmax);
    alpha = __builtin_amdgcn_exp2f((m_reg - mn) * C2);
    m_reg = mn;
    const float mnL = -mn * C2;
#pragma unroll
    for (int r = 0; r < 16; ++r) { p0[r] = __builtin_amdgcn_exp2f(fmaf(p0[r], C2, mnL)); p1[r] = __builtin_amdgcn_exp2f(fmaf(p1[r], C2, mnL)); }
    float ps = 0;
#pragma unroll
    for (int r = 0; r < 16; ++r) ps += p0[r] + p1[r];
    { auto rr = __builtin_amdgcn_permlane32_swap(__float_as_uint(ps), __float_as_uint(ps), false, false);
      ps = __uint_as_float(rr[0]) + __uint_as_float(rr[1]); }
    l_reg = l_reg * alpha + ps;
#define PK4(P, B_, OUT) do { unsigned a0 = cvt_pk_bf16(P[B_+0], P[B_+1]), a1 = cvt_pk_bf16(P[B_+2], P[B_+3]);                          \
        unsigned b0 = cvt_pk_bf16(P[B_+4], P[B_+5]), b1 = cvt_pk_bf16(P[B_+6], P[B_+7]);                                             \
        auto r0 = __builtin_amdgcn_permlane32_swap(a0, b0, false, false); auto r1 = __builtin_amdgcn_permlane32_swap(a1, b1, false, false); \
        u32x4 w = {r0[0], r1[0], r0[1], r1[1]}; OUT = *reinterpret_cast<bf16x8*>(&w); } while (0)
    PK4(p0, 0, pa0); PK4(p0, 8, pa1); PK4(p1, 0, pa2); PK4(p1, 8, pa3);
#undef PK4
#pragma unroll
    for (int g = 0; g < 3; ++g) {
#pragma unroll
        for (int hh = 0; hh < 2; ++hh) {
            bf16x8 bq[4];
#pragma unroll
            for (int dd = 0; dd < 4; ++dd) bq[dd] = *reinterpret_cast<const LAS bf16x8*>(kb[dd] + g * 128 + hh * (32 * 384));
#pragma unroll
            for (int dd = 0; dd < 4; ++dd) { if (hh == 0) n0 = __builtin_amdgcn_mfma_f32_32x32x16_bf16(bq[dd], qr[4 * g + dd], n0, 0, 0, 0);
                                             else n1 = __builtin_amdgcn_mfma_f32_32x32x16_bf16(bq[dd], qr[4 * g + dd], n1, 0, 0, 0); } } }
#pragma unroll
    for (int g = 0; g < 6; ++g) {
        __builtin_amdgcn_sched_group_barrier(0x100, 4, 0);
        __builtin_amdgcn_sched_group_barrier(0x402, 8, 0);
#pragma unroll
        for (int i = 0; i < 4; ++i) { __builtin_amdgcn_sched_group_barrier(0x008, 1, 0); __builtin_amdgcn_sched_group_barrier(0x402, 6, 0); }
    }
    SBAR();
}
template <int VB>
__device__ __forceinline__ void pv_tile(f32x16* o, int vb0, bf16x8 pa0, bf16x8 pa1, bf16x8 pa2, bf16x8 pa3) {
#define TRRD(dst, off) asm volatile("ds_read_b64_tr_b16 %0, %1 offset:%2" : "=&v"(dst) : "v"(vb0), "i"(off) : "memory")
#define PV_D0(d0) do { s16x4 l0, l1, l2, l3, h0, h1, h2, h3; constexpr int b_ = VB * SHM_V + v_rd_off(d0, 0, 0); \
        TRRD(l0, b_); TRRD(h0, b_ + 2048); TRRD(l1, b_ + 4096); TRRD(h1, b_ + 6144); TRRD(l2, b_ + 8192); TRRD(h2, b_ + 10240); TRRD(l3, b_ + 12288); TRRD(h3, b_ + 14336); \
        asm volatile("s_waitcnt lgkmcnt(0)" ::: "memory"); SBAR(); \
        o[d0] = __builtin_amdgcn_mfma_f32_32x32x16_bf16(pa0, (bf16x8){l0[0], l0[1], l0[2], l0[3], h0[0], h0[1], h0[2], h0[3]}, o[d0], 0, 0, 0);   \
        o[d0] = __builtin_amdgcn_mfma_f32_32x32x16_bf16(pa1, (bf16x8){l1[0], l1[1], l1[2], l1[3], h1[0], h1[1], h1[2], h1[3]}, o[d0], 0, 0, 0);   \
        o[d0] = __builtin_amdgcn_mfma_f32_32x32x16_bf16(pa2, (bf16x8){l2[0], l2[1], l2[2], l2[3], h2[0], h2[1], h2[2], h2[3]}, o[d0], 0, 0, 0);   \
        o[d0] = __builtin_amdgcn_mfma_f32_32x32x16_bf16(pa3, (bf16x8){l3[0], l3[1], l3[2], l3[3], h3[0], h3[1], h3[2], h3[3]}, o[d0], 0, 0, 0); } while (0)
    PV_D0(0); PV_D0(1); PV_D0(2); PV_D0(3);
#undef PV_D0
#undef TRRD
}
}

__device__ __forceinline__ void attn_block(const Ctx& F, int b, int h, int qb) {
    using namespace mla;
    PHASE_IDS;
    LAS unsigned char* L = F.lds;
    const bf16_t* Qg = (const bf16_t*)(F.ws + WS_QB); const bf16_t* Kg = (const bf16_t*)(F.ws + WS_KB); const bf16_t* Vg = (const bf16_t*)(F.ws + WS_VB); unsigned char* Og = (unsigned char*)(F.ws + WS_AO);
    const int wid = wave, r32 = lane & 31, hi = lane >> 5;
    const size_t rowb = (size_t)b * SEQ; const int P0 = qb * QB;
    const int NT = (P0 + QB) / KVBLK;
    LAS unsigned char* V_lds = L + O_V; LAS unsigned char* K_lds = L + O_K;
    LAS float* wsf = (LAS float*)(L + O_WS) + wid * 64; LAS float* li_l = wsf; LAS float* al_l = wsf + 32;
    const bf16_t* Kh = Kg + rowb * (MH * QK) + h * QK; const bf16_t* Vh = Vg + rowb * D + h * VD;
#define KOFF_(i_) ({ const int p_ = (wid + 8 * (i_)) * 64 + lane, row_ = p_ / 24, cs_ = p_ - row_ * 24, ch_ = cs_ ^ (row_ & 7); (unsigned)(row_ * (MH * QK) + ch_ * 8) * 2u; })
#define VOFF_(i_) ({ const int p_ = (wid + 8 * (i_)) * 64 + lane, sub_ = p_ >> 5, r_ = p_ & 31, kk_ = (sub_ >> 2) * 8 + (r_ >> 2), k_ = (kk_ & ~0xC) | ((kk_ & 4) << 1) | ((kk_ & 8) >> 1), c_ = (sub_ & 3) * 32 + (r_ & 3) * 8; (unsigned)(k_ * D + c_) * 2u; })
    const unsigned koff0 = KOFF_(0), koff1 = KOFF_(1), koff2 = KOFF_(2), voff0 = VOFF_(0), voff1 = VOFF_(1);
#undef KOFF_
#undef VOFF_
    const int vb0 = (int)(uintptr_t)V_lds + v_rd_base(lane);
    bf16x8 qr[12];
    { const bf16_t* qp = Qg + (rowb + P0 + wid * QBLK + r32) * (MH * QK) + h * QK + hi * 8;
#pragma unroll
      for (int d0 = 0; d0 < 12; ++d0) qr[d0] = *(const bf16x8*)(qp + d0 * 16); }
#define DMA(t, bf) do { const char* kp_ = (const char*)(Kh + (size_t)(t) * KVBLK * (MH * QK)); const char* vp_ = (const char*)(Vh + (size_t)(t) * KVBLK * D); \
        glds16s(kp_, koff0, klds0 + (bf) * SHM_K + wid * 1024); glds16s(kp_, koff1, klds0 + (bf) * SHM_K + (wid + 8) * 1024); glds16s(kp_, koff2, klds0 + (bf) * SHM_K + (wid + 16) * 1024); \
        glds16s(vp_, voff0, vlds0 + (bf) * SHM_V + wid * 1024); glds16s(vp_, voff1, vlds0 + (bf) * SHM_V + (wid + 8) * 1024); } while (0)
    const unsigned klds0 = (unsigned)(uintptr_t)K_lds, vlds0 = (unsigned)(uintptr_t)V_lds;
    { const char* kp_ = (const char*)Kh; glds16s(kp_, koff0, klds0 + wid * 1024); glds16s(kp_, koff1, klds0 + (wid + 8) * 1024); glds16s(kp_, koff2, klds0 + (wid + 16) * 1024); } VM_WAIT();
    __syncthreads();
    float m_reg = -1e30f, l_reg = 0.f, mn, alpha; f32x16 o[4] = {}; f32x16 p0, p1; bf16x8 pa0, pa1, pa2, pa3;
    const int qlo = P0 + wid * QBLK, qm = qlo + r32 - 4 * hi;
#define RESC(a) do { if (__any((a) < 1.f)) { if (hi == 0) al_l[r32] = (a); LDS_WAIT(); \
        _Pragma("unroll") for (int d_ = 0; d_ < 4; ++d_) _Pragma("unroll") for (int r = 0; r < 16; ++r) o[d_][r] *= al_l[crow(r, hi)]; } } while (0)
#ifdef MK_ATT_PROBE
#define AT_STAMP(k_) do { if (blockIdx.x == 0 && threadIdx.x == 0) { const unsigned t_ = (unsigned)__builtin_amdgcn_s_memrealtime(); if ((k_) == MK_ATT_PROBE) *(volatile LAS unsigned*)(F.lds + 147440) += t_ - at_prev; at_prev = t_; } } while (0)
    unsigned at_prev = 0;
#else
#define AT_STAMP(k_) do { } while (0)
#endif
#define DMA_K(t, bf) do { const char* kp_ = (const char*)(Kh + (size_t)(t) * KVBLK * (MH * QK)); \
        glds16s(kp_, koff0, klds0 + (bf) * SHM_K + wid * 1024); glds16s(kp_, koff1, klds0 + (bf) * SHM_K + (wid + 8) * 1024); glds16s(kp_, koff2, klds0 + (bf) * SHM_K + (wid + 16) * 1024); } while (0)
#define DMA_V(t, bf) do { const char* vp_ = (const char*)(Vh + (size_t)(t) * KVBLK * D); \
        glds16s(vp_, voff0, vlds0 + (bf) * SHM_V + wid * 1024); glds16s(vp_, voff1, vlds0 + (bf) * SHM_V + (wid + 8) * 1024); } while (0)
#define MASKT(P0_, P1_, t_) do { const int kb_ = (t_) * KVBLK; if (kb_ + KVBLK - 1 > qlo) mask_tile(P0_, P1_, qm - kb_); } while (0)
#define STEPP(s, CB, PN0, PN1, PO0, PO1) do { \
        AT_STAMP(0); \
        if ((s) + 1 < NT) DMA_K((s) + 1, 1 - (CB)); \
        DMA_V((s), (CB)); \
        qkt_sm<CB>(PN0, PN1, K_lds, r32, hi, qr, PO0, PO1, m_reg, alpha, l_reg, pa0, pa1, pa2, pa3); AT_STAMP(1); \
        MASKT(PN0, PN1, (s)); AT_STAMP(2); \
        RESC(alpha); AT_STAMP(3); \
        pv_tile<1 - (CB)>(o, vb0, pa0, pa1, pa2, pa3); AT_STAMP(4); \
        VM_WAIT(); \
        __syncthreads(); AT_STAMP(5); } while (0)
    f32x16 q0, q1;
    { DMA_K(1, 1); DMA_V(0, 0); SBAR(); qkt<0>(p0, p1, K_lds, r32, hi, qr); MASKT(p0, p1, 0); VM_WAIT(); __syncthreads(); }
    for (int s = 1; s + 1 < NT; s += 2) { STEPP(s, 1, q0, q1, p0, p1); STEPP(s + 1, 0, p0, p1, q0, q1); }
    STEPP(NT - 1, 1, q0, q1, p0, p1);
    { partialSM(q0, q1, m_reg, mn, alpha); finishSM(q0, q1, alpha, l_reg, pa0, pa1, pa2, pa3); SBAR(); RESC(alpha); pv_tile<1>(o, vb0, pa0, pa1, pa2, pa3); }
    if (hi == 0) li_l[r32] = l_reg; LDS_WAIT();
    float rli[16];
#pragma unroll
    for (int r = 0; r < 16; ++r) rli[r] = __builtin_amdgcn_rcpf(li_l[crow(r, hi)]);
    unsigned char* Ow = Og + (rowb + P0 + wid * QBLK) * D + h * VD;
#pragma unroll
    for (int r = 0; r < 16; ++r) { const int orow = crow(r, hi);
#pragma unroll
        for (int d0 = 0; d0 < 4; ++d0) { const float v = o[d0][r] * rli[r]; const float vn = __shfl_xor(v, 1);
            if ((r32 & 1) == 0) *(unsigned short*)(Ow + (size_t)orow * D + d0 * 32 + r32) = (unsigned short)__builtin_amdgcn_cvt_pk_fp8_f32(v, vn, 0, false); } }
    __syncthreads();
#undef DMA
#undef DMA_K
#undef DMA_V
#undef MASKT
#undef RESC
#undef STEPP
}
__device__ __forceinline__ void phase_attn(const Ctx& F) {
    constexpr int NQB = SEQ / 256, NITEM = NB * MH * (NQB / 2);
    for (int L = F.vcu; L < NITEM; L += F.G) {
        const int bh = L / (NQB / 2), x = L - bh * (NQB / 2);
        attn_block(F, bh / MH, bh % MH, NQB - 1 - x);
        attn_block(F, bh / MH, bh % MH, x);
    }
}
constexpr int NP = 13, NSTEPS = 2 + DEPTH * NP;
__host__ __device__ constexpr bool step_applies(int st) {
    if (st < 2) return true;
    const int l = (st - 2) / NP, p = (st - 2) % NP;
    if (p == 3) return l >= NA;
    if (p >= 10 || p == 6) return false;
    return true;
}
struct Args { const float* in[28]; float* out; unsigned char* ws; int lo, hi, final_only, pad; };

__global__ void __launch_bounds__(NTHREADS, 2) fwd_kernel(Args args) {
    extern __shared__ __attribute__((aligned(16))) unsigned char lds_raw[];
    Ctx F;
    F.lds = (LAS unsigned char*)lds_raw;
    F.G = gridDim.x; { const int bx = blockIdx.x; F.vcu = (F.G % 8 == 0) ? (bx % 8) * (F.G / 8) + bx / 8 : bx; }
    F.in.p = (KargPtr)__builtin_amdgcn_kernarg_segment_ptr();
    F.out = args.out; F.ws = args.ws;
    volatile LAS unsigned* MISC = (volatile LAS unsigned*)(F.lds + LDS_MISC);
    if (threadIdx.x < 64) MISC[threadIdx.x] = 0u;
    __syncthreads();
#if MK_ONE_LAUNCH
    (void)xcd_barrier_post(F.ctl() + CW_BAR, MISC);
#endif
    const int lo = args.lo, hi = args.hi;
    bool did = false;
#if defined(MK_SCAN_PROBE) || defined(MK_ATT_PROBE)
    if (threadIdx.x == 0) *(volatile LAS unsigned*)(F.lds + 147440) = 0u;
#endif
#ifdef MK_PROBE_MASK
    unsigned long long pr_prev = 0, pr_acc = 0; bool pr_on = false;
#define PR_STAMP(st_) do { if (blockIdx.x == 0 && threadIdx.x == 0) { const unsigned long long t_ = __builtin_amdgcn_s_memrealtime(); if (pr_on) pr_acc += t_ - pr_prev; pr_prev = t_; \
        const int s_ = (st_); int c_ = -1; if (s_ >= 0) { if (s_ < 2) c_ = 26 + s_; else { const int l_ = (s_ - 2) / NP, p_ = (s_ - 2) % NP; c_ = (p_ < 4 && l_ >= NA) ? 13 + p_ : p_; } } \
        pr_on = (c_ >= 0) && (((unsigned long long)(MK_PROBE_MASK) >> c_) & 1ull); } } while (0)
#else
#define PR_STAMP(st_) do { } while (0)
#endif
#if MK_ONE_LAUNCH
#define PHASE_LAUNDER { GAS unsigned char* w_ = (GAS unsigned char*)F.ws; GAS float* o_ = (GAS float*)F.out; int g_ = F.G, v_ = F.vcu; asm volatile("" : "+s"(w_), "+s"(o_), "+s"(g_), "+s"(v_)); F.ws = (unsigned char*)w_; F.out = (float*)o_; F.G = g_; F.vcu = v_; }
#define PHASE_BEGIN(stp) if ((stp) >= lo && (stp) < hi) { if (did) { XcdBarrier b_; b_.bar = F.ctl() + CW_BAR; b_.x = xb_xcc_id(); b_.st = (volatile LAS unsigned*)(F.lds + LDS_MISC); xcd_barrier(b_); } did = true; PR_STAMP(stp); PHASE_LAUNDER
#else
#define PHASE_BEGIN(st) if ((st) >= lo && (st) < hi) { did = true; PHASE_LAUNDER
#endif
#define PHASE_END }

    if (args.final_only) { phase_final_only(F, args.final_only == 1); return; }

    PHASE_BEGIN(0) phase_mod(F); __syncthreads(); phase_convert(F); PHASE_END
    PHASE_BEGIN(1) phase_combine<true>(F, -1); PHASE_END

    { constexpr int l = 0;
    {
        const int sb = 2 + l * NP;
        if (l < NA) {
            PHASE_BEGIN(sb + 0) {
                { pg8::PlainSched S; S.init(T, 3072, F.G, (int)blockIdx.x); S.Bt = (const char*)(F.ws + WS_WIN) + (size_t)l * 3072 * 1024; S.K = 1024;
                  pg8::EpiHgrnIn E{(bf16_t*)(F.ws + WS_QH), (float*)(F.ws + WS_LF), (const float*)(F.ws + WS_LB) + (size_t)l * D, 0x320, 0.015625f};
                  pg8::gemm_phase<true>(F.lds, (const char*)(F.ws + WS_H8), 1024, S, E); }
                { pg8::PlainSched S; S.init(T, 1024, F.G, (int)blockIdx.x); S.Bt = (const char*)(F.ws + WS_WINF) + (size_t)l * 1024 * 1024 * 2; S.K = 2048;
                  pg8::EpiHgrnIn E{(bf16_t*)(F.ws + WS_QH), (float*)(F.ws + WS_LF), (const float*)(F.ws + WS_LB) + (size_t)l * D, 0x1, 1.0f};
                  pg8::gemm_phase<false>(F.lds, (const char*)(F.ws + WS_H), 2048, S, E); } }
            PHASE_END
            PHASE_BEGIN(sb + 1) phase_hgrn_scan(F); PHASE_END
            PHASE_BEGIN(sb + 2) phase_hgrn_gate(F, l); PHASE_END
        } else {
            const int j = l - NA;
            PHASE_BEGIN(sb + 0) {
                if (l == NA) { pg8::PlainSched S; S.init(T, 512, F.G, (int)blockIdx.x); S.Bt = (const char*)(F.ws + WS_WDKV); S.K = 1024;
                    pg8::EpiPlainBf16 E{(bf16_t*)(F.ws + WS_CKR), 512, 0.015625f};
                    pg8::gemm_phase<true>(F.lds, (const char*)(F.ws + WS_HK), 1024, S, E); }
                pg8::PlainSched S; S.init(T, 512, F.G, (int)blockIdx.x); S.Bt = (const char*)(F.ws + WS_WDQ) + (size_t)j * 512 * 1024; S.K = 1024;
                pg8::EpiPlainBf16 E{(bf16_t*)(F.ws + WS_CQ), 512, 0.015625f};
                pg8::gemm_phase<true>(F.lds, (const char*)(F.ws + WS_H8), 1024, S, E); }
            PHASE_END
            PHASE_BEGIN(sb + 1) if (l == NA) phase_kv_rows(F); phase_cq_rows(F, j); PHASE_END
            PHASE_BEGIN(sb + 2) {
                if (l == NA) { pg8::PlainSched S; S.init(T, 2048, F.G, (int)blockIdx.x); S.Bt = (const char*)(F.ws + WS_WUKV); S.K = 512;
                    pg8::EpiKvUp E{(bf16_t*)(F.ws + WS_KB), (bf16_t*)(F.ws + WS_VB)};
                    pg8::gemm_phase<false>(F.lds, (const char*)(F.ws + WS_CKV), 512, S, E); }
                pg8::PlainSched S; S.init(T, 1536, F.G, (int)blockIdx.x); S.Bt = (const char*)(F.ws + WS_WUQ) + (size_t)j * 1536 * 384 * 2; S.K = 768;
                pg8::EpiQUp E{(bf16_t*)(F.ws + WS_QB), (const float*)(F.ws + WS_ROPE)};
                pg8::gemm_phase<false>(F.lds, (const char*)(F.ws + WS_CQN), 768, S, E); }
            PHASE_END
            PHASE_BEGIN(sb + 3) phase_attn(F); PHASE_END
        }
        PHASE_BEGIN(sb + 4) {
            pg8::PlainSched S; S.init(T, 1024, F.G, (int)blockIdx.x); S.K = 1024;
            S.Bt = (l < NA) ? (const char*)(F.ws + WS_WOUT) + (size_t)l * 1024 * 1024 : (const char*)(F.ws + WS_WO) + (size_t)(l - NA) * 1024 * 1024;
            const char* A = (l < NA) ? (const char*)(F.ws + WS_OG) : (const char*)(F.ws + WS_AO);
            pg8::EpiResid E{l == 0 ? F.in[0] : nullptr, (bf16_t*)(F.ws + WS_XB), modp(F, l, 0, 2), 0.015625f, 6 * D};
            pg8::gemm_phase<true>(F.lds, A, 1024, S, E); }
        PHASE_END
        PHASE_BEGIN(sb + 5) phase_router(F, l, args.pad != 0); PHASE_END
        PHASE_BEGIN(sb + 7) {
            moe_table(F, l);
            pg8::MoeSched<true> S{(const LAS int*)(F.lds + LDS_TAB), (const LAS int*)(F.lds + LDS_BLKE), 8, F.G, F.vcu, (const char*)(F.ws + WS_WGU) + (size_t)l * NE * 2048 * 1024, (size_t)2048 * 1024, 1024, (const int*)(F.ws + WS_RINFO)};
            pg8::EpiMoeGU E{(unsigned char*)(F.ws + WS_ACT), F.in[24] + (size_t)l * NE * 2048};
            pg8::gemm_phase<true>(F.lds, (const char*)(F.ws + WS_H), 1024, S, E);
#ifdef MK_GU_EXTRA
            __syncthreads();
#if MK_GU_EXTRA == 3
            { pg8::MoeSchedHot S2{{(const LAS int*)(F.lds + LDS_TAB), (const LAS int*)(F.lds + LDS_BLKE), 8, F.G, F.vcu, (const char*)(F.ws + WS_WGU) + (size_t)l * NE * 2048 * 1024, (size_t)2048 * 1024, 1024, (const int*)(F.ws + WS_RINFO)}};
#else
            { pg8::MoeSched<true> S2{(const LAS int*)(F.lds + LDS_TAB), (const LAS int*)(F.lds + LDS_BLKE), 8, F.G, F.vcu, (const char*)(F.ws + WS_WGU) + (size_t)l * NE * 2048 * 1024, (size_t)2048 * 1024, 1024, (const int*)(F.ws + WS_RINFO)};
#endif
#if MK_GU_EXTRA == 1
              pg8::EpiMoeGU E2{(unsigned char*)(F.ws + WS_YS), F.in[24] + (size_t)l * NE * 2048};
#else
              pg8::EpiNull E2;
#endif
              pg8::gemm_phase<true>(F.lds, (const char*)(F.ws + WS_H), 1024, S2, E2); }
#endif
            }
        PHASE_END
        PHASE_BEGIN(sb + 8) {
            moe_table(F, l);
            pg8::MoeSched<false> S{(const LAS int*)(F.lds + LDS_TAB), (const LAS int*)(F.lds + LDS_BLKE), 4, F.G, F.vcu, (const char*)(F.ws + WS_WDN) + (size_t)l * NE * 1024 * 1024, (size_t)1024 * 1024, 1024, nullptr};
            pg8::EpiMoeDN E{(unsigned char*)(F.ws + WS_YS), F.in[26] + (size_t)l * NE * 1024, (const LAS int*)(F.lds + LDS_TAB), (const float*)(F.ws + WS_RW)};
            pg8::gemm_phase<true>(F.lds, (const char*)(F.ws + WS_ACT), 1024, S, E); }
        PHASE_END
        PHASE_BEGIN(sb + 9) moe_table(F, l); phase_combine<false>(F, l, args.pad != 0); PHASE_END
    }
    }
    { constexpr int l = 1;
    {
        const int sb = 2 + l * NP;
        if (l < NA) {
            PHASE_BEGIN(sb + 0) {
                { pg8::PlainSched S; S.init(T, 3072, F.G, (int)blockIdx.x); S.Bt = (const char*)(F.ws + WS_WIN) + (size_t)l * 3072 * 1024; S.K = 1024;
                  pg8::EpiHgrnIn E{(bf16_t*)(F.ws + WS_QH), (float*)(F.ws + WS_LF), (const float*)(F.ws + WS_LB) + (size_t)l * D, 0x320, 0.015625f};
                  pg8::gemm_phase<true>(F.lds, (const char*)(F.ws + WS_H8), 1024, S, E); }
                { pg8::PlainSched S; S.init(T, 1024, F.G, (int)blockIdx.x); S.Bt = (const char*)(F.ws + WS_WINF) + (size_t)l * 1024 * 1024 * 2; S.K = 2048;
                  pg8::EpiHgrnIn E{(bf16_t*)(F.ws + WS_QH), (float*)(F.ws + WS_LF), (const float*)(F.ws + WS_LB) + (size_t)l * D, 0x1, 1.0f};
                  pg8::gemm_phase<false>(F.lds, (const char*)(F.ws + WS_H), 2048, S, E); } }
            PHASE_END
            PHASE_BEGIN(sb + 1) phase_hgrn_scan(F); PHASE_END
            PHASE_BEGIN(sb + 2) phase_hgrn_gate(F, l); PHASE_END
        } else {
            const int j = l - NA;
            PHASE_BEGIN(sb + 0) {
                if (l == NA) { pg8::PlainSched S; S.init(T, 512, F.G, (int)blockIdx.x); S.Bt = (const char*)(F.ws + WS_WDKV); S.K = 1024;
                    pg8::EpiPlainBf16 E{(bf16_t*)(F.ws + WS_CKR), 512, 0.015625f};
                    pg8::gemm_phase<true>(F.lds, (const char*)(F.ws + WS_HK), 1024, S, E); }
                pg8::PlainSched S; S.init(T, 512, F.G, (int)blockIdx.x); S.Bt = (const char*)(F.ws + WS_WDQ) + (size_t)j * 512 * 1024; S.K = 1024;
                pg8::EpiPlainBf16 E{(bf16_t*)(F.ws + WS_CQ), 512, 0.015625f};
                pg8::gemm_phase<true>(F.lds, (const char*)(F.ws + WS_H8), 1024, S, E); }
            PHASE_END
            PHASE_BEGIN(sb + 1) if (l == NA) phase_kv_rows(F); phase_cq_rows(F, j); PHASE_END
            PHASE_BEGIN(sb + 2) {
                if (l == NA) { pg8::PlainSched S; S.init(T, 2048, F.G, (int)blockIdx.x); S.Bt = (const char*)(F.ws + WS_WUKV); S.K = 512;
                    pg8::EpiKvUp E{(bf16_t*)(F.ws + WS_KB), (bf16_t*)(F.ws + WS_VB)};
                    pg8::gemm_phase<false>(F.lds, (const char*)(F.ws + WS_CKV), 512, S, E); }
                pg8::PlainSched S; S.init(T, 1536, F.G, (int)blockIdx.x); S.Bt = (const char*)(F.ws + WS_WUQ) + (size_t)j * 1536 * 384 * 2; S.K = 768;
                pg8::EpiQUp E{(bf16_t*)(F.ws + WS_QB), (const float*)(F.ws + WS_ROPE)};
                pg8::gemm_phase<false>(F.lds, (const char*)(F.ws + WS_CQN), 768, S, E); }
            PHASE_END
            PHASE_BEGIN(sb + 3) phase_attn(F); PHASE_END
        }
        PHASE_BEGIN(sb + 4) {
            pg8::PlainSched S; S.init(T, 1024, F.G, (int)blockIdx.x); S.K = 1024;
            S.Bt = (l < NA) ? (const char*)(F.ws + WS_WOUT) + (size_t)l * 1024 * 1024 : (const char*)(F.ws + WS_WO) + (size_t)(l - NA) * 1024 * 1024;
            const char* A = (l < NA) ? (const char*)(F.ws + WS_OG) : (const char*)(F.ws + WS_AO);
            pg8::EpiResid E{l == 0 ? F.in[0] : nullptr, (bf16_t*)(F.ws + WS_XB), modp(F, l, 0, 2), 0.015625f, 6 * D};
            pg8::gemm_phase<true>(F.lds, A, 1024, S, E); }
        PHASE_END
        PHASE_BEGIN(sb + 5) phase_router(F, l, args.pad != 0); PHASE_END
        PHASE_BEGIN(sb + 7) {
            moe_table(F, l);
            pg8::MoeSched<true> S{(const LAS int*)(F.lds + LDS_TAB), (const LAS int*)(F.lds + LDS_BLKE), 8, F.G, F.vcu, (const char*)(F.ws + WS_WGU) + (size_t)l * NE * 2048 * 1024, (size_t)2048 * 1024, 1024, (const int*)(F.ws + WS_RINFO)};
            pg8::EpiMoeGU E{(unsigned char*)(F.ws + WS_ACT), F.in[24] + (size_t)l * NE * 2048};
            pg8::gemm_phase<true>(F.lds, (const char*)(F.ws + WS_H), 1024, S, E);
#ifdef MK_GU_EXTRA
            __syncthreads();
#if MK_GU_EXTRA == 3
            { pg8::MoeSchedHot S2{{(const LAS int*)(F.lds + LDS_TAB), (const LAS int*)(F.lds + LDS_BLKE), 8, F.G, F.vcu, (const char*)(F.ws + WS_WGU) + (size_t)l * NE * 2048 * 1024, (size_t)2048 * 1024, 1024, (const int*)(F.ws + WS_RINFO)}};
#else
            { pg8::MoeSched<true> S2{(const LAS int*)(F.lds + LDS_TAB), (const LAS int*)(F.lds + LDS_BLKE), 8, F.G, F.vcu, (const char*)(F.ws + WS_WGU) + (size_t)l * NE * 2048 * 1024, (size_t)2048 * 1024, 1024, (const int*)(F.ws + WS_RINFO)};
#endif
#if MK_GU_EXTRA == 1
              pg8::EpiMoeGU E2{(unsigned char*)(F.ws + WS_YS), F.in[24] + (size_t)l * NE * 2048};
#else
              pg8::EpiNull E2;
#endif
              pg8::gemm_phase<true>(F.lds, (const char*)(F.ws + WS_H), 1024, S2, E2); }
#endif
            }
        PHASE_END
        PHASE_BEGIN(sb + 8) {
            moe_table(F, l);
            pg8::MoeSched<false> S{(const LAS int*)(F.lds + LDS_TAB), (const LAS int*)(F.lds + LDS_BLKE), 4, F.G, F.vcu, (const char*)(F.ws + WS_WDN) + (size_t)l * NE * 1024 * 1024, (size_t)1024 * 1024, 1024, nullptr};
            pg8::EpiMoeDN E{(unsigned char*)(F.ws + WS_YS), F.in[26] + (size_t)l * NE * 1024, (const LAS int*)(F.lds + LDS_TAB), (const float*)(F.ws + WS_RW)};
            pg8::gemm_phase<true>(F.lds, (const char*)(F.ws + WS_ACT), 1024, S, E); }
        PHASE_END
        PHASE_BEGIN(sb + 9) moe_table(F, l); phase_combine<false>(F, l, args.pad != 0); PHASE_END
    }
    }
    { constexpr int l = 2;
    {
        const int sb = 2 + l * NP;
        if (l < NA) {
            PHASE_BEGIN(sb + 0) {
                { pg8::PlainSched S; S.init(T, 3072, F.G, (int)blockIdx.x); S.Bt = (const char*)(F.ws + WS_WIN) + (size_t)l * 3072 * 1024; S.K = 1024;
                  pg8::EpiHgrnIn E{(bf16_t*)(F.ws + WS_QH), (float*)(F.ws + WS_LF), (const float*)(F.ws + WS_LB) + (size_t)l * D, 0x320, 0.015625f};
                  pg8::gemm_phase<true>(F.lds, (const char*)(F.ws + WS_H8), 1024, S, E); }
                { pg8::PlainSched S; S.init(T, 1024, F.G, (int)blockIdx.x); S.Bt = (const char*)(F.ws + WS_WINF) + (size_t)l * 1024 * 1024 * 2; S.K = 2048;
                  pg8::EpiHgrnIn E{(bf16_t*)(F.ws + WS_QH), (float*)(F.ws + WS_LF), (const float*)(F.ws + WS_LB) + (size_t)l * D, 0x1, 1.0f};
                  pg8::gemm_phase<false>(F.lds, (const char*)(F.ws + WS_H), 2048, S, E); } }
            PHASE_END
            PHASE_BEGIN(sb + 1) phase_hgrn_scan(F); PHASE_END
            PHASE_BEGIN(sb + 2) phase_hgrn_gate(F, l); PHASE_END
        } else {
            const int j = l - NA;
            PHASE_BEGIN(sb + 0) {
                if (l == NA) { pg8::PlainSched S; S.init(T, 512, F.G, (int)blockIdx.x); S.Bt = (const char*)(F.ws + WS_WDKV); S.K = 1024;
                    pg8::EpiPlainBf16 E{(bf16_t*)(F.ws + WS_CKR), 512, 0.015625f};
                    pg8::gemm_phase<true>(F.lds, (const char*)(F.ws + WS_HK), 1024, S, E); }
                pg8::PlainSched S; S.init(T, 512, F.G, (int)blockIdx.x); S.Bt = (const char*)(F.ws + WS_WDQ) + (size_t)j * 512 * 1024; S.K = 1024;
                pg8::EpiPlainBf16 E{(bf16_t*)(F.ws + WS_CQ), 512, 0.015625f};
                pg8::gemm_phase<true>(F.lds, (const char*)(F.ws + WS_H8), 1024, S, E); }
            PHASE_END
            PHASE_BEGIN(sb + 1) if (l == NA) phase_kv_rows(F); phase_cq_rows(F, j); PHASE_END
            PHASE_BEGIN(sb + 2) {
                if (l == NA) { pg8::PlainSched S; S.init(T, 2048, F.G, (int)blockIdx.x); S.Bt = (const char*)(F.ws + WS_WUKV); S.K = 512;
                    pg8::EpiKvUp E{(bf16_t*)(F.ws + WS_KB), (bf16_t*)(F.ws + WS_VB)};
                    pg8::gemm_phase<false>(F.lds, (const char*)(F.ws + WS_CKV), 512, S, E); }
                pg8::PlainSched S; S.init(T, 1536, F.G, (int)blockIdx.x); S.Bt = (const char*)(F.ws + WS_WUQ) + (size_t)j * 1536 * 384 * 2; S.K = 768;
                pg8::EpiQUp E{(bf16_t*)(F.ws + WS_QB), (const float*)(F.ws + WS_ROPE)};
                pg8::gemm_phase<false>(F.lds, (const char*)(F.ws + WS_CQN), 768, S, E); }
            PHASE_END
            PHASE_BEGIN(sb + 3) phase_attn(F); PHASE_END
        }
        PHASE_BEGIN(sb + 4) {
            pg8::PlainSched S; S.init(T, 1024, F.G, (int)blockIdx.x); S.K = 1024;
            S.Bt = (l < NA) ? (const char*)(F.ws + WS_WOUT) + (size_t)l * 1024 * 1024 : (const char*)(F.ws + WS_WO) + (size_t)(l - NA) * 1024 * 1024;
            const char* A = (l < NA) ? (const char*)(F.ws + WS_OG) : (const char*)(F.ws + WS_AO);
            pg8::EpiResid E{l == 0 ? F.in[0] : nullptr, (bf16_t*)(F.ws + WS_XB), modp(F, l, 0, 2), 0.015625f, 6 * D};
            pg8::gemm_phase<true>(F.lds, A, 1024, S, E); }
        PHASE_END
        PHASE_BEGIN(sb + 5) phase_router(F, l, args.pad != 0); PHASE_END
        PHASE_BEGIN(sb + 7) {
            moe_table(F, l);
            pg8::MoeSched<true> S{(const LAS int*)(F.lds + LDS_TAB), (const LAS int*)(F.lds + LDS_BLKE), 8, F.G, F.vcu, (const char*)(F.ws + WS_WGU) + (size_t)l * NE * 2048 * 1024, (size_t)2048 * 1024, 1024, (const int*)(F.ws + WS_RINFO)};
            pg8::EpiMoeGU E{(unsigned char*)(F.ws + WS_ACT), F.in[24] + (size_t)l * NE * 2048};
            pg8::gemm_phase<true>(F.lds, (const char*)(F.ws + WS_H), 1024, S, E);
#ifdef MK_GU_EXTRA
            __syncthreads();
#if MK_GU_EXTRA == 3
            { pg8::MoeSchedHot S2{{(const LAS int*)(F.lds + LDS_TAB), (const LAS int*)(F.lds + LDS_BLKE), 8, F.G, F.vcu, (const char*)(F.ws + WS_WGU) + (size_t)l * NE * 2048 * 1024, (size_t)2048 * 1024, 1024, (const int*)(F.ws + WS_RINFO)}};
#else
            { pg8::MoeSched<true> S2{(const LAS int*)(F.lds + LDS_TAB), (const LAS int*)(F.lds + LDS_BLKE), 8, F.G, F.vcu, (const char*)(F.ws + WS_WGU) + (size_t)l * NE * 2048 * 1024, (size_t)2048 * 1024, 1024, (const int*)(F.ws + WS_RINFO)};
#endif
#if MK_GU_EXTRA == 1
              pg8::EpiMoeGU E2{(unsigned char*)(F.ws + WS_YS), F.in[24] + (size_t)l * NE * 2048};
#else
              pg8::EpiNull E2;
#endif
              pg8::gemm_phase<true>(F.lds, (const char*)(F.ws + WS_H), 1024, S2, E2); }
#endif
            }
        PHASE_END
        PHASE_BEGIN(sb + 8) {
            moe_table(F, l);
            pg8::MoeSched<false> S{(const LAS int*)(F.lds + LDS_TAB), (const LAS int*)(F.lds + LDS_BLKE), 4, F.G, F.vcu, (const char*)(F.ws + WS_WDN) + (size_t)l * NE * 1024 * 1024, (size_t)1024 * 1024, 1024, nullptr};
            pg8::EpiMoeDN E{(unsigned char*)(F.ws + WS_YS), F.in[26] + (size_t)l * NE * 1024, (const LAS int*)(F.lds + LDS_TAB), (const float*)(F.ws + WS_RW)};
            pg8::gemm_phase<true>(F.lds, (const char*)(F.ws + WS_ACT), 1024, S, E); }
        PHASE_END
        PHASE_BEGIN(sb + 9) moe_table(F, l); phase_combine<false>(F, l, args.pad != 0); PHASE_END
    }
    }
    { constexpr int l = 3;
    {
        const int sb = 2 + l * NP;
        if (l < NA) {
            PHASE_BEGIN(sb + 0) {
                { pg8::PlainSched S; S.init(T, 3072, F.G, (int)blockIdx.x); S.Bt = (const char*)(F.ws + WS_WIN) + (size_t)l * 3072 * 1024; S.K = 1024;
                  pg8::EpiHgrnIn E{(bf16_t*)(F.ws + WS_QH), (float*)(F.ws + WS_LF), (const float*)(F.ws + WS_LB) + (size_t)l * D, 0x320, 0.015625f};
                  pg8::gemm_phase<true>(F.lds, (const char*)(F.ws + WS_H8), 1024, S, E); }
                { pg8::PlainSched S; S.init(T, 1024, F.G, (int)blockIdx.x); S.Bt = (const char*)(F.ws + WS_WINF) + (size_t)l * 1024 * 1024 * 2; S.K = 2048;
                  pg8::EpiHgrnIn E{(bf16_t*)(F.ws + WS_QH), (float*)(F.ws + WS_LF), (const float*)(F.ws + WS_LB) + (size_t)l * D, 0x1, 1.0f};
                  pg8::gemm_phase<false>(F.lds, (const char*)(F.ws + WS_H), 2048, S, E); } }
            PHASE_END
            PHASE_BEGIN(sb + 1) phase_hgrn_scan(F); PHASE_END
            PHASE_BEGIN(sb + 2) phase_hgrn_gate(F, l); PHASE_END
        } else {
            const int j = l - NA;
            PHASE_BEGIN(sb + 0) {
                if (l == NA) { pg8::PlainSched S; S.init(T, 512, F.G, (int)blockIdx.x); S.Bt = (const char*)(F.ws + WS_WDKV); S.K = 1024;
                    pg8::EpiPlainBf16 E{(bf16_t*)(F.ws + WS_CKR), 512, 0.015625f};
                    pg8::gemm_phase<true>(F.lds, (const char*)(F.ws + WS_HK), 1024, S, E); }
                pg8::PlainSched S; S.init(T, 512, F.G, (int)blockIdx.x); S.Bt = (const char*)(F.ws + WS_WDQ) + (size_t)j * 512 * 1024; S.K = 1024;
                pg8::EpiPlainBf16 E{(bf16_t*)(F.ws + WS_CQ), 512, 0.015625f};
                pg8::gemm_phase<true>(F.lds, (const char*)(F.ws + WS_H8), 1024, S, E); }
            PHASE_END
            PHASE_BEGIN(sb + 1) if (l == NA) phase_kv_rows(F); phase_cq_rows(F, j); PHASE_END
            PHASE_BEGIN(sb + 2) {
                if (l == NA) { pg8::PlainSched S; S.init(T, 2048, F.G, (int)blockIdx.x); S.Bt = (const char*)(F.ws + WS_WUKV); S.K = 512;
                    pg8::EpiKvUp E{(bf16_t*)(F.ws + WS_KB), (bf16_t*)(F.ws + WS_VB)};
                    pg8::gemm_phase<false>(F.lds, (const char*)(F.ws + WS_CKV), 512, S, E); }
                pg8::PlainSched S; S.init(T, 1536, F.G, (int)blockIdx.x); S.Bt = (const char*)(F.ws + WS_WUQ) + (size_t)j * 1536 * 384 * 2; S.K = 768;
                pg8::EpiQUp E{(bf16_t*)(F.ws + WS_QB), (const float*)(F.ws + WS_ROPE)};
                pg8::gemm_phase<false>(F.lds, (const char*)(F.ws + WS_CQN), 768, S, E); }
            PHASE_END
            PHASE_BEGIN(sb + 3) phase_attn(F); PHASE_END
        }
        PHASE_BEGIN(sb + 4) {
            pg8::PlainSched S; S.init(T, 1024, F.G, (int)blockIdx.x); S.K = 1024;
            S.Bt = (l < NA) ? (const char*)(F.ws + WS_WOUT) + (size_t)l * 1024 * 1024 : (const char*)(F.ws + WS_WO) + (size_t)(l - NA) * 1024 * 1024;
            const char* A = (l < NA) ? (const char*)(F.ws + WS_OG) : (const char*)(F.ws + WS_AO);
            pg8::EpiResid E{l == 0 ? F.in[0] : nullptr, (bf16_t*)(F.ws + WS_XB), modp(F, l, 0, 2), 0.015625f, 6 * D};
            pg8::gemm_phase<true>(F.lds, A, 1024, S, E); }
        PHASE_END
        PHASE_BEGIN(sb + 5) phase_router(F, l, args.pad != 0); PHASE_END
        PHASE_BEGIN(sb + 7) {
            moe_table(F, l);
            pg8::MoeSched<true> S{(const LAS int*)(F.lds + LDS_TAB), (const LAS int*)(F.lds + LDS_BLKE), 8, F.G, F.vcu, (const char*)(F.ws + WS_WGU) + (size_t)l * NE * 2048 * 1024, (size_t)2048 * 1024, 1024, (const int*)(F.ws + WS_RINFO)};
            pg8::EpiMoeGU E{(unsigned char*)(F.ws + WS_ACT), F.in[24] + (size_t)l * NE * 2048};
            pg8::gemm_phase<true>(F.lds, (const char*)(F.ws + WS_H), 1024, S, E);
#ifdef MK_GU_EXTRA
            __syncthreads();
#if MK_GU_EXTRA == 3
            { pg8::MoeSchedHot S2{{(const LAS int*)(F.lds + LDS_TAB), (const LAS int*)(F.lds + LDS_BLKE), 8, F.G, F.vcu, (const char*)(F.ws + WS_WGU) + (size_t)l * NE * 2048 * 1024, (size_t)2048 * 1024, 1024, (const int*)(F.ws + WS_RINFO)}};
#else
            { pg8::MoeSched<true> S2{(const LAS int*)(F.lds + LDS_TAB), (const LAS int*)(F.lds + LDS_BLKE), 8, F.G, F.vcu, (const char*)(F.ws + WS_WGU) + (size_t)l * NE * 2048 * 1024, (size_t)2048 * 1024, 1024, (const int*)(F.ws + WS_RINFO)};
#endif
#if MK_GU_EXTRA == 1
              pg8::EpiMoeGU E2{(unsigned char*)(F.ws + WS_YS), F.in[24] + (size_t)l * NE * 2048};
#else
              pg8::EpiNull E2;
#endif
              pg8::gemm_phase<true>(F.lds, (const char*)(F.ws + WS_H), 1024, S2, E2); }
#endif
            }
        PHASE_END
        PHASE_BEGIN(sb + 8) {
            moe_table(F, l);
            pg8::MoeSched<false> S{(const LAS int*)(F.lds + LDS_TAB), (const LAS int*)(F.lds + LDS_BLKE), 4, F.G, F.vcu, (const char*)(F.ws + WS_WDN) + (size_t)l * NE * 1024 * 1024, (size_t)1024 * 1024, 1024, nullptr};
            pg8::EpiMoeDN E{(unsigned char*)(F.ws + WS_YS), F.in[26] + (size_t)l * NE * 1024, (const LAS int*)(F.lds + LDS_TAB), (const float*)(F.ws + WS_RW)};
            pg8::gemm_phase<true>(F.lds, (const char*)(F.ws + WS_ACT), 1024, S, E); }
        PHASE_END
        PHASE_BEGIN(sb + 9) moe_table(F, l); phase_combine<false>(F, l, args.pad != 0); PHASE_END
    }
    }
#ifdef MK_PROBE_MASK
    PR_STAMP(-1);
    if (blockIdx.x == 0 && threadIdx.x == 0) { const unsigned long long t0 = __builtin_amdgcn_s_memrealtime(); while (__builtin_amdgcn_s_memrealtime() - t0 < 4ull * pr_acc) __builtin_amdgcn_s_sleep(8); }
#endif
#if defined(MK_SCAN_PROBE) || defined(MK_ATT_PROBE)
    if (blockIdx.x == 0 && threadIdx.x == 0) { const unsigned long long acc_ = *(volatile LAS unsigned*)(F.lds + 147440); const unsigned long long t0 = __builtin_amdgcn_s_memrealtime(); while (__builtin_amdgcn_s_memrealtime() - t0 < 4ull * acc_) __builtin_amdgcn_s_sleep(8); }
#endif
#undef PHASE_BEGIN
#undef PHASE_END
}

extern "C" void kernel_launch(void* const* d_in, const int* in_sizes, int n_in, void* d_out, int out_size, void* d_ws, size_t ws_size, hipStream_t stream) {
    static int grid = 0;
    if (grid == 0) {
        if (n_in != 28 || in_sizes[0] != T * D || out_size != T * D || ws_size < WS_END) {
            fprintf(stderr, "kernel_launch: shape mismatch: n_in %d in0 %d out %d ws %zu (need %zu)\n", n_in, n_in > 0 ? in_sizes[0] : -1, out_size, ws_size, (size_t)WS_END); grid = -1; return; }
        int dev = 0, cus = 0, per_cu = 0;
        if (hipGetDevice(&dev) != hipSuccess || hipDeviceGetAttribute(&cus, hipDeviceAttributeMultiprocessorCount, dev) != hipSuccess) { fprintf(stderr, "kernel_launch: device query failed\n"); grid = -1; return; }
        if (hipFuncSetAttribute((const void*)fwd_kernel, hipFuncAttributeMaxDynamicSharedMemorySize, LDS_BYTES) != hipSuccess) { fprintf(stderr, "kernel_launch: hipFuncSetAttribute failed\n"); grid = -1; return; }
        if (hipOccupancyMaxActiveBlocksPerMultiprocessor(&per_cu, (const void*)fwd_kernel, NTHREADS, LDS_BYTES) != hipSuccess || per_cu < 1)
            fprintf(stderr, "kernel_launch: note: occupancy query reports %d workgroups per CU\n", per_cu);
        (void)hipGetLastError();
        grid = cus;
    }
    if (grid < 0) return;
    if (hipMemsetAsync((char*)d_ws + WS_CTL, 0, CTL_ZERO_BYTES, stream) != hipSuccess) { fprintf(stderr, "kernel_launch: memset failed\n"); return; }
    Args a{};
    for (int i = 0; i < 28; ++i) a.in[i] = (const float*)d_in[i];
    a.out = (float*)d_out; a.ws = (unsigned char*)d_ws; a.final_only = 0; a.pad = 0;
    constexpr int LAST = (MK_LAST_STEP < NSTEPS) ? MK_LAST_STEP : NSTEPS;
#if MK_ONE_LAUNCH
    a.lo = 0; a.hi = LAST;
    hipLaunchKernelGGL(fwd_kernel, dim3(grid), dim3(NTHREADS), LDS_BYTES, stream, a);
#else
    for (int st = 0; st < LAST; ++st) { if (!step_applies(st)) continue;
#ifdef MK_SKIP_LO
        if (st >= MK_SKIP_LO && st < MK_SKIP_HI) continue;
#endif
        a.lo = st; a.hi = st + 1;
        hipLaunchKernelGGL(fwd_kernel, dim3(grid), dim3(NTHREADS), LDS_BYTES, stream, a);
#ifdef MK_REPEAT_LO
        if (st >= MK_REPEAT_LO && st < MK_REPEAT_HI) { a.pad = 1; hipLaunchKernelGGL(fwd_kernel, dim3(grid), dim3(NTHREADS), LDS_BYTES, stream, a); a.pad = 0; }
#endif
    }
#endif
    if (LAST < NSTEPS) {
        a.lo = 0; a.hi = 0; a.final_only = (LAST <= 2 + 4) ? 1 : 2;
        hipLaunchKernelGGL(fwd_kernel, dim3(grid), dim3(NTHREADS), LDS_BYTES, stream, a);
    }
    const hipError_t le = hipPeekAtLastError();
    if (le != hipSuccess) fprintf(stderr, "kernel_launch: launch failed: %s\n", hipGetErrorName(le));
}
```

```cpp
#define MK_ONE_LAUNCH 1
#define MK_LAST_STEP 9999
#include <hip/hip_runtime.h>
#include <cstdio>
#include <cstdint>

#ifndef MK_ONE_LAUNCH
#define MK_ONE_LAUNCH 1
#endif
#ifndef MK_LAST_STEP
#define MK_LAST_STEP 9999
#endif

#define GAS __attribute__((address_space(1)))
#define LAS __attribute__((address_space(3)))
typedef unsigned short bf16_t;
typedef short bf16x8 __attribute__((ext_vector_type(8)));
typedef short s16x4 __attribute__((ext_vector_type(4)));
typedef float f32x4 __attribute__((ext_vector_type(4)));
typedef float f32x2 __attribute__((ext_vector_type(2)));
typedef float f32x16 __attribute__((ext_vector_type(16)));
typedef unsigned u32x4 __attribute__((ext_vector_type(4)));
typedef unsigned u32x2 __attribute__((ext_vector_type(2)));

constexpr int NB = 16, SEQ = 4096, D = 1024, T = NB * SEQ;
constexpr int DEPTH = 4, NA = 2;
constexpr int HGH = 8, HGD = 128, HGC = 64;
constexpr int MH = 8, NOPE = 128, ROPE = 64, VD = 128, QK = NOPE + ROPE;
constexpr int QRANK = 384, KVRANK = 256;
constexpr int NE = 32, TOPK = 4, FF = 1024, MOEB = 256;
constexpr int NASSIGN = T * TOPK;
constexpr int NROWS_MAX = NASSIGN + NE * MOEB;
constexpr int NBLK_MAX = NROWS_MAX / MOEB;
constexpr float NORM_EPS = 1e-6f;
constexpr float SWIGLU_LIMIT = 7.0f, SWIGLU_ALPHA = 1.702f;
constexpr int NWAVES = 8, NTHREADS = 512;

constexpr size_t MiB = 1u << 20;
constexpr size_t al256(size_t x) { return (x + 255) & ~(size_t)255; }
constexpr size_t WS_CTL = 0, CTL_ZERO_BYTES = 1 * MiB;
constexpr int CW_BAR = 4096;
constexpr int CW_CNT = 16384;
constexpr size_t WS_MOD   = 1 * MiB;
constexpr size_t WS_KVMOD = WS_MOD + al256((size_t)DEPTH * NB * 6 * D * 4);
constexpr size_t WS_LB    = WS_KVMOD + al256((size_t)NB * 2 * D * 4);
constexpr size_t WS_ROPE  = WS_LB + al256((size_t)NA * D * 4);
constexpr size_t WS_TKE   = WS_ROPE + al256((size_t)T * 64 * 4);
constexpr size_t WS_TKW   = WS_TKE + al256((size_t)T * 4 * 4);
constexpr size_t WS_TKR   = WS_TKW + al256((size_t)T * 4 * 4);
constexpr int VCAP = T;
constexpr size_t WS_RINFO = WS_TKR + al256((size_t)T * 4 * 4);
constexpr size_t WS_RW    = WS_RINFO + al256((size_t)NE * VCAP * 4);
constexpr size_t WS_WR    = al256(WS_RW + (size_t)NE * VCAP * 4 + MiB);
constexpr size_t WS_WIN   = al256(WS_WR + (size_t)DEPTH * 131072);
constexpr size_t WS_WINF  = WS_WIN + (size_t)NA * 3072 * 1024;
constexpr size_t WS_WOUT  = WS_WIN + (size_t)NA * 4096 * 1024 * 2;
constexpr size_t WS_WDKV  = WS_WOUT + (size_t)NA * 1024 * 1024 * 2;
constexpr size_t WS_WUKV  = WS_WDKV + (size_t)512 * 1024 * 2;
constexpr size_t WS_WDQ   = WS_WUKV + (size_t)2048 * 256 * 2;
constexpr size_t WS_WUQ   = WS_WDQ + (size_t)2 * 512 * 1024 * 2;
constexpr size_t WS_WO    = WS_WUQ + (size_t)2 * 1536 * 384 * 2;
constexpr size_t WS_WGU   = al256(WS_WO + (size_t)2 * 1024 * 1024 * 2);
constexpr size_t WS_WDN   = WS_WGU + (size_t)DEPTH * NE * 2048 * 1024 * 2;
constexpr size_t WS_H     = WS_WDN + (size_t)DEPTH * NE * 1024 * 1024 * 2;
constexpr size_t WS_HK    = WS_H + (size_t)T * D * 2;
constexpr size_t WS_XB    = WS_HK + (size_t)T * D * 2;
constexpr size_t WS_H8    = WS_XB + (size_t)T * D * 2;
constexpr size_t WS_ACT   = WS_H8 + (size_t)T * D;
constexpr size_t WS_YS    = WS_ACT + (size_t)NROWS_MAX * FF * 2;
constexpr size_t WS_MIX   = WS_YS + (size_t)NROWS_MAX * D * 2;
constexpr size_t WS_QH = WS_MIX;
constexpr size_t WS_KK = WS_QH + (size_t)T * D * 2;
constexpr size_t WS_VV = WS_KK + (size_t)T * D * 2;
constexpr size_t WS_GS = WS_VV + (size_t)T * D * 2;
constexpr size_t WS_LF = WS_GS + (size_t)T * D * 2;
constexpr size_t WS_OO = WS_LF + (size_t)T * D * 4;
constexpr size_t WS_OG = WS_OO + (size_t)T * D * 2;
constexpr size_t WS_MIX_END_A = WS_OG + (size_t)T * D * 2;
constexpr size_t WS_KB  = WS_MIX;
constexpr size_t WS_VB  = WS_KB + (size_t)T * MH * QK * 2;
constexpr size_t WS_QB  = WS_VB + (size_t)T * D * 2;
constexpr size_t WS_CKR = WS_QB + (size_t)T * MH * QK * 2;
constexpr size_t WS_CKV = WS_CKR + (size_t)T * 512 * 2;
constexpr size_t WS_CQ  = WS_CKV + (size_t)T * 256 * 2;
constexpr size_t WS_CQN = WS_CQ + (size_t)T * 512 * 2;
constexpr size_t WS_AO  = WS_CQN + (size_t)T * 384 * 2;
constexpr size_t WS_MIX_END_B = WS_AO + (size_t)T * D * 2;
constexpr size_t WS_END = (WS_MIX_END_A > WS_MIX_END_B ? WS_MIX_END_A : WS_MIX_END_B);
static_assert(WS_END < (size_t)4200 * MiB / 1 && WS_END < 4294967296ull, "workspace map must fit 4 x largest tensor");

constexpr int RING_BYTES = 131072;
constexpr int LDS_TAB = RING_BYTES;
constexpr int LDS_BLKE = RING_BYTES + 1024;
constexpr int LDS_MISC = RING_BYTES + 512;
constexpr int LDS_SIDE = LDS_BLKE + NBLK_MAX * 4;
static_assert(LDS_SIDE % 16 == 0 && LDS_SIDE + 3 * 2048 <= 147456, "LDS map");
constexpr int LDS_BYTES = 147456;

#define RLX_AGENT __ATOMIC_RELAXED, __HIP_MEMORY_SCOPE_AGENT
#define LDS_WAIT() asm volatile("s_waitcnt lgkmcnt(0)" ::: "memory")
#define VM_WAIT() asm volatile("s_waitcnt vmcnt(0)" ::: "memory")
typedef __bf16 bf16x2_t __attribute__((ext_vector_type(2)));
__device__ __forceinline__ unsigned cvt_pk_bf16(float lo, float hi) { f32x2 v = {lo, hi}; bf16x2_t b = __builtin_convertvector(v, bf16x2_t); return __builtin_bit_cast(unsigned, b); }
__device__ __forceinline__ float bf2f(unsigned short b) { return __uint_as_float(((unsigned)b) << 16); }
__device__ __forceinline__ float bflo(unsigned w) { return __uint_as_float(w << 16); }
__device__ __forceinline__ float bfhi(unsigned w) { return __uint_as_float(w & 0xffff0000u); }
__device__ __forceinline__ unsigned short f2bf(float f) { return (unsigned short)(cvt_pk_bf16(f, 0.f) & 0xffffu); }
__device__ __forceinline__ float wave_sum(float v) {
#pragma unroll
    for (int o = 1; o < 64; o <<= 1) v += __shfl_xor(v, o);
    return v;
}
__device__ __forceinline__ void glds16s(const void* sbase, unsigned voff, unsigned lds_dst) {
    asm volatile("s_mov_b32 m0, %2\n\ts_nop 0\n\tglobal_load_lds_dwordx4 %0, %1" :: "v"(voff), "s"(sbase), "s"(lds_dst) : "memory", "m0"); }
__device__ __forceinline__ int opaque_v(int x) { asm volatile("" : "+v"(x)); return x; }
#define PHASE_IDS const int tid = opaque_v((int)threadIdx.x), lane = tid & 63, wave = __builtin_amdgcn_readfirstlane(tid >> 6); (void)lane; (void)wave
typedef _Float16 f16x2_t __attribute__((ext_vector_type(2)));
__device__ __forceinline__ unsigned pk_f16(float a, float b) { return __builtin_bit_cast(unsigned, __builtin_amdgcn_cvt_pkrtz(a, b)); }
__device__ __forceinline__ float f16lo(unsigned u) { return (float)__builtin_bit_cast(f16x2_t, u)[0]; }
__device__ __forceinline__ float f16hi(unsigned u) { return (float)__builtin_bit_cast(f16x2_t, u)[1]; }
__device__ __forceinline__ float fsigmoid(float x) { return __builtin_amdgcn_rcpf(1.0f + __expf(-x)); }
__device__ __forceinline__ float fsilu(float x) { return x * __builtin_amdgcn_rcpf(1.0f + __expf(-x)); }

#define XB_TMO      128
#define XB_XCNT(j)  (256  + 64 * (j))
#define XB_XSUB(j)  (1280 + 64 * (j))
#define XB_XGEN(j)  (2304 + 64 * (j))
#define XB_TOP      3328
#define XB_TOPGEN   3392
#define XCD_BAR_WORDS 3456
#define XB_SPIN_CAP (1u << 23)
__device__ __forceinline__ unsigned xb_ld(unsigned* p)              { return __hip_atomic_load(p, __ATOMIC_RELAXED, __HIP_MEMORY_SCOPE_AGENT); }
__device__ __forceinline__ unsigned xb_add(unsigned* p, unsigned v) { return __hip_atomic_fetch_add(p, v, __ATOMIC_RELAXED, __HIP_MEMORY_SCOPE_AGENT); }
__device__ __forceinline__ unsigned xb_xcc_id() { return (unsigned)__builtin_amdgcn_s_getreg((3 << 11) | 20) & 0xFu; }
#define XB_SPIN(cond, bar) do { unsigned _sp = 0; while (cond) { __builtin_amdgcn_s_sleep(1); \
    if ((++_sp & 255u) == 0u) { if (xb_ld(&(bar)[XB_TMO])) break; if (_sp > XB_SPIN_CAP) { atomicAdd(&(bar)[XB_TMO], 1u); break; } } } } while (0)
struct XcdBarrier { unsigned* bar; unsigned x; volatile LAS unsigned* st; };
__device__ __forceinline__ XcdBarrier xcd_barrier_post(unsigned* bar, volatile LAS unsigned* st) {
    XcdBarrier b; b.bar = bar; b.x = xb_xcc_id(); b.st = st;
    if (threadIdx.x == 0) (void)xb_add(&bar[XB_XCNT(b.x)], 1u);
    return b;
}
__device__ __forceinline__ void xcd_barrier_complete(unsigned* bar, unsigned x, unsigned& nloc, unsigned& nx) {
    const unsigned G = gridDim.x * gridDim.y * gridDim.z;
    unsigned sum, cnt, mine, sp = 0u;
    for (;;) {
        sum = 0u; cnt = 0u; mine = 0u;
#pragma unroll
        for (unsigned j = 0; j < 16; ++j) { const unsigned c = xb_ld(&bar[XB_XCNT(j)]); sum += c; cnt += (c > 0u) ? 1u : 0u; mine = (j == x) ? c : mine; }
        if (sum == G) break;
        __builtin_amdgcn_s_sleep(1);
        if ((++sp & 255u) == 0u) { if (xb_ld(&bar[XB_TMO])) break; if (sp > XB_SPIN_CAP) { atomicAdd(&bar[XB_TMO], 1u); break; } }
    }
    nloc = mine > 0u ? mine : 1u; nx = cnt > 0u ? cnt : 1u;
}
__device__ __forceinline__ void xcd_barrier(const XcdBarrier& b) {
    asm volatile("s_waitcnt vmcnt(0)" ::: "memory");
    __syncthreads();
    if (threadIdx.x == 0) {
        unsigned* bar = b.bar;
        __builtin_amdgcn_s_waitcnt(0);
        unsigned nloc = b.st[0], nx = b.st[1];
        if (nloc == 0u) { xcd_barrier_complete(bar, b.x, nloc, nx); b.st[0] = nloc; b.st[1] = nx; }
        const unsigned old = xb_add(&bar[XB_XSUB(b.x)], 1u);
        const unsigned gen = old / nloc;
        if (old + 1u == (gen + 1u) * nloc) {
            __builtin_amdgcn_fence(__ATOMIC_RELEASE, "agent");
            asm volatile("s_waitcnt vmcnt(0)" ::: "memory");
            const unsigned og = xb_add(&bar[XB_TOP], 1u);
            const unsigned tg = og / nx;
            if (og + 1u == (tg + 1u) * nx) xb_add(&bar[XB_TOPGEN], 1u);
            else XB_SPIN(xb_ld(&bar[XB_TOPGEN]) == tg, bar);
            __builtin_amdgcn_fence(__ATOMIC_ACQUIRE, "agent");
            xb_add(&bar[XB_XGEN(b.x)], 1u);
            asm volatile("s_waitcnt vmcnt(0)" ::: "memory");
        } else {
            XB_SPIN(xb_ld(&bar[XB_XGEN(b.x)]) == gen, bar);
            __builtin_amdgcn_fence(__ATOMIC_ACQUIRE, "agent");
            asm volatile("s_waitcnt vmcnt(0)" ::: "memory");
        }
    }
    __syncthreads();
}
namespace pg8 {
constexpr int BM = 256, BK = 64, HALF = 128, HTB = HALF * BK * 2, STAGE_BYTES = 8 * HTB, NXCD = 8, WGM = 8;
__host__ __device__ __forceinline__ int lds_byte(int r, int c) { const int st = (r >> 4) * 2 + (c >> 5), rr = r & 15, cc = c & 31, ob = rr * 64 + cc * 2; return st * 1024 + (ob ^ (((ob >> 9) & 1) << 5)); }
__host__ __device__ __forceinline__ void stage_rc(int b, int& R, int& C) { const int st = b / 1024, sb = b % 1024, swz = sb ^ (((sb >> 9) & 1) << 5); R = (st >> 1) * 16 + swz / 64; C = (st & 1) * 32 + (swz % 64) / 2; }
__host__ __device__ __forceinline__ int perm32(int rho) { const int n = rho >> 4, i = rho & 15; return 8 * (i >> 2) + 4 * n + (i & 3); }

struct Unit { int pm, pn, e; };

struct StaticOrder {
    int nM, nN, nwg, G, c;
    __device__ void init(int M, int N, int G_, int c_) { nM = M / BM; nN = N / BM; nwg = nM * nN; G = G_; c = c_; }
    __device__ bool next(int i, Unit& u) const {
        const long L = (long)i * G + c; if (L >= nwg) return false;
        int wgid = (int)L; { const int q = nwg / NXCD, r = nwg % NXCD, xcd = wgid % NXCD, off = wgid / NXCD; wgid = (xcd < r ? xcd * (q + 1) : r * (q + 1) + (xcd - r) * q) + off; }
        const int nig = WGM * nN, gid = wgid / nig, fm = gid * WGM, gsz = (nM - fm) < WGM ? (nM - fm) : WGM;
        u.pm = fm + ((wgid % nig) % gsz); u.pn = (wgid % nig) / gsz; u.e = 0; return true;
    }
};

struct PlainSched : StaticOrder {
    static constexpr bool GATHER = false;
    const char* Bt; int K;
    __device__ __forceinline__ const char* bptr(const Unit& u) const { return Bt + (size_t)u.pn * BM * K; }
    __device__ __forceinline__ unsigned adelta(const Unit& a, const Unit& b) const { return (unsigned)((b.pm - a.pm) * BM * K); }
    __device__ __forceinline__ void aoffs(const Unit& u, unsigned (&o)[2][2]) const {
        int R0, C0, R1, C1; { const int t_ = opaque_v((int)threadIdx.x); stage_rc(t_ * 16, R0, C0); stage_rc(t_ * 16 + 8192, R1, C1); C0 *= 2; C1 *= 2; }
#pragma unroll
        for (int h = 0; h < 2; ++h) { o[h][0] = (unsigned)((u.pm * BM + h * HALF + R0) * K + C0); o[h][1] = (unsigned)((u.pm * BM + h * HALF + R1) * K + C1); }
    }
};

#define PG8_SA(b, h) (((b) * 2 + (h)) * HTB)
#define PG8_SB(b, h) ((4 + (b) * 2 + (h)) * HTB)
#define PG8_STAGE_B(bufoff, gbase) do { glds16s((gbase), voffB, lds0 + (bufoff) + ldsw); glds16s((gbase) + r64, voffB, lds0 + (bufoff) + ldsw + 8192u); } while (0)
#define PG8_STAGE_A(bufoff, gbase, h) do { if constexpr (Sched::GATHER) { glds16s((gbase), vc[h][0], lds0 + (bufoff) + ldsw); glds16s((gbase), vc[h][1], lds0 + (bufoff) + ldsw + 8192u); } \
        else { glds16s((gbase) + (h) * hstep, vc[0][0], lds0 + (bufoff) + ldsw); glds16s((gbase) + (h) * hstep + r64, vc[0][0], lds0 + (bufoff) + ldsw + 8192u); } } while (0)
#define PG8_LDA(dst, b, h) do { _Pragma("unroll") for (int m = 0; m < 4; ++m) _Pragma("unroll") for (int k = 0; k < 2; ++k) dst[m][k] = *(const LAS bf16x8*)(lds + PG8_SA(b, h) + aoff + m * 2048 + k * 1024); } while (0)
#define PG8_LDB(dst, b, h) do { _Pragma("unroll") for (int n = 0; n < 2; ++n) _Pragma("unroll") for (int k = 0; k < 2; ++k) dst[n][k] = *(const LAS bf16x8*)(lds + PG8_SB(b, h) + boff + n * 2048 + k * 1024); } while (0)
#define PG8_MMA(ai, bj, At, Bt) do { __builtin_amdgcn_s_setprio(1); _Pragma("unroll") for (int m = 0; m < 4; ++m) _Pragma("unroll") for (int n = 0; n < 2; ++n) _Pragma("unroll") for (int k = 0; k < 2; ++k) \
        acc[ai][bj][m][n] = __builtin_amdgcn_mfma_f32_16x16x32_bf16(Bt[n][k], At[m][k], acc[ai][bj][m][n], 0, 0, 0); __builtin_amdgcn_s_setprio(0); } while (0)
#define PG8_WAIT_V(n) asm volatile("s_waitcnt vmcnt(" #n ")" ::: "memory")
#define PG8_WAIT_L(n) asm volatile("s_waitcnt lgkmcnt(" #n ")" ::: "memory")
#define PG8_BAR __builtin_amdgcn_s_barrier()
#define PG8_SCHED __builtin_amdgcn_sched_barrier(0)

typedef int i32x4v __attribute__((ext_vector_type(4)));
typedef int i32x8v __attribute__((ext_vector_type(8)));
__device__ __forceinline__ i32x8v cat8(bf16x8 a, bf16x8 b) { const i32x4v x = __builtin_bit_cast(i32x4v, a), y = __builtin_bit_cast(i32x4v, b); return __builtin_shufflevector(x, y, 0, 1, 2, 3, 4, 5, 6, 7); }
#define PG8_MFMA8(accv, b8, a8) asm volatile("v_mfma_f32_16x16x128_f8f6f4 %0, %1, %2, %0" : "+v"(accv) : "v"(b8), "v"(a8))
#define PG8_MFMA_DRAIN() asm volatile("s_nop 15\n\ts_nop 15\n\ts_nop 15\n\ts_nop 15" ::: "memory")
#define PG8_MMA8(ai, bj, At, Bt) do { __builtin_amdgcn_s_setprio(1); _Pragma("unroll") for (int m = 0; m < 4; ++m) _Pragma("unroll") for (int n = 0; n < 2; ++n) \
        PG8_MFMA8(acc[ai][bj][m][n], Bt##8[n], At##8[m]); __builtin_amdgcn_s_setprio(0); } while (0)
#define PG8_MM(ai, bj, At, Bt) do { if constexpr (FP8) PG8_MMA8(ai, bj, At, Bt); else PG8_MMA(ai, bj, At, Bt); } while (0)
#define PG8_LDA8(dst, b, h) do { _Pragma("unroll") for (int m = 0; m < 4; ++m) dst##8[m] = cat8(*(const LAS bf16x8*)(lds + PG8_SA(b, h) + aoff + m * 2048), *(const LAS bf16x8*)(lds + PG8_SA(b, h) + aoff + m * 2048 + 1024)); } while (0)
#define PG8_LDB8(dst, b, h) do { _Pragma("unroll") for (int n = 0; n < 2; ++n) dst##8[n] = cat8(*(const LAS bf16x8*)(lds + PG8_SB(b, h) + boff + n * 2048), *(const LAS bf16x8*)(lds + PG8_SB(b, h) + boff + n * 2048 + 1024)); } while (0)
#define PG8_LA(dst, b, h) do { if constexpr (FP8) PG8_LDA8(dst, b, h); else PG8_LDA(dst, b, h); } while (0)
#define PG8_LB(dst, b, h) do { if constexpr (FP8) PG8_LDB8(dst, b, h); else PG8_LDB(dst, b, h); } while (0)
template <bool FP8, class Epi, class Sched>
__device__ __forceinline__ void gemm_phase(LAS unsigned char* lds, const char* A0, int K, const Sched& S, const Epi& E) {
    asm volatile("" : "+s"(K));
    const int tid = opaque_v((int)threadIdx.x), wid = __builtin_amdgcn_readfirstlane(tid >> 6), lane = tid & 63, wr = wid >> 2, wc = wid & 3, fr = lane & 15, fq = lane >> 4;
    const int nt = K / (BK * 2);
    unsigned voffB;
    { int R0, C0; stage_rc(tid * 16, R0, C0); C0 *= 2;
      const int Rb0 = Epi::PERM ? ((R0 & ~31) + perm32(R0 & 31)) : R0;
      voffB = (unsigned)(Rb0 * K + C0); }
    const size_t r64 = (size_t)64 * K;
    const size_t kstep = (size_t)(BK * 2);
    const size_t hstep = (size_t)HALF * K;
    const unsigned ldsw = (unsigned)wid * 1024u, lds0 = (unsigned)(uintptr_t)lds;
    const int aoff = lds_byte(wr * 64 + fr, fq * 8), boff = lds_byte(wc * 32 + fr, fq * 8);
    Unit cur, nxt; int ui = 0;
    if (!S.next(0, cur)) return;
    f32x4 acc[2][2][4][2];
    float zz_ = 0.f; asm volatile("" : "+v"(zz_));
#pragma unroll
    for (int a = 0; a < 2; ++a)
#pragma unroll
        for (int b = 0; b < 2; ++b)
#pragma unroll
            for (int m = 0; m < 4; ++m)
#pragma unroll
                for (int n = 0; n < 2; ++n) acc[a][b][m][n] = (f32x4){zz_, zz_, zz_, zz_};
    bf16x8 At[4][2], B0[2][2], B1[2][2];
    i32x8v At8[4], B08[2], B18[2];
    unsigned vc[2][2], vn[2][2];
    int rcA = 0; if constexpr (Sched::GATHER) { int R0_, C0_; stage_rc(tid * 16, R0_, C0_); rcA = (R0_ << 8) | (C0_ * 2); }
    S.aoffs(cur, vc);
    const char* cB = S.bptr(cur);
    int sbc = 0;
#define PG8_SIDE(u_, buf_) do { if constexpr (Epi::NSIDE > 0) { _Pragma("unroll") for (int i_ = 0; i_ < Epi::NSIDE; ++i_) if (wid == i_) { const int ln_ = opaque_v((int)threadIdx.x) & 63; \
        const unsigned long long sp_ = (unsigned long long)(uintptr_t)E.side_base((u_), i_); const unsigned lo_ = __builtin_amdgcn_readfirstlane((unsigned)sp_), hi_ = __builtin_amdgcn_readfirstlane((unsigned)(sp_ >> 32)); \
        glds16s((const void*)(uintptr_t)(((unsigned long long)hi_ << 32) | lo_), E.side_voff(ln_, i_), lds0 + (unsigned)LDS_SIDE + (unsigned)(buf_) * 2048u + (unsigned)i_ * 1024u); } } } while (0)
    PG8_SIDE(cur, 0);
    PG8_STAGE_B(PG8_SB(0, 0), cB); PG8_STAGE_B(PG8_SB(0, 1), cB + hstep); PG8_STAGE_A(PG8_SA(0, 0), A0, 0); PG8_STAGE_A(PG8_SA(0, 1), A0, 1);
    if (wr == 1) PG8_BAR;
    PG8_WAIT_V(2); PG8_BAR;
    PG8_STAGE_B(PG8_SB(1, 0), cB + kstep); PG8_STAGE_A(PG8_SA(1, 0), A0 + kstep, 0); PG8_STAGE_B(PG8_SB(1, 1), cB + hstep + kstep);
    PG8_WAIT_V(6); PG8_BAR;
#pragma unroll 1
    for (;;) {
        const bool has_next = S.next(ui + 1, nxt);
        const char* nB = cB; unsigned dlt = 0u;
        if constexpr (Sched::GATHER) {
            if (has_next) { S.aload(nxt, vn, rcA); nB = S.bptr(nxt); }
        } else { if (has_next) { dlt = S.adelta(cur, nxt); nB = S.bptr(nxt); } }
        const int sbn = (sbc == 2) ? 0 : sbc + 1;
        if (has_next) PG8_SIDE(nxt, sbn);
#pragma unroll 1
        for (int t = 0; t < nt; t += 2) {
            const bool last = (t == nt - 2);
            const char* a1 = A0 + (size_t)(t + 1) * kstep;
            const char* a2 = last ? A0 : A0 + (size_t)(t + 2) * kstep; const char* b2 = last ? nB : cB + (size_t)(t + 2) * kstep;
            const char* a3 = a2 + kstep; const char* b3 = b2 + kstep;
            PG8_LB(B0, 0, 0); PG8_LB(B1, 0, 1); PG8_SCHED; PG8_LA(At, 0, 0); PG8_STAGE_A(PG8_SA(1, 1), a1, 1);
            PG8_WAIT_V(8); PG8_WAIT_L(0); PG8_BAR;
            if (last) {
                if constexpr (Sched::GATHER) { if (has_next) {
#pragma unroll
                    for (int h = 0; h < 2; ++h) { vc[h][0] = (unsigned)opaque_v((int)vn[h][0]); vc[h][1] = (unsigned)opaque_v((int)vn[h][1]); }
                    S.aconv(vc, rcA); } }
                else vc[0][0] += dlt; }
            PG8_MM(0, 0, At, B0); PG8_MM(0, 1, At, B1); PG8_BAR; PG8_SCHED;
            PG8_LA(At, 0, 1); PG8_STAGE_B(PG8_SB(0, 0), b2); PG8_STAGE_B(PG8_SB(0, 1), b2 + hstep); PG8_STAGE_A(PG8_SA(0, 0), a2, 0);
            PG8_WAIT_V(8); PG8_WAIT_L(0); PG8_BAR; PG8_MM(1, 0, At, B0); PG8_MM(1, 1, At, B1); PG8_BAR; PG8_SCHED;
            PG8_LB(B0, 1, 0); PG8_LB(B1, 1, 1); PG8_SCHED; PG8_LA(At, 1, 0); PG8_STAGE_A(PG8_SA(0, 1), a2, 1);
            PG8_WAIT_V(8); PG8_WAIT_L(0); PG8_BAR; PG8_MM(0, 0, At, B0); PG8_MM(0, 1, At, B1); PG8_BAR; PG8_SCHED;
            PG8_LA(At, 1, 1); PG8_STAGE_B(PG8_SB(1, 0), b3); PG8_STAGE_B(PG8_SB(1, 1), b3 + hstep); PG8_STAGE_A(PG8_SA(1, 0), a3, 0);
            PG8_WAIT_V(8); PG8_WAIT_L(0); PG8_BAR; PG8_MM(1, 0, At, B0); PG8_MM(1, 1, At, B1); PG8_BAR; PG8_SCHED;
        }
        if (wr == 0) PG8_BAR;
        if constexpr (FP8) PG8_MFMA_DRAIN();
        { const int l_ = opaque_v((int)threadIdx.x) & 63; E(acc, cur, wr, wc, l_ & 15, l_ >> 4, (const LAS float*)(lds + LDS_SIDE + sbc * 2048)); }
        if (!has_next) break;
        zz_ = 0.f; asm volatile("" : "+v"(zz_));
#pragma unroll
        for (int a = 0; a < 2; ++a)
#pragma unroll
            for (int b = 0; b < 2; ++b)
#pragma unroll
                for (int m = 0; m < 4; ++m)
#pragma unroll
                    for (int n = 0; n < 2; ++n) acc[a][b][m][n] = (f32x4){zz_, zz_, zz_, zz_};
        cur = nxt; cB = nB; ++ui; sbc = sbn;
        if (wr == 1) PG8_BAR;
    }
    PG8_WAIT_V(0);
    PG8_BAR;
}
}
namespace pg8 {
__device__ __forceinline__ u32x2 pack8_fp8(const f32x4 a, const f32x4 b) { int w0 = 0, w1 = 0;
    w0 = __builtin_amdgcn_cvt_pk_fp8_f32(a[0], a[1], w0, false); w0 = __builtin_amdgcn_cvt_pk_fp8_f32(a[2], a[3], w0, true);
    w1 = __builtin_amdgcn_cvt_pk_fp8_f32(b[0], b[1], w1, false); w1 = __builtin_amdgcn_cvt_pk_fp8_f32(b[2], b[3], w1, true); u32x2 r; r.x = (unsigned)w0; r.y = (unsigned)w1; return r; }
__device__ __forceinline__ u32x4 pack8(const f32x4 a, const f32x4 b) { u32x4 w; w.x = cvt_pk_bf16(a[0], a[1]); w.y = cvt_pk_bf16(a[2], a[3]); w.z = cvt_pk_bf16(b[0], b[1]); w.w = cvt_pk_bf16(b[2], b[3]); return w; }

struct EpiNull { static constexpr bool PERM = true; static constexpr int NSIDE = 0;
    __device__ __forceinline__ void operator()(const f32x4 (&acc)[2][2][4][2], const Unit& u, int wr, int wc, int fr, int fq, const LAS float* sd) const {} };
struct EpiPlainBf16 {
    static constexpr bool PERM = true; static constexpr int NSIDE = 0;
    bf16_t* O; int ldc; float sc;
    __device__ __forceinline__ void operator()(const f32x4 (&acc)[2][2][4][2], const Unit& u, int wr, int wc, int fr, int fq, const LAS float* sd) const {
        const int row0 = u.pm * BM + wr * 64 + fr, col0 = u.pn * BM + wc * 32 + 8 * fq;
#pragma unroll
        for (int ai = 0; ai < 2; ++ai)
#pragma unroll
            for (int m = 0; m < 4; ++m) { bf16_t* rowp = O + (size_t)(row0 + ai * HALF + m * 16) * ldc + col0;
#pragma unroll
                for (int bj = 0; bj < 2; ++bj) *(u32x4*)(rowp + bj * HALF) = pack8(acc[ai][bj][m][0] * sc, acc[ai][bj][m][1] * sc);
                __builtin_amdgcn_sched_barrier(0); }
    }
};

struct EpiHgrnIn {
    static constexpr bool PERM = true; static constexpr int NSIDE = 0;
    bf16_t* P; float* LF; const float* lb;
    int segmap; float scale;
    __device__ __forceinline__ void operator()(const f32x4 (&acc)[2][2][4][2], const Unit& u, int wr, int wc, int fr, int fq, const LAS float* sd) const {
        const int seg = (segmap >> (4 * (u.pn >> 2))) & 15;
        const int col0 = (u.pn & 3) * BM + wc * 32 + 8 * fq;
        const size_t ub = (size_t)((u.pm * 4 + wr) * 8 + (u.pn & 3) * 2) * 8192;
        const size_t base_t = ub + (size_t)(((2 * wc + (fq >> 1)) * 64 + (fr & 3) * 16 + (fr >> 2)) * 16 + 8 * (fq & 1));
        if (seg == 1) {
            float lbv[2][8];
#pragma unroll
            for (int bj = 0; bj < 2; ++bj) { const f32x4 a = *(const f32x4*)(lb + col0 + bj * HALF), b = *(const f32x4*)(lb + col0 + bj * HALF + 4);
                lbv[bj][0] = a[0]; lbv[bj][1] = a[1]; lbv[bj][2] = a[2]; lbv[bj][3] = a[3]; lbv[bj][4] = b[0]; lbv[bj][5] = b[1]; lbv[bj][6] = b[2]; lbv[bj][7] = b[3]; }
#pragma unroll
            for (int ai = 0; ai < 2; ++ai)
#pragma unroll
                for (int m = 0; m < 4; ++m) { const size_t off = base_t + (size_t)ai * 131072 + m * 64;
#pragma unroll
                    for (int bj = 0; bj < 2; ++bj) { float lf[8], ky[8];
#pragma unroll
                        for (int j = 0; j < 8; ++j) { const float f = acc[ai][bj][m][j >> 2][j & 3], l = lbv[bj][j];
                            const float sg = fsigmoid(f); const float fg = l + (1.0f - l) * sg;
                            lf[j] = __builtin_amdgcn_logf(fmaxf(fg, 1e-30f));        ky[j] = (1.0f - l) * (1.0f - sg); }
                        { u32x4 lw; lw.x = pk_f16(lf[0], lf[1]); lw.y = pk_f16(lf[2], lf[3]); lw.z = pk_f16(lf[4], lf[5]); lw.w = pk_f16(lf[6], lf[7]); *(u32x4*)((unsigned short*)LF + off + bj * 8192) = lw; }
                        u32x4 w; w.x = cvt_pk_bf16(ky[0], ky[1]); w.y = cvt_pk_bf16(ky[2], ky[3]); w.z = cvt_pk_bf16(ky[4], ky[5]); w.w = cvt_pk_bf16(ky[6], ky[7]);
                        *(u32x4*)(P + (size_t)T * D + off + bj * 8192) = w; }
                    __builtin_amdgcn_sched_barrier(0); }
        } else {
            bf16_t* O = P + (size_t)seg * T * D;
            const bool act = (seg != 2);
            size_t base = base_t; int SB = 8192, SM = 64;
            if (seg == 2) { base = ub + (size_t)(((4 * wc + fq) * 64 + fr) * 8); SM = 128; }
            if (seg == 3) { base = (size_t)(u.pm * BM + wr * 64 + fr) * D + col0; SB = HALF; SM = 16 * D; }
#pragma unroll
            for (int ai = 0; ai < 2; ++ai)
#pragma unroll
                for (int m = 0; m < 4; ++m) { const size_t off = base + (size_t)ai * 131072 + (size_t)(m * SM);
#pragma unroll
                    for (int bj = 0; bj < 2; ++bj) { f32x4 a = acc[ai][bj][m][0] * scale, b = acc[ai][bj][m][1] * scale;
                        asm volatile("" : "+v"(a), "+v"(b));
                        if (act) {
#pragma unroll
                            for (int j = 0; j < 4; ++j) { a[j] = fsilu(a[j]); b[j] = fsilu(b[j]); } }
                        *(u32x4*)(O + off + bj * SB) = pack8(a, b);
                        __builtin_amdgcn_sched_barrier(0); } }
        }
    }
};

struct EpiResid {
    static constexpr bool PERM = true; static constexpr int NSIDE = 0;
    const float* Xf; bf16_t* Xb; const float* gate; float sc;
    int gstride;
    __device__ __forceinline__ void operator()(const f32x4 (&acc)[2][2][4][2], const Unit& u, int wr, int wc, int fr, int fq, const LAS float* sd) const {
        const int row0 = u.pm * BM + wr * 64 + fr, col0 = u.pn * BM + wc * 32 + 8 * fq;
        const float* g = gate + (size_t)((u.pm * BM) / SEQ) * gstride;
        f32x4 gv[2][2];
#pragma unroll
        for (int bj = 0; bj < 2; ++bj)
#pragma unroll
            for (int n = 0; n < 2; ++n) gv[bj][n] = *(const f32x4*)(g + col0 + bj * HALF + n * 4) * sc;
#pragma unroll
        for (int ai = 0; ai < 2; ++ai) {
            if (Xf) {
#pragma unroll
                for (int mp = 0; mp < 2; ++mp) { f32x4 xin[2][2][2];
#pragma unroll
                    for (int mm = 0; mm < 2; ++mm) { const size_t off = (size_t)(row0 + ai * HALF + (2 * mp + mm) * 16) * D + col0;
#pragma unroll
                        for (int bj = 0; bj < 2; ++bj) { xin[mm][bj][0] = *(const f32x4*)(Xf + off + bj * HALF); xin[mm][bj][1] = *(const f32x4*)(Xf + off + bj * HALF + 4); } }
#pragma unroll
                    for (int mm = 0; mm < 2; ++mm) { const int m = 2 * mp + mm; const size_t off = (size_t)(row0 + ai * HALF + m * 16) * D + col0;
#pragma unroll
                        for (int bj = 0; bj < 2; ++bj) *(u32x4*)(Xb + off + bj * HALF) = pack8(xin[mm][bj][0] + gv[bj][0] * acc[ai][bj][m][0], xin[mm][bj][1] + gv[bj][1] * acc[ai][bj][m][1]); }
                    __builtin_amdgcn_sched_barrier(0); }
            } else if (ai == 0) {
                u32x4 xw[2][4][2];
#pragma unroll
                for (int a2 = 0; a2 < 2; ++a2)
#pragma unroll
                    for (int m = 0; m < 4; ++m) { const size_t off = (size_t)(row0 + a2 * HALF + m * 16) * D + col0;
#pragma unroll
                        for (int bj = 0; bj < 2; ++bj) xw[a2][m][bj] = *(const u32x4*)(Xb + off + bj * HALF); }
#pragma unroll
                for (int a2 = 0; a2 < 2; ++a2) {
#pragma unroll
                    for (int m = 0; m < 4; ++m) { const size_t off = (size_t)(row0 + a2 * HALF + m * 16) * D + col0;
#pragma unroll
                        for (int bj = 0; bj < 2; ++bj) { const u32x4 w = xw[a2][m][bj];
                            const f32x4 x0 = (f32x4){bflo(w.x), bfhi(w.x), bflo(w.y), bfhi(w.y)}, x1 = (f32x4){bflo(w.z), bfhi(w.z), bflo(w.w), bfhi(w.w)};
                            *(u32x4*)(Xb + off + bj * HALF) = pack8(x0 + gv[bj][0] * acc[a2][bj][m][0], x1 + gv[bj][1] * acc[a2][bj][m][1]); } }
                    __builtin_amdgcn_sched_barrier(0); }
                __builtin_amdgcn_sched_barrier(0); } }
    }
};

struct EpiKvUp {
    static constexpr bool PERM = true; static constexpr int NSIDE = 0;
    bf16_t *Kb, *Vb;
    __device__ __forceinline__ void operator()(const f32x4 (&acc)[2][2][4][2], const Unit& u, int wr, int wc, int fr, int fq, const LAS float* sd) const {
        const int row0 = u.pm * BM + wr * 64 + fr, c = wc * 32 + 8 * fq, h = u.pn;
#pragma unroll
        for (int ai = 0; ai < 2; ++ai)
#pragma unroll
            for (int m = 0; m < 4; ++m) { const size_t row = (size_t)(row0 + ai * HALF + m * 16);
                *(u32x4*)(Kb + row * (MH * QK) + h * QK + c) = pack8(acc[ai][0][m][0], acc[ai][0][m][1]);
                *(u32x4*)(Vb + row * D + h * VD + c) = pack8(acc[ai][1][m][0], acc[ai][1][m][1]);
                __builtin_amdgcn_sched_barrier(0); }
    }
};

struct EpiQUp {
    static constexpr bool PERM = true; static constexpr int NSIDE = 0;
    bf16_t* Qb; const float* rope;
    __device__ __forceinline__ void operator()(const f32x4 (&acc)[2][2][4][2], const Unit& u, int wr, int wc, int fr, int fq, const LAS float* sd) const {
        const int row0 = u.pm * BM + wr * 64 + fr, c = wc * 32 + 8 * fq;
        if (u.pn < 4) {
#pragma unroll
            for (int ai = 0; ai < 2; ++ai)
#pragma unroll
                for (int m = 0; m < 4; ++m) { const size_t row = (size_t)(row0 + ai * HALF + m * 16);
#pragma unroll
                    for (int bj = 0; bj < 2; ++bj) *(u32x4*)(Qb + row * (MH * QK) + (2 * u.pn + bj) * QK + c) = pack8(acc[ai][bj][m][0], acc[ai][bj][m][1]);
                    __builtin_amdgcn_sched_barrier(0); }
        } else {
            const int h = 4 * (u.pn - 4) + wc, i0 = 8 * fq;
#pragma unroll
            for (int ai = 0; ai < 2; ++ai)
#pragma unroll
              for (int mp = 0; mp < 1; ++mp) {
                f32x4 cs[4][4];
#pragma unroll
                for (int mm = 0; mm < 4; ++mm) { const float* rp = rope + (size_t)(row0 + ai * HALF + mm * 16) * 64 + i0;
                    cs[mm][0] = *(const f32x4*)(rp); cs[mm][1] = *(const f32x4*)(rp + 4); cs[mm][2] = *(const f32x4*)(rp + 32); cs[mm][3] = *(const f32x4*)(rp + 36); }
#pragma unroll
                for (int mm = 0; mm < 4; ++mm) { const int m = mm; const size_t row = (size_t)(row0 + ai * HALF + m * 16);
                    const f32x4 c0 = cs[mm][0], c1 = cs[mm][1], s0 = cs[mm][2], s1 = cs[mm][3];
                    const f32x4 a0 = acc[ai][0][m][0], a1 = acc[ai][0][m][1], b0 = acc[ai][1][m][0], b1 = acc[ai][1][m][1];
                    const f32x4 o10 = a0 * c0 - b0 * s0, o11 = a1 * c1 - b1 * s1, o20 = b0 * c0 + a0 * s0, o21 = b1 * c1 + a1 * s1;
                    bf16_t* qp = Qb + row * (MH * QK) + h * QK + NOPE + i0;
                    *(u32x4*)(qp) = pack8(o10, o11); *(u32x4*)(qp + 32) = pack8(o20, o21); }
                __builtin_amdgcn_sched_barrier(0); }
        }
    }
};

template <bool GATHER_> struct MoeSched {
    static constexpr bool GATHER = GATHER_;
    const LAS int* tab;
    const LAS int* blke;
    int NT, G, c;
    const char* Bt; size_t estride; int K;
    const int* rinfo;
    __device__ __forceinline__ unsigned adelta(const Unit& a, const Unit& b) const { return (unsigned)((b.pm - a.pm) * BM * K); }
    __device__ __forceinline__ bool next(int i, Unit& u) const {
        const int L = i * G + c; const int rb = L / NT;
        if (rb >= tab[32]) return false;
        u.pm = rb; u.pn = L - rb * NT; u.e = blke[rb]; return true;
    }
    __device__ __forceinline__ const char* bptr(const Unit& u) const { return Bt + (size_t)u.e * estride + (size_t)u.pn * BM * K; }
    __device__ __forceinline__ void aload(const Unit& u, unsigned (&raw)[2][2], int rc) const {
        const int R0 = rc >> 8; const int lb = (u.pm - tab[u.e]) * BM; const int lim = tab[64 + u.e] - lb;
        const int* rp = rinfo + (size_t)u.e * VCAP + lb;
#pragma unroll
        for (int h = 0; h < 2; ++h) { const int r0 = h * HALF + R0, r1 = r0 + 64; const int a = rp[r0 < lim ? r0 : 0], b = rp[r1 < lim ? r1 : 0];
            raw[h][0] = (unsigned)(r0 < lim ? a : -1); raw[h][1] = (unsigned)(r1 < lim ? b : -1); }
    }
    __device__ __forceinline__ void aconv(unsigned (&o)[2][2], int rc) const {
        const int C0 = rc & 255;
#pragma unroll
        for (int h = 0; h < 2; ++h) { const int i0 = (int)o[h][0], i1 = (int)o[h][1]; const int t0 = (i0 < 0 ? 0 : i0) >> 2, t1 = (i1 < 0 ? 0 : i1) >> 2;
            o[h][0] = (unsigned)(t0 * K + C0); o[h][1] = (unsigned)(t1 * K + C0); }
    }
    __device__ __forceinline__ void aoffs(const Unit& u, unsigned (&o)[2][2]) const {
        int R0, C0, R1, C1; { const int t_ = opaque_v((int)threadIdx.x); stage_rc(t_ * 16, R0, C0); stage_rc(t_ * 16 + 8192, R1, C1); C0 *= 2; C1 *= 2; }
        if constexpr (GATHER_) { const int rc = (R0 << 8) | C0; aload(u, o, rc); aconv(o, rc); }
        else {
#pragma unroll
            for (int h = 0; h < 2; ++h) { o[h][0] = (unsigned)((u.pm * BM + h * HALF + R0) * K + C0); o[h][1] = (unsigned)((u.pm * BM + h * HALF + R1) * K + C1); }
        }
    }
};

struct MoeSchedHot : MoeSched<true> {
    __device__ __forceinline__ bool next(int i, Unit& u) const { if (!MoeSched<true>::next(i, u)) return false; u.pm &= 3; u.pn = 0; u.e = blke[u.pm]; return true; } };

struct EpiMoeGU {
    static constexpr bool PERM = true; static constexpr int NSIDE = 1;
    unsigned char* ACT; const float* bgu;
    __device__ __forceinline__ const char* side_base(const Unit& u, int) const { return (const char*)(bgu + (size_t)u.e * 2048 + u.pn * HALF); }
    __device__ __forceinline__ unsigned side_voff(int lane, int) const { return (unsigned)((lane & 31) * 16 + (lane >> 5) * 4096); }
    __device__ __forceinline__ void operator()(const f32x4 (&acc)[2][2][4][2], const Unit& u, int wr, int wc, int fr, int fq, const LAS float* sd) const {
        const int row0 = u.pm * BM + wr * 64 + fr, c = u.pn * HALF + wc * 32 + 8 * fq;
        const LAS float* bp = sd + wc * 32 + 8 * fq;
        const f32x4 bg0 = *(const LAS f32x4*)(bp), bg1 = *(const LAS f32x4*)(bp + 4), bu0 = *(const LAS f32x4*)(bp + 128) + 1.0f, bu1 = *(const LAS f32x4*)(bp + 132) + 1.0f;
#pragma unroll
        for (int ai = 0; ai < 2; ++ai)
#pragma unroll
            for (int m = 0; m < 4; ++m) { const size_t row = (size_t)(row0 + ai * HALF + m * 16);
                const f32x4 lim = (f32x4){SWIGLU_LIMIT, SWIGLU_LIMIT, SWIGLU_LIMIT, SWIGLU_LIMIT};
                const f32x4 g0 = __builtin_elementwise_min(acc[ai][0][m][0] * 0.015625f + bg0, lim), g1 = __builtin_elementwise_min(acc[ai][0][m][1] * 0.015625f + bg1, lim);
                const f32x4 u0 = __builtin_elementwise_min(__builtin_elementwise_max(acc[ai][1][m][0] * 0.015625f + bu0, 1.0f - lim), 1.0f + lim), u1 = __builtin_elementwise_min(__builtin_elementwise_max(acc[ai][1][m][1] * 0.015625f + bu1, 1.0f - lim), 1.0f + lim);
                const f32x4 z0 = g0 * (-SWIGLU_ALPHA * 1.4426950408889634f), z1 = g1 * (-SWIGLU_ALPHA * 1.4426950408889634f);
                f32x4 s0, s1;
#pragma unroll
                for (int j = 0; j < 4; ++j) { s0[j] = __builtin_amdgcn_rcpf(1.0f + __builtin_amdgcn_exp2f(z0[j])); s1[j] = __builtin_amdgcn_rcpf(1.0f + __builtin_amdgcn_exp2f(z1[j])); }
                const f32x4 r0 = u0 * (g0 * s0), r1 = u1 * (g1 * s1);
                *(u32x2*)(ACT + row * FF + c) = pack8_fp8(r0, r1);
                __builtin_amdgcn_sched_barrier(0); }
    }
};

struct EpiMoeDN {
    static constexpr bool PERM = true; static constexpr int NSIDE = 2;
    unsigned char* YS; const float* bdn; const LAS int* tab; const float* rw;
    __device__ __forceinline__ const char* side_base(const Unit& u, int i) const { return i == 0 ? (const char*)(rw + (size_t)u.e * VCAP + (size_t)(u.pm - tab[u.e]) * BM) : (const char*)(bdn + (size_t)u.e * 1024 + u.pn * BM); }
    __device__ __forceinline__ unsigned side_voff(int lane, int) const { return (unsigned)(lane * 16); }
    __device__ __forceinline__ void operator()(const f32x4 (&acc)[2][2][4][2], const Unit& u, int wr, int wc, int fr, int fq, const LAS float* sd) const {
        const int row0 = u.pm * BM + wr * 64 + fr, c = u.pn * BM + wc * 32 + 8 * fq;
        const LAS float* bp = sd + 256 + wc * 32 + 8 * fq; const LAS float* wp = sd + wr * 64 + fr;
        f32x4 bb[2][2];
#pragma unroll
        for (int bj = 0; bj < 2; ++bj) { bb[bj][0] = *(const LAS f32x4*)(bp + bj * HALF) * 64.0f; bb[bj][1] = *(const LAS f32x4*)(bp + bj * HALF + 4) * 64.0f; }
#pragma unroll
        for (int ai = 0; ai < 2; ++ai)
#pragma unroll
            for (int m = 0; m < 4; ++m) { const float w = wp[ai * HALF + m * 16] * 0.5f;
                unsigned char* yp = YS + (size_t)(row0 + ai * HALF + m * 16) * D + c;
#pragma unroll
                for (int bj = 0; bj < 2; ++bj) {
                    const f32x4 v0 = (acc[ai][bj][m][0] + bb[bj][0]) * w, v1 = (acc[ai][bj][m][1] + bb[bj][1]) * w;
                    int p0 = 0, p1 = 0;
                    p0 = __builtin_amdgcn_cvt_pk_fp8_f32(__builtin_amdgcn_fmed3f(v0[0], -448.f, 448.f), __builtin_amdgcn_fmed3f(v0[1], -448.f, 448.f), p0, false);
                    p0 = __builtin_amdgcn_cvt_pk_fp8_f32(__builtin_amdgcn_fmed3f(v0[2], -448.f, 448.f), __builtin_amdgcn_fmed3f(v0[3], -448.f, 448.f), p0, true);
                    p1 = __builtin_amdgcn_cvt_pk_fp8_f32(__builtin_amdgcn_fmed3f(v1[0], -448.f, 448.f), __builtin_amdgcn_fmed3f(v1[1], -448.f, 448.f), p1, false);
                    p1 = __builtin_amdgcn_cvt_pk_fp8_f32(__builtin_amdgcn_fmed3f(v1[2], -448.f, 448.f), __builtin_amdgcn_fmed3f(v1[3], -448.f, 448.f), p1, true);
                    u32x2 o; o.x = (unsigned)p0; o.y = (unsigned)p1; *(u32x2*)(yp + bj * HALF) = o; }
                __builtin_amdgcn_sched_barrier(0); }
    }
};
}
typedef const __attribute__((address_space(4))) unsigned long long* KargPtr;
struct InTab { KargPtr p;
    __device__ __forceinline__ const float* operator[](int i) const { KargPtr q = p; asm volatile("" : "+s"(q)); return (const float*)(const GAS float*)q[i]; } };
struct Ctx {
    LAS unsigned char* lds;
    int G, vcu;
    InTab in; float* out; unsigned char* ws;
    __device__ __forceinline__ float* MOD() const { return (float*)(ws + WS_MOD); }
    __device__ __forceinline__ unsigned* ctl() const { return (unsigned*)(ws + WS_CTL); }
};
__device__ __forceinline__ const float* modp(const Ctx& F, int l, int b, int which) { return (const float*)(F.ws + WS_MOD) + ((size_t)(l * NB + b) * 6 + which) * D; }

__device__ const double ROPE_INV_FREQ[32] = {
    1.0, 0.7498942093324559, 0.5623413251903491, 0.4216965034285822, 0.31622776601683794, 0.23713737056616552, 0.1778279410038923, 0.1333521432163324,
    0.1, 0.07498942093324559, 0.05623413251903491, 0.04216965034285822, 0.03162277660168379, 0.023713737056616554, 0.01778279410038923, 0.01333521432163324,
    0.01, 0.007498942093324559, 0.005623413251903491, 0.004216965034285822, 0.0031622776601683794, 0.0023713737056616554, 0.001778279410038923, 0.001333521432163324,
    0.001, 0.0007498942093324559, 0.0005623413251903491, 0.0004216965034285822, 0.00031622776601683794, 0.00023713737056616554, 0.0001778279410038923, 0.0001333521432163324};

__device__ __forceinline__ int map_rows(int maptype, int n0) {
    if (maptype == 1) { return n0 < 1024 ? (n0 >> 7) * 256 + (n0 & 127) : ((n0 - 1024) >> 7) * 256 + 128 + ((n0 - 1024) & 127); }
    if (maptype == 2) { const int h = n0 / QK, d = n0 - h * QK; if (d < NOPE) return h * NOPE + d; const int i = d - NOPE;
                        return 1024 + (h >> 2) * 256 + (i >> 5) * 128 + (h & 3) * 32 + (i & 31); }
    return n0;
}
struct ConvD { const float* src; unsigned char* dst; int N, Kb; };
#define CONV_DEC(Wp, wstride, nmat, K_, N_, dstoff, dstride, mt, f8_) CONV_DECP(Wp, wstride, nmat, K_, N_, N_, dstoff, dstride, mt, f8_)
#define CONV_DECP(Wp, wstride, nmat, K_, N_, pitch_, dstoff, dstride, mt, f8_) do { if ((f8_) == PASS8) { constexpr int KD = (f8_) ? 128 : 64; const int per = ((K_) / KD) * ((N_) / 32), tot = (nmat) * per; \
        if (r < tot) { const int mi = r / per, item = r - mi * per, nblk = (N_) / 32, kb = item / nblk, nb = item - kb * nblk, es = (f8_) ? 1 : 2; \
            d.src = (Wp) + (size_t)mi * (wstride) + (size_t)(KD * kb) * (pitch_) + 32 * nb; d.N = (pitch_); d.Kb = (K_) * es; \
            d.dst = F.ws + (dstoff) + ((size_t)mi * (dstride) + (size_t)map_rows((mt), 32 * nb) * (K_) + KD * kb) * es; return; } r -= tot; } } while (0)
template <int PASS8> __device__ __forceinline__ void conv_decode(const Ctx& F, int it, ConvD& d) {
    int r = it;
    CONV_DEC(F.in[23], (size_t)1024 * 2048, 128, 1024, 2048, WS_WGU, (size_t)2048 * 1024, 1, 1);
    CONV_DEC(F.in[25], (size_t)1024 * 1024, 128, 1024, 1024, WS_WDN, (size_t)1024 * 1024, 0, 1);
    CONV_DECP(F.in[7],        (size_t)1024 * 4096, 2, 1024, 1024, 4096, WS_WIN, (size_t)3072 * 1024, 0, 1);
    CONV_DECP(F.in[7] + 2048, (size_t)1024 * 4096, 2, 1024, 1024, 4096, WS_WIN + (size_t)1024 * 1024, (size_t)3072 * 1024, 0, 1);
    CONV_DECP(F.in[7] + 3072, (size_t)1024 * 4096, 2, 1024, 1024, 4096, WS_WIN + (size_t)2048 * 1024, (size_t)3072 * 1024, 0, 1);
    CONV_DECP(F.in[7] + 1024, (size_t)1024 * 4096, 2, 1024, 1024, 4096, WS_WINF, (size_t)1024 * 1024, 0, 0);
    CONV_DEC(F.in[10], (size_t)1024 * 1024, 2, 1024, 1024, WS_WOUT, (size_t)1024 * 1024, 0, 1);
    CONV_DEC(F.in[14], (size_t)0, 1, 1024, 320, WS_WDKV, (size_t)0, 0, 1);
    CONV_DEC(F.in[16], (size_t)0, 1, 256, 2048, WS_WUKV, (size_t)0, 0, 0);
    CONV_DEC(F.in[17], (size_t)1024 * 384, 2, 1024, 384, WS_WDQ, (size_t)512 * 1024, 0, 1);
    CONV_DEC(F.in[19], (size_t)384 * 1536, 2, 384, 1536, WS_WUQ, (size_t)1536 * 384, 2, 0);
    CONV_DEC(F.in[20], (size_t)1024 * 1024, 2, 1024, 1024, WS_WO, (size_t)1024 * 1024, 0, 1);
    d.src = F.in[20]; d.dst = F.ws + WS_WO; d.N = 1024; d.Kb = 2048;
}
template <int NL> __device__ __forceinline__ void conv_load(const ConvD& d, int lane, float (&wv)[NL]) {
    const float* p = d.src + (size_t)(lane >> 5) * d.N + (lane & 31);
#pragma unroll
    for (int i = 0; i < NL; ++i) wv[i] = p[(size_t)(2 * i) * d.N];
}
template <int NL, int F8> __device__ __forceinline__ void conv_store(const ConvD& d, int lane, LAS float* scr, const float (&wv)[NL]) {
    { LAS float* w = scr + (lane >> 5) * 32; const int n = lane & 31;
#pragma unroll
      for (int i = 0; i < NL; ++i) w[(2 * i) * 32 + (n ^ (i & 24))] = wv[i]; }
    LDS_WAIT(); asm volatile("" ::: "memory");
    const int c = lane & 7;
#pragma unroll
    for (int j = 0; j < 4; ++j) { const int n = (lane >> 3) + 8 * j;
        if constexpr (F8) { const LAS float* s = scr + (16 * c) * 32 + (n ^ (8 * (c & 3)));
            u32x4 o;
#pragma unroll
            for (int q = 0; q < 4; ++q) { int t = 0;
                t = __builtin_amdgcn_cvt_pk_fp8_f32(s[(4 * q) * 32] * 64.f, s[(4 * q + 1) * 32] * 64.f, t, false);
                t = __builtin_amdgcn_cvt_pk_fp8_f32(s[(4 * q + 2) * 32] * 64.f, s[(4 * q + 3) * 32] * 64.f, t, true); o[q] = (unsigned)t; }
            *(u32x4*)(d.dst + (size_t)n * d.Kb + 16 * c) = o; }
        else { const LAS float* s = scr + (8 * c) * 32 + (n ^ (8 * ((c >> 1) & 3)));
            u32x4 o;
#pragma unroll
            for (int q = 0; q < 4; ++q) o[q] = cvt_pk_bf16(s[(2 * q) * 32], s[(2 * q + 1) * 32]);
            *(u32x4*)(d.dst + (size_t)n * d.Kb + 16 * c) = o; } }
    LDS_WAIT(); asm volatile("" ::: "memory");
}
template <int PASS8> __device__ __forceinline__ void conv_pass(const Ctx& F, LAS float* scr, int gw, int NGW, int lane) {
    constexpr int NL = PASS8 ? 64 : 32;
    constexpr int TOTAL = PASS8 ? (128 * 8 * 64 + 128 * 8 * 32 + 3 * 2 * 8 * 32 + 2 * 8 * 32 + 2 * 8 * 32 + 8 * 10 + 2 * 8 * 12) : (2 * 16 * 32 + 4 * 64 + 2 * 6 * 48);
    float wa[NL], wb[NL];
    int it = gw;
    if (it < TOTAL) { ConvD da, db; conv_decode<PASS8>(F, it, da); conv_load<NL>(da, lane, wa);
        for (;;) {
            const int it1 = it + NGW; const bool h1 = it1 < TOTAL;
            if (h1) { conv_decode<PASS8>(F, it1, db); conv_load<NL>(db, lane, wb); }
            conv_store<NL, PASS8>(da, lane, scr, wa);
            if (!h1) break;
            const int it2 = it1 + NGW; const bool h2 = it2 < TOTAL;
            if (h2) { conv_decode<PASS8>(F, it2, da); conv_load<NL>(da, lane, wa); }
            conv_store<NL, PASS8>(db, lane, scr, wb);
            if (!h2) break;
            it = it2;
        } }
}
__device__ __forceinline__ void phase_convert(const Ctx& F) {
    PHASE_IDS;
    LAS float* scr = (LAS float*)(F.lds + wave * 16384);
    const int gw = F.vcu * NWAVES + wave, NGW = F.G * NWAVES;
    conv_pass<1>(F, scr, gw, NGW, lane);
    conv_pass<0>(F, scr, gw, NGW, lane);
    const int gt = (F.vcu * NTHREADS + tid), NGT = F.G * NTHREADS;
    for (int it = gt; it < DEPTH * NE * 128; it += NGT) { const int l = it >> 12, e = (it >> 7) & 31, c = it & 127;
        const float* wp = F.in[21] + (size_t)l * D * NE + (size_t)(8 * c) * NE + e;
        float w[8];
#pragma unroll
        for (int i = 0; i < 8; ++i) w[i] = wp[i * NE];
        u32x4 hi, lo;
#pragma unroll
        for (int q = 0; q < 4; ++q) { const unsigned h = cvt_pk_bf16(w[2 * q], w[2 * q + 1]); hi[q] = h;
            lo[q] = cvt_pk_bf16(w[2 * q] - __uint_as_float(h << 16), w[2 * q + 1] - __uint_as_float(h & 0xffff0000u)); }
        unsigned char* dst = F.ws + WS_WR + (size_t)l * 131072 + (size_t)e * 2048 + 16 * (c ^ (e & 15));
        *(u32x4*)dst = hi; *(u32x4*)(dst + 65536) = lo; }
    for (int i = gt; i < 192 * 1024 / 16; i += NGT) *((u32x4*)(F.ws + WS_WDKV + (size_t)320 * 1024) + i) = (u32x4){0u, 0u, 0u, 0u};
    for (int i = gt; i < 2 * 128 * 1024 / 16; i += NGT) { const int m = i / (128 * 1024 / 16), j = i - m * (128 * 1024 / 16);
        *((u32x4*)(F.ws + WS_WDQ + (size_t)m * 512 * 1024 + (size_t)384 * 1024) + j) = (u32x4){0u, 0u, 0u, 0u}; }
}

__device__ __forceinline__ void phase_mod(const Ctx& F) {
    PHASE_IDS;
    LAS float* cact = (LAS float*)(F.lds);
    LAS float* red = (LAS float*)(F.lds + 65536);
    const float* c = F.in[1];
    for (int i = tid; i < NB * D; i += NTHREADS) { const int b = i / D, k = i - b * D; cact[k * 16 + b] = fsilu(c[i]); }
    __syncthreads();
    constexpr int NTASK = (DEPTH * 6 * D + 2 * D) / 128;
    const int kq = tid >> 7, jj = tid & 127;
    for (int task = F.vcu; task < NTASK; task += F.G) {
        const int gcol = task * 128 + jj;
        const float* W; const float* bias; float* outp; int N, col, l = gcol / (6 * D);
        if (l < DEPTH) { col = gcol - l * 6 * D; N = 6 * D; W = F.in[5] + (size_t)l * D * N; bias = F.in[6] + (size_t)l * N; outp = (float*)(F.ws + WS_MOD) + (size_t)l * NB * N; }
        else { col = gcol - DEPTH * 6 * D; N = 2 * D; W = F.in[12]; bias = F.in[13]; outp = (float*)(F.ws + WS_KVMOD); }
        float acc[16];
#pragma unroll
        for (int b = 0; b < 16; ++b) acc[b] = 0.f;
#pragma unroll 8
        for (int k = kq * 256; k < kq * 256 + 256; ++k) {
            const float w = W[(size_t)k * N + col];
            const LAS f32x4* cp = (const LAS f32x4*)(cact + k * 16);
#pragma unroll
            for (int q = 0; q < 4; ++q) { const f32x4 cv = cp[q]; acc[4 * q] += cv[0] * w; acc[4 * q + 1] += cv[1] * w; acc[4 * q + 2] += cv[2] * w; acc[4 * q + 3] += cv[3] * w; }
        }
#pragma unroll
        for (int q = 0; q < 4; ++q) *(LAS f32x4*)(red + (kq * 128 + jj) * 16 + 4 * q) = (f32x4){acc[4 * q], acc[4 * q + 1], acc[4 * q + 2], acc[4 * q + 3]};
        __syncthreads();
#pragma unroll
        for (int q = 0; q < 4; ++q) { const int o = tid + q * NTHREADS, cj = o >> 4, b = o & 15;
            const float s = red[(0 * 128 + cj) * 16 + b] + red[(1 * 128 + cj) * 16 + b] + red[(2 * 128 + cj) * 16 + b] + red[(3 * 128 + cj) * 16 + b];
            const int oc = (task * 128 + cj) - (l < DEPTH ? l * 6 * D : DEPTH * 6 * D);
            outp[(size_t)b * N + oc] = s + bias[oc]; }
        __syncthreads();
    }
    const int gt = (F.vcu * NTHREADS + tid), NGT = F.G * NTHREADS;
    for (int i = gt; i < D; i += NGT) { const float l0 = F.in[8][i], l1 = F.in[8][D + i];
        ((float*)(F.ws + WS_LB))[i] = 0.f; ((float*)(F.ws + WS_LB))[D + i] = 1.0f / (1.0f + __expf(l0 - l1)); }
    const int* pos = (const int*)F.in[2];
    for (int i = gt; i < T * 32; i += NGT) { const int t = i >> 5, j = i & 31;
        const double rev = (double)pos[t] * ROPE_INV_FREQ[j] * 0.15915494309189535;
        const float fr = (float)(rev - floor(rev));
        float* rp = (float*)(F.ws + WS_ROPE) + (size_t)t * 64 + j;
        rp[0] = __builtin_amdgcn_cosf(fr); rp[32] = __builtin_amdgcn_sinf(fr); }
}

struct Row4 { f32x4 v[4]; };
__device__ __forceinline__ f32x4 bf4lo(const u32x4 w) { return (f32x4){bflo(w.x), bfhi(w.x), bflo(w.y), bfhi(w.y)}; }
__device__ __forceinline__ f32x4 bf4hi(const u32x4 w) { return (f32x4){bflo(w.z), bfhi(w.z), bflo(w.w), bfhi(w.w)}; }
__device__ __forceinline__ int row4_col(int lane, int j) { return 512 * (j >> 1) + 8 * lane + 4 * (j & 1); }
__device__ __forceinline__ Row4 ld_row_f32(const float* p, int lane) { Row4 r; const f32x4* q = (const f32x4*)p + 2 * lane;
#pragma unroll
    for (int j = 0; j < 4; ++j) r.v[j] = q[128 * (j >> 1) + (j & 1)]; return r; }
__device__ __forceinline__ void st_row_f32(float* p, int lane, const Row4& r) { f32x4* q = (f32x4*)p + 2 * lane;
#pragma unroll
    for (int j = 0; j < 4; ++j) q[128 * (j >> 1) + (j & 1)] = r.v[j]; }
__device__ __forceinline__ Row4 ld_row_bf16(const bf16_t* p, int lane) { Row4 r; const u32x4* q = (const u32x4*)p + lane;
#pragma unroll
    for (int jj = 0; jj < 2; ++jj) { const u32x4 w = q[64 * jj]; r.v[2 * jj] = (f32x4){bflo(w.x), bfhi(w.x), bflo(w.y), bfhi(w.y)}; r.v[2 * jj + 1] = (f32x4){bflo(w.z), bfhi(w.z), bflo(w.w), bfhi(w.w)}; } return r; }
__device__ __forceinline__ void st_row_bf16(bf16_t* p, int lane, const Row4& r) { u32x4* q = (u32x4*)p + lane;
#pragma unroll
    for (int jj = 0; jj < 2; ++jj) { u32x4 w; w.x = cvt_pk_bf16(r.v[2 * jj][0], r.v[2 * jj][1]); w.y = cvt_pk_bf16(r.v[2 * jj][2], r.v[2 * jj][3]);
        w.z = cvt_pk_bf16(r.v[2 * jj + 1][0], r.v[2 * jj + 1][1]); w.w = cvt_pk_bf16(r.v[2 * jj + 1][2], r.v[2 * jj + 1][3]); q[64 * jj] = w; } }
__device__ __forceinline__ void st_row_fp8(unsigned char* p, int lane, const Row4& r) { u32x2* q = (u32x2*)p + lane;
#pragma unroll
    for (int jj = 0; jj < 2; ++jj) { int w0 = 0, w1 = 0;
        w0 = __builtin_amdgcn_cvt_pk_fp8_f32(r.v[2 * jj][0], r.v[2 * jj][1], w0, false); w0 = __builtin_amdgcn_cvt_pk_fp8_f32(r.v[2 * jj][2], r.v[2 * jj][3], w0, true);
        w1 = __builtin_amdgcn_cvt_pk_fp8_f32(r.v[2 * jj + 1][0], r.v[2 * jj + 1][1], w1, false); w1 = __builtin_amdgcn_cvt_pk_fp8_f32(r.v[2 * jj + 1][2], r.v[2 * jj + 1][3], w1, true);
        u32x2 o; o.x = (unsigned)w0; o.y = (unsigned)w1; q[64 * jj] = o; } }
__device__ __forceinline__ float row_ssq(const Row4& r) { float s = 0.f;
#pragma unroll
    for (int j = 0; j < 4; ++j) s += (r.v[j][0] * r.v[j][0] + r.v[j][1] * r.v[j][1]) + (r.v[j][2] * r.v[j][2] + r.v[j][3] * r.v[j][3]);
    return wave_sum(s); }
__device__ __forceinline__ Row4 norm_mod(const Row4& x, float rstd, const float* g, const float* sc, const float* sh, int lane) {
    const Row4 gv = ld_row_f32(g, lane), scv = ld_row_f32(sc, lane), shv = ld_row_f32(sh, lane); Row4 h;
#pragma unroll
    for (int j = 0; j < 4; ++j) h.v[j] = (x.v[j] * rstd * gv.v[j]) * (scv.v[j] + 1.0f) + shv.v[j];
    return h; }

template <bool FIRST> struct CombRow;
template <> struct CombRow<true> { f32x4 xf[4]; };
template <> struct CombRow<false> { u32x4 xb[2]; u32x2 ys[4][2]; };
__device__ __forceinline__ f32x4 fp8x4(unsigned w) { const auto lo = __builtin_amdgcn_cvt_pk_f32_fp8((int)w, false), hi = __builtin_amdgcn_cvt_pk_f32_fp8((int)w, true); return (f32x4){lo[0], lo[1], hi[0], hi[1]}; }
template <bool FIRST> __device__ __forceinline__ void comb_load(CombRow<FIRST>& r, const Ctx& F, int m, int lane, int d0, int d1, int d2, int d3) {
    if constexpr (FIRST) { const f32x4* q = (const f32x4*)(F.in[0] + (size_t)m * D) + 2 * lane;
#pragma unroll
        for (int j = 0; j < 4; ++j) r.xf[j] = q[128 * (j >> 1) + (j & 1)]; }
    else { const u32x4* q = (const u32x4*)((const bf16_t*)(F.ws + WS_XB) + (size_t)m * D) + lane; r.xb[0] = q[0]; r.xb[1] = q[64];
#pragma unroll
        for (int s = 0; s < 4; ++s) { const int dr = s == 0 ? d0 : (s == 1 ? d1 : (s == 2 ? d2 : d3));
            const u32x2* y = (const u32x2*)((const unsigned char*)(F.ws + WS_YS) + (size_t)dr * D) + lane; r.ys[s][0] = y[0]; r.ys[s][1] = y[64]; } }
}
template <bool FIRST> __device__ __forceinline__ void phase_combine(const Ctx& F, int l, bool dummy = false) {
    PHASE_IDS;
    const int gw = F.vcu * NWAVES + wave, NGW = F.G * NWAVES;
    bf16_t* XB = (bf16_t*)(F.ws + (dummy ? WS_ACT + (size_t)T * D * 6 : WS_XB));
    float* Xout = dummy ? (float*)(F.ws + WS_ACT) : F.out; bf16_t* Hout = (bf16_t*)(F.ws + (dummy ? WS_ACT + (size_t)T * D * 4 : WS_H));
    for (int ch = gw; ch < T / 32; ch += NGW) {
        const int m0 = ch * 32, b = m0 / SEQ, ln = l + 1;
        Row4 gt, gm, shv;
        if (l >= 0) { gt = ld_row_f32(modp(F, l, b, 5), lane);
#pragma unroll
            for (int j = 0; j < 4; ++j) gt.v[j] *= 0.03125f; }
        if (l == DEPTH - 1) gm = ld_row_f32(F.in[27], lane);
        else { const Row4 g = ld_row_f32(F.in[3] + (size_t)ln * D, lane), sc = ld_row_f32(modp(F, ln, b, 1), lane); shv = ld_row_f32(modp(F, ln, b, 0), lane);
#pragma unroll
            for (int j = 0; j < 4; ++j) gm.v[j] = g.v[j] * (sc.v[j] + 1.0f); }
        CombRow<FIRST> cur, nxt;
        int dv0 = 0, dv1 = 0, dv2 = 0, dv3 = 0;
        if constexpr (!FIRST) { const int4 dd = *(const int4*)((const int*)(F.ws + WS_TKR) + (size_t)(m0 + (lane & 31)) * 4), ee = *(const int4*)((const int*)(F.ws + WS_TKE) + (size_t)(m0 + (lane & 31)) * 4);
            const LAS int* tab = (const LAS int*)(F.lds + LDS_TAB);
            dv0 = tab[ee.x] * MOEB + dd.x; dv1 = tab[ee.y] * MOEB + dd.y; dv2 = tab[ee.z] * MOEB + dd.z; dv3 = tab[ee.w] * MOEB + dd.w; }
#define COMB_D(r_) __shfl(dv0, (r_)), __shfl(dv1, (r_)), __shfl(dv2, (r_)), __shfl(dv3, (r_))
        comb_load<FIRST>(cur, F, m0, lane, COMB_D(0));
        for (int r = 0; r < 32; ++r) {
            const int m = m0 + r;
            if (r + 1 < 32) comb_load<FIRST>(nxt, F, m + 1, lane, COMB_D(r + 1));
            Row4 x;
            if constexpr (FIRST) {
#pragma unroll
                for (int j = 0; j < 4; ++j) x.v[j] = cur.xf[j]; }
            else {
                x.v[0] = bf4lo(cur.xb[0]); x.v[1] = bf4hi(cur.xb[0]); x.v[2] = bf4lo(cur.xb[1]); x.v[3] = bf4hi(cur.xb[1]);
                Row4 y;
                y.v[0] = fp8x4(cur.ys[0][0].x); y.v[1] = fp8x4(cur.ys[0][0].y); y.v[2] = fp8x4(cur.ys[0][1].x); y.v[3] = fp8x4(cur.ys[0][1].y);
#pragma unroll
                for (int s = 1; s < 4; ++s) { y.v[0] += fp8x4(cur.ys[s][0].x); y.v[1] += fp8x4(cur.ys[s][0].y); y.v[2] += fp8x4(cur.ys[s][1].x); y.v[3] += fp8x4(cur.ys[s][1].y); }
#pragma unroll
                for (int j = 0; j < 4; ++j) x.v[j] += gt.v[j] * y.v[j];
            }
            const float rstd = rsqrtf(row_ssq(x) * (1.0f / D) + NORM_EPS);
            if (l == DEPTH - 1) { Row4 o;
#pragma unroll
                for (int j = 0; j < 4; ++j) o.v[j] = x.v[j] * rstd * gm.v[j];
                st_row_f32(Xout + (size_t)m * D, lane, o);
            } else {
                if (l >= 0) st_row_bf16(XB + (size_t)m * D, lane, x);
                Row4 h;
#pragma unroll
                for (int j = 0; j < 4; ++j) h.v[j] = (x.v[j] * rstd) * gm.v[j] + shv.v[j];
                if (ln < NA || dummy) st_row_bf16(Hout + (size_t)m * D, lane, h);
                if (!dummy) st_row_fp8((unsigned char*)(F.ws + WS_H8) + (size_t)m * D, lane, h);
                if (l == NA - 1) {
                    const float* kvm = (const float*)(F.ws + WS_KVMOD) + (size_t)b * 2 * D;
                    const Row4 hk = norm_mod(x, rstd, F.in[11], kvm + D, kvm, lane);
                    st_row_fp8((unsigned char*)(F.ws + WS_HK) + (size_t)m * D, lane, hk);
                }
            }
            if (r + 1 < 32) cur = nxt;
        }
    }
}
__device__ __forceinline__ void phase_final_only(const Ctx& F, bool from_input) {
    PHASE_IDS;
    const int gw = F.vcu * NWAVES + wave, NGW = F.G * NWAVES;
    for (int m = gw; m < T; m += NGW) {
        Row4 x = from_input ? ld_row_f32(F.in[0] + (size_t)m * D, lane) : ld_row_bf16((const bf16_t*)(F.ws + WS_XB) + (size_t)m * D, lane);
        const float rstd = rsqrtf(row_ssq(x) * (1.0f / D) + NORM_EPS);
        const Row4 gv = ld_row_f32(F.in[27], lane); Row4 o;
#pragma unroll
        for (int j = 0; j < 4; ++j) o.v[j] = x.v[j] * rstd * gv.v[j];
        st_row_f32(F.out + (size_t)m * D, lane, o);
    }
}

__device__ __forceinline__ void phase_hgrn_gate(const Ctx& F, int l) {
    PHASE_IDS;
    const int gw = F.vcu * NWAVES + wave, NGW = F.G * NWAVES;
    const bf16_t* OO = (const bf16_t*)(F.ws + WS_OO); const bf16_t* GS = (const bf16_t*)(F.ws + WS_GS); unsigned char* OG = (unsigned char*)(F.ws + WS_OG);
    f32x4 gv[2]; { const float* g = F.in[9] + (size_t)l * HGD + 8 * (lane & 15); gv[0] = *(const f32x4*)g; gv[1] = *(const f32x4*)(g + 4); }
    for (int ch = gw; ch < T / 32; ch += NGW) {
        const u32x4* oq = (const u32x4*)(OO + (size_t)ch * 32 * D) + lane; const u32x4* gq = (const u32x4*)(GS + (size_t)ch * 32 * D) + lane;
        u32x4 co0 = oq[0], co1 = oq[64], cg0 = gq[0], cg1 = gq[64];
        for (int i = 0; i < 32; ++i) {
            u32x4 no0 = co0, no1 = co1, ng0 = cg0, ng1 = cg1;
            if (i + 1 < 32) { no0 = oq[(size_t)(i + 1) * 128]; no1 = oq[(size_t)(i + 1) * 128 + 64]; ng0 = gq[(size_t)(i + 1) * 128]; ng1 = gq[(size_t)(i + 1) * 128 + 64]; }
            Row4 o, g, r; o.v[0] = bf4lo(co0); o.v[1] = bf4hi(co0); o.v[2] = bf4lo(co1); o.v[3] = bf4hi(co1); g.v[0] = bf4lo(cg0); g.v[1] = bf4hi(cg0); g.v[2] = bf4lo(cg1); g.v[3] = bf4hi(cg1);
#pragma unroll
            for (int jh = 0; jh < 2; ++jh) {
                const f32x4 a = o.v[2 * jh], b2 = o.v[2 * jh + 1];
                float s = ((a[0] * a[0] + a[1] * a[1]) + (a[2] * a[2] + a[3] * a[3])) + ((b2[0] * b2[0] + b2[1] * b2[1]) + (b2[2] * b2[2] + b2[3] * b2[3]));
#pragma unroll
                for (int d = 1; d < 16; d <<= 1) s += __shfl_xor(s, d);
                const float rstd = rsqrtf(s * (1.0f / HGD) + NORM_EPS);
                r.v[2 * jh] = (a * rstd * gv[0]) * g.v[2 * jh]; r.v[2 * jh + 1] = (b2 * rstd * gv[1]) * g.v[2 * jh + 1];
            }
            st_row_fp8(OG + ((size_t)ch * 32 + i) * D, lane, r);
            co0 = no0; co1 = no1; cg0 = ng0; cg1 = ng1;
        }
    }
}

__device__ __forceinline__ void phase_kv_rows(const Ctx& F) {
    PHASE_IDS;
    const int gw = F.vcu * NWAVES + wave, NGW = F.G * NWAVES;
    const bf16_t* CKR = (const bf16_t*)(F.ws + WS_CKR); bf16_t* CKV = (bf16_t*)(F.ws + WS_CKV); bf16_t* KB = (bf16_t*)(F.ws + WS_KB);
    const float* rope = (const float*)(F.ws + WS_ROPE);
    const f32x4 gv = *(const f32x4*)(F.in[15] + 4 * lane);
    for (int ch = gw; ch < T / 32; ch += NGW) {
        const int i = lane & 31, hb = (lane >> 5) * 4;
        const bf16_t* rp0 = CKR + (size_t)ch * 32 * 512;
        u32x2 cw = *((const u32x2*)rp0 + lane); unsigned short c1 = rp0[KVRANK + i], c2 = rp0[KVRANK + 32 + i];
        for (int r = 0; r < 32; ++r) {
            const int m = ch * 32 + r; const bf16_t* rpn = rp0 + (size_t)(r + 1) * 512;
            u32x2 nw = cw; unsigned short n1 = c1, n2 = c2;
            if (r + 1 < 32) { nw = *((const u32x2*)rpn + lane); n1 = rpn[KVRANK + i]; n2 = rpn[KVRANK + 32 + i]; }
            const float cs = rope[(size_t)m * 64 + i], sn = rope[(size_t)m * 64 + 32 + i];
            f32x4 v = (f32x4){bflo(cw.x), bfhi(cw.x), bflo(cw.y), bfhi(cw.y)};
            const float ss = wave_sum((v[0] * v[0] + v[1] * v[1]) + (v[2] * v[2] + v[3] * v[3]));
            const float rstd = rsqrtf(ss * (1.0f / KVRANK) + NORM_EPS);
            v = v * rstd * gv;
            u32x2 o; o.x = cvt_pk_bf16(v[0], v[1]); o.y = cvt_pk_bf16(v[2], v[3]);
            *((u32x2*)(CKV + (size_t)m * KVRANK) + lane) = o;
            const float t1 = bf2f(c1), t2 = bf2f(c2);
            const float r1 = t1 * cs - t2 * sn, r2 = t2 * cs + t1 * sn;
            const unsigned short b1 = f2bf(r1), b2 = f2bf(r2);
#pragma unroll
            for (int h = 0; h < 4; ++h) { bf16_t* kp = KB + (size_t)m * (MH * QK) + (hb + h) * QK + NOPE; kp[i] = b1; kp[32 + i] = b2; }
            cw = nw; c1 = n1; c2 = n2;
        }
    }
}

__device__ __forceinline__ void phase_cq_rows(const Ctx& F, int j) {
    PHASE_IDS;
    const int gw = F.vcu * NWAVES + wave, NGW = F.G * NWAVES;
    const bf16_t* CQ = (const bf16_t*)(F.ws + WS_CQ); bf16_t* CQN = (bf16_t*)(F.ws + WS_CQN);
    const float* g = F.in[18] + (size_t)j * QRANK;
    float gq[3][2];
#pragma unroll
    for (int q = 0; q < 3; ++q) { gq[q][0] = g[128 * q + 2 * lane]; gq[q][1] = g[128 * q + 2 * lane + 1]; }
    for (int ch = gw; ch < T / 32; ch += NGW) {
        const unsigned* rp0 = (const unsigned*)(CQ + (size_t)ch * 32 * 512);
        unsigned cwv[3];
#pragma unroll
        for (int q = 0; q < 3; ++q) cwv[q] = rp0[64 * q + lane];
        for (int r = 0; r < 32; ++r) {
            const int m = ch * 32 + r; unsigned nwv[3];
#pragma unroll
            for (int q = 0; q < 3; ++q) nwv[q] = (r + 1 < 32) ? rp0[(size_t)(r + 1) * 256 + 64 * q + lane] : cwv[q];
            float v[3][2]; float s = 0.f;
#pragma unroll
            for (int q = 0; q < 3; ++q) { v[q][0] = bflo(cwv[q]); v[q][1] = bfhi(cwv[q]); s += v[q][0] * v[q][0] + v[q][1] * v[q][1]; }
            const float rstd = rsqrtf(wave_sum(s) * (1.0f / QRANK) + NORM_EPS);
            unsigned* op = (unsigned*)(CQN + (size_t)m * QRANK);
#pragma unroll
            for (int q = 0; q < 3; ++q) op[64 * q + lane] = cvt_pk_bf16(v[q][0] * rstd * gq[q][0], v[q][1] * rstd * gq[q][1]);
#pragma unroll
            for (int q = 0; q < 3; ++q) cwv[q] = nwv[q];
        }
    }
}
__device__ __forceinline__ void phase_router(const Ctx& F, int l, bool dummy = false) {
    PHASE_IDS;
    constexpr int RT0 = LDS_BLKE + NBLK_MAX * 4;
    LAS float* gmt = (LAS float*)(F.lds + RT0);
    LAS float* sht = (LAS float*)(F.lds + RT0 + 4096);
    LAS float* rst = (LAS float*)(F.lds + RT0 + 8192) + wave * 32;
    LAS int* hist = (LAS int*)(F.lds + RT0 + 9216);
    LAS int* basev = (LAS int*)(F.lds + RT0 + 9216 + 128);
    static_assert(RT0 + 9216 + 256 <= LDS_BYTES, "router LDS map");
    LAS float* lgt = (LAS float*)(F.lds) + wave * (32 * 33);
    const unsigned char* Wr = F.ws + WS_WR + (size_t)l * 131072; const float* br = F.in[22] + (size_t)l * NE;
    const bf16_t* X = (const bf16_t*)(F.ws + WS_XB); unsigned char* H = (unsigned char*)(F.ws + (dummy ? WS_ACT : WS_H));
    int* TKE = (int*)(F.ws + (dummy ? WS_YS : WS_TKE)); float* TKW = (float*)(F.ws + (dummy ? WS_YS + 4 * MiB : WS_TKW)); int* TKR = (int*)(F.ws + (dummy ? WS_YS + 8 * MiB : WS_TKR));
    unsigned* cnt = F.ctl() + CW_CNT + l * 64 + (dummy ? 1024 : 0);
    const int r32 = lane & 31, hi = lane >> 5;
    for (int bt = F.vcu; bt < T / 256; bt += F.G) {
        const int b = (bt * 256) / SEQ;
        const float* g = F.in[4] + (size_t)l * D; const float* sc = modp(F, l, b, 4); const float* sh = modp(F, l, b, 3);
        for (int i = tid; i < D; i += NTHREADS) { gmt[i] = g[i] * (1.0f + sc[i]); sht[i] = sh[i]; }
        if (tid < 32) hist[tid] = 0;
        for (int i = tid; i < 131072 / 16; i += NTHREADS) *(LAS u32x4*)(F.lds + 16 * i) = *(const u32x4*)(Wr + 16 * i);
        __syncthreads();
        const int row0 = bt * 256 + wave * 32;
        { const u32x4* xq = (const u32x4*)(X + (size_t)row0 * D) + lane;
          u32x4 c0 = xq[0], c1 = xq[64];
          for (int i = 0; i < 32; ++i) {
            u32x4 n0 = c0, n1 = c1;
            if (i + 1 < 32) { n0 = xq[(size_t)(i + 1) * 128]; n1 = xq[(size_t)(i + 1) * 128 + 64]; }
            Row4 x; x.v[0] = bf4lo(c0); x.v[1] = bf4hi(c0); x.v[2] = bf4lo(c1); x.v[3] = bf4hi(c1);
            const float rstd = rsqrtf(row_ssq(x) * (1.0f / D) + NORM_EPS);
            Row4 h;
#pragma unroll
            for (int j = 0; j < 4; ++j) { const int cc = row4_col(lane, j); const f32x4 gm = *(const LAS f32x4*)(gmt + cc), s4 = *(const LAS f32x4*)(sht + cc); h.v[j] = x.v[j] * rstd * gm + s4; }
            st_row_fp8(H + (size_t)(row0 + i) * D, lane, h);
            if (lane == 0) rst[i] = rstd;
            c0 = n0; c1 = n1;
          } }
        LDS_WAIT(); asm volatile("" ::: "memory");
        f32x16 acc = {};
        { const float rstd = rst[r32]; const bf16_t* xr = X + (size_t)(row0 + r32) * D + 8 * hi; const LAS unsigned char* wb = F.lds + r32 * 2048; const int sw = r32 & 15;
#pragma unroll 2
          for (int j = 0; j < 64; ++j) {
              const u32x4 xw = *(const u32x4*)(xr + 16 * j);
              const f32x4 gm0 = *(const LAS f32x4*)(gmt + 16 * j + 8 * hi), gm1 = *(const LAS f32x4*)(gmt + 16 * j + 8 * hi + 4), s40 = *(const LAS f32x4*)(sht + 16 * j + 8 * hi), s41 = *(const LAS f32x4*)(sht + 16 * j + 8 * hi + 4);
              const f32x4 h0 = bf4lo(xw) * rstd * gm0 + s40, h1 = bf4hi(xw) * rstd * gm1 + s41;
              const int off = 16 * ((2 * j + hi) ^ sw);
              const bf16x8 bh = *(const LAS bf16x8*)(wb + off), bl = *(const LAS bf16x8*)(wb + 65536 + off);
              u32x4 ah, al;
              ah[0] = cvt_pk_bf16(h0[0], h0[1]); ah[1] = cvt_pk_bf16(h0[2], h0[3]); ah[2] = cvt_pk_bf16(h1[0], h1[1]); ah[3] = cvt_pk_bf16(h1[2], h1[3]);
              al[0] = cvt_pk_bf16(h0[0] - __uint_as_float(ah[0] << 16), h0[1] - __uint_as_float(ah[0] & 0xffff0000u)); al[1] = cvt_pk_bf16(h0[2] - __uint_as_float(ah[1] << 16), h0[3] - __uint_as_float(ah[1] & 0xffff0000u));
              al[2] = cvt_pk_bf16(h1[0] - __uint_as_float(ah[2] << 16), h1[1] - __uint_as_float(ah[2] & 0xffff0000u)); al[3] = cvt_pk_bf16(h1[2] - __uint_as_float(ah[3] << 16), h1[3] - __uint_as_float(ah[3] & 0xffff0000u));
              const bf16x8 ahv = __builtin_bit_cast(bf16x8, ah), alv = __builtin_bit_cast(bf16x8, al);
              acc = __builtin_amdgcn_mfma_f32_32x32x16_bf16(ahv, bh, acc, 0, 0, 0);
              acc = __builtin_amdgcn_mfma_f32_32x32x16_bf16(ahv, bl, acc, 0, 0, 0);
              acc = __builtin_amdgcn_mfma_f32_32x32x16_bf16(alv, bh, acc, 0, 0, 0);
          } }
        __syncthreads();
        { const float bias = br[r32];
#pragma unroll
          for (int r = 0; r < 16; ++r) lgt[((r & 3) + 8 * (r >> 2) + 4 * hi) * 33 + r32] = acc[r] + bias; }
        LDS_WAIT(); asm volatile("" ::: "memory");
        int te[4]; float tw[4]; int tr[4];
        if (lane < 32) {
            float v[32];
#pragma unroll
            for (int e = 0; e < 32; ++e) v[e] = lgt[lane * 33 + e];
            float tv[4];
#pragma unroll
            for (int k = 0; k < 4; ++k) { float best = v[0]; int bi = 0;
#pragma unroll
                for (int e = 1; e < 32; ++e) { if (v[e] > best) { best = v[e]; bi = e; } }
                tv[k] = best; te[k] = bi;
#pragma unroll
                for (int e = 0; e < 32; ++e) v[e] = (e == bi) ? -3.0e38f : v[e]; }
            const float e1 = __expf(tv[1] - tv[0]), e2 = __expf(tv[2] - tv[0]), e3 = __expf(tv[3] - tv[0]);
            const float inv = 1.0f / (1.0f + e1 + e2 + e3);
            tw[0] = inv; tw[1] = e1 * inv; tw[2] = e2 * inv; tw[3] = e3 * inv;
#pragma unroll
            for (int k = 0; k < 4; ++k) tr[k] = __hip_atomic_fetch_add(hist + te[k], 1, __ATOMIC_RELAXED, __HIP_MEMORY_SCOPE_WORKGROUP);
        }
        __syncthreads();
        if (tid < 32) basev[tid] = (int)__hip_atomic_fetch_add(cnt + tid, (unsigned)hist[tid], RLX_AGENT);
        __syncthreads();
        if (lane < 32) {
            const int row = row0 + lane;
            int4 ev = make_int4(te[0], te[1], te[2], te[3]); *(int4*)(TKE + (size_t)row * 4) = ev;
            *(f32x4*)(TKW + (size_t)row * 4) = (f32x4){tw[0], tw[1], tw[2], tw[3]};
            int4 rv = make_int4(basev[te[0]] + tr[0], basev[te[1]] + tr[1], basev[te[2]] + tr[2], basev[te[3]] + tr[3]); *(int4*)(TKR + (size_t)row * 4) = rv;
            if (!dummy) { int* RI = (int*)(F.ws + WS_RINFO); float* RW = (float*)(F.ws + WS_RW);
                RI[(size_t)te[0] * VCAP + rv.x] = row * 4 + 0; RI[(size_t)te[1] * VCAP + rv.y] = row * 4 + 1; RI[(size_t)te[2] * VCAP + rv.z] = row * 4 + 2; RI[(size_t)te[3] * VCAP + rv.w] = row * 4 + 3;
                RW[(size_t)te[0] * VCAP + rv.x] = tw[0]; RW[(size_t)te[1] * VCAP + rv.y] = tw[1]; RW[(size_t)te[2] * VCAP + rv.z] = tw[2]; RW[(size_t)te[3] * VCAP + rv.w] = tw[3]; }
        }
        __syncthreads();
    }
}

__device__ __forceinline__ void moe_table(const Ctx& F, int l) {
    PHASE_IDS;
    LAS int* tab = (LAS int*)(F.lds + LDS_TAB);
    if (tid < 32) tab[64 + tid] = (int)__hip_atomic_load(F.ctl() + CW_CNT + l * 64 + tid, RLX_AGENT);
    __syncthreads();
    if (tid == 0) { int s = 0;
        for (int e = 0; e < 32; ++e) { tab[e] = s; s += (tab[64 + e] + MOEB - 1) / MOEB; }
        tab[32] = s; }
    __syncthreads();
    { LAS int* blke = (LAS int*)(F.lds + LDS_BLKE);
      for (int rb = tid; rb < tab[32]; rb += NTHREADS) { int e = 0;
#pragma unroll
          for (int j = 1; j < 32; ++j) e += (tab[j] <= rb) ? 1 : 0;
          blke[rb] = e; } }
    __syncthreads();
}
namespace scan {
constexpr int RS_K = 272, RS_S = 144;
constexpr int O_QT = 0, O_KT = 17408, O_QH = 34816, O_KHT = 52224, O_VT = 70656, O_SS = 79872, O_ST0 = 89088, O_ST1 = 106496, O_SEG = 123904, O_DEC = 125952;
__device__ __forceinline__ bf16x8 ldfrag(const LAS unsigned char* base, int row, int rs, int kb  ) { return *(const LAS bf16x8*)(base + row * rs + kb); }
}
__device__ __forceinline__ void phase_hgrn_scan(const Ctx& F) {
    PHASE_IDS;
    using namespace scan;
    LAS unsigned char* L = F.lds;
    const bf16_t* QH_g = (const bf16_t*)(F.ws + WS_QH); const bf16_t* KK_g = (const bf16_t*)(F.ws + WS_KK); const bf16_t* VV_g = (const bf16_t*)(F.ws + WS_VV);
    const unsigned short* LF_g = (const unsigned short*)(F.ws + WS_LF)  ; bf16_t* OO_g = (bf16_t*)(F.ws + WS_OO);
    const int w = wave, l15 = lane & 15, l4 = lane >> 4;
    const int cg = lane & 3, seg = lane >> 2, kc0 = 16 * w + 4 * cg;
    LAS float* DEC = (LAS float*)(L + O_DEC);
    for (int u = F.vcu; u < NB * HGH * 2; u += F.G) {
        const int vh = u & 1, h = (u >> 1) & 7, b = u >> 4;
        const size_t rowb = (size_t)b * SEQ; const int hk = h * HGD, hv = h * HGD + vh * 64;
        for (int i = tid; i < 64 * RS_K / 16; i += NTHREADS) *(LAS u32x4*)(L + O_ST0 + i * 16) = (u32x4){0u, 0u, 0u, 0u};
        f32x4 sacc[4];
#pragma unroll
        for (int vi = 0; vi < 4; ++vi) sacc[vi] = (f32x4){0.f, 0.f, 0.f, 0.f};
        u32x2 lfr[4]; u32x2 qr[4], kr[4]; u32x4 vw;
#define SCAN_LOAD_LF(c_) do { const size_t base_ = ((size_t)(((b * 64 + (c_)) * 8 + h) * 8 + w)) * 1024 + 4 * lane; \
            _Pragma("unroll") for (int i = 0; i < 4; ++i) lfr[i] = *(const u32x2*)(LF_g + base_ + i * 256); } while (0)
#define SCAN_LOAD_QK(c_) do { const size_t base_ = ((size_t)(((b * 64 + (c_)) * 8 + h) * 8 + w)) * 1024 + 4 * lane; \
            _Pragma("unroll") for (int i = 0; i < 4; ++i) { qr[i] = *(const u32x2*)(QH_g + base_ + i * 256); kr[i] = *(const u32x2*)(KK_g + base_ + i * 256); } } while (0)
#define SCAN_LOAD_V(c_) do { vw = *(const u32x4*)(VV_g + ((size_t)(((b * 64 + (c_)) * 8 + h) * 16 + vh * 8 + w)) * 512 + 8 * lane); } while (0)
#define SCAN_LOAD(c_) do { SCAN_LOAD_LF(c_); SCAN_LOAD_QK(c_); SCAN_LOAD_V(c_); } while (0)
        SCAN_LOAD(0);
        __syncthreads();
#ifdef MK_SCAN_PROBE
#define SP_STAMP(k_) do { if (blockIdx.x == 0 && threadIdx.x == 0) { const unsigned t_ = (unsigned)__builtin_amdgcn_s_memrealtime(); if ((k_) == MK_SCAN_PROBE) *(volatile LAS unsigned*)(F.lds + 147440) += t_ - sp_prev; sp_prev = t_; } } while (0)
        unsigned sp_prev = 0;
#else
#define SP_STAMP(k_) do { } while (0)
#endif
        for (int c = 0; c < SEQ / HGC; ++c) {
            SP_STAMP(0);
            const size_t r0 = rowb + (size_t)c * HGC;
            const LAS unsigned char* STc = L + ((c & 1) ? O_ST1 : O_ST0); LAS unsigned char* STn = L + ((c & 1) ? O_ST0 : O_ST1);
            { float cs[4][4], I[4];
#pragma unroll
              for (int j = 0; j < 4; ++j) { float run = 0.f;
#pragma unroll
                  for (int i = 0; i < 4; ++i) { const unsigned lw_ = (j < 2) ? lfr[i].x : lfr[i].y; run += (j & 1) ? f16hi(lw_) : f16lo(lw_); cs[i][j] = run; }
                  float x = run;
#pragma unroll
                  for (int d = 4; d < 64; d <<= 1) { const float y = __shfl_up(x, d); if (lane >= d) x += y; }
                  I[j] = x; }
              float qv[4][4], kv[4][4];
#pragma unroll
              for (int i = 0; i < 4; ++i) { qv[i][0] = bflo(qr[i].x); qv[i][1] = bfhi(qr[i].x); qv[i][2] = bflo(qr[i].y); qv[i][3] = bfhi(qr[i].y);
                  kv[i][0] = bflo(kr[i].x); kv[i][1] = bfhi(kr[i].x); kv[i][2] = bflo(kr[i].y); kv[i][3] = bfhi(kr[i].y); }
              float qt[4][4], kt[4][4], qh[4][4], kh[4][4];
#pragma unroll
              for (int j = 0; j < 4; ++j) { const float ref = __shfl(I[j], cg + 28), last = __shfl(I[j], cg + 60), P = I[j] - cs[3][j];
                  const float eref = __builtin_amdgcn_exp2f(ref), elr = __builtin_amdgcn_exp2f(last - ref);
                  if (seg == 0) DEC[kc0 + j] = eref * elr;
#pragma unroll
                  for (int i = 0; i < 4; ++i) { const float d = fminf(fmaxf(P + cs[i][j] - ref, -86.56170245f), 86.56170245f); const float E = __builtin_amdgcn_exp2f(d), R = __builtin_amdgcn_rcpf(E);
                      qt[i][j] = qv[i][j] * E; kt[i][j] = kv[i][j] * R; qh[i][j] = qt[i][j] * eref; kh[i][j] = kt[i][j] * elr; } }
#pragma unroll
              for (int i = 0; i < 4; ++i) { const int ro = (4 * seg + i) * RS_K + kc0 * 2; u32x2 o;
                  o.x = cvt_pk_bf16(qt[i][0], qt[i][1]); o.y = cvt_pk_bf16(qt[i][2], qt[i][3]); *(LAS u32x2*)(L + O_QT + ro) = o;
                  o.x = cvt_pk_bf16(kt[i][0], kt[i][1]); o.y = cvt_pk_bf16(kt[i][2], kt[i][3]); *(LAS u32x2*)(L + O_KT + ro) = o;
                  o.x = cvt_pk_bf16(qh[i][0], qh[i][1]); o.y = cvt_pk_bf16(qh[i][2], qh[i][3]); *(LAS u32x2*)(L + O_QH + ro) = o; }
#pragma unroll
              for (int j = 0; j < 4; ++j) { u32x2 o; o.x = cvt_pk_bf16(kh[0][j], kh[1][j]); o.y = cvt_pk_bf16(kh[2][j], kh[3][j]); *(LAS u32x2*)(L + O_KHT + (kc0 + j) * RS_S + seg * 8) = o; }
              LAS unsigned short* vt = (LAS unsigned short*)(L + O_VT + (8 * w) * RS_S) + lane;
              vt[0 * (RS_S / 2)] = (unsigned short)(vw.x & 0xffffu); vt[1 * (RS_S / 2)] = (unsigned short)(vw.x >> 16);
              vt[2 * (RS_S / 2)] = (unsigned short)(vw.y & 0xffffu); vt[3 * (RS_S / 2)] = (unsigned short)(vw.y >> 16);
              vt[4 * (RS_S / 2)] = (unsigned short)(vw.z & 0xffffu); vt[5 * (RS_S / 2)] = (unsigned short)(vw.z >> 16);
              vt[6 * (RS_S / 2)] = (unsigned short)(vw.w & 0xffffu); vt[7 * (RS_S / 2)] = (unsigned short)(vw.w >> 16); }
            SP_STAMP(1);
            __syncthreads();
            SP_STAMP(2);
            if (c + 1 < SEQ / HGC) SCAN_LOAD_LF(c + 1);
#pragma unroll
            for (int q = 0; q < 2; ++q) { const int id = 2 * w + q, si = id >> 2, ti = id & 3;
                f32x4 a = (f32x4){0.f, 0.f, 0.f, 0.f};
                if (si <= ti) {
#pragma unroll
                    for (int ks = 0; ks < 4; ++ks) a = __builtin_amdgcn_mfma_f32_16x16x32_bf16(ldfrag(L + O_KT, si * 16 + l15, RS_K, ks * 64 + l4 * 16), ldfrag(L + O_QT, ti * 16 + l15, RS_K, ks * 64 + l4 * 16), a, 0, 0, 0);
                }
                const int t = ti * 16 + l15, s0 = si * 16 + l4 * 4;
#pragma unroll
                for (int r = 0; r < 4; ++r) a[r] = (s0 + r <= t) ? a[r] : 0.f;
                u32x2 o; o.x = cvt_pk_bf16(a[0], a[1]); o.y = cvt_pk_bf16(a[2], a[3]);
                *(LAS u32x2*)(L + O_SS + t * RS_S + s0 * 2) = o; }
            __syncthreads();
            SP_STAMP(3);
            if (c + 1 < SEQ / HGC) SCAN_LOAD_QK(c + 1);
#pragma unroll
            for (int q = 0; q < 2; ++q) { const int id = 2 * w + q, vi = id >> 2, ti = id & 3;
                f32x4 a = (f32x4){0.f, 0.f, 0.f, 0.f};
#pragma unroll
                for (int ks = 0; ks < 2; ++ks) a = __builtin_amdgcn_mfma_f32_16x16x32_bf16(ldfrag(L + O_VT, vi * 16 + l15, RS_S, ks * 64 + l4 * 16), ldfrag(L + O_SS, ti * 16 + l15, RS_S, ks * 64 + l4 * 16), a, 0, 0, 0);
#pragma unroll
                for (int ks = 0; ks < 4; ++ks) a = __builtin_amdgcn_mfma_f32_16x16x32_bf16(ldfrag(STc, vi * 16 + l15, RS_K, ks * 64 + l4 * 16), ldfrag(L + O_QH, ti * 16 + l15, RS_K, ks * 64 + l4 * 16), a, 0, 0, 0);
                const int t = ti * 16 + l15, v0 = vi * 16 + l4 * 4;
                u32x2 o; o.x = cvt_pk_bf16(a[0], a[1]); o.y = cvt_pk_bf16(a[2], a[3]);
                *(u32x2*)(OO_g + (r0 + t) * D + hv + v0) = o; }
            if (c + 1 < SEQ / HGC) SCAN_LOAD_V(c + 1);
            { const f32x4 dec = *(const LAS f32x4*)(DEC + w * 16 + l4 * 4);
              const bf16x8 ka0 = ldfrag(L + O_KHT, w * 16 + l15, RS_S, l4 * 16), ka1 = ldfrag(L + O_KHT, w * 16 + l15, RS_S, 64 + l4 * 16);
#pragma unroll
              for (int vi = 0; vi < 4; ++vi) { f32x4 a = sacc[vi] * dec;
                  a = __builtin_amdgcn_mfma_f32_16x16x32_bf16(ka0, ldfrag(L + O_VT, vi * 16 + l15, RS_S, l4 * 16), a, 0, 0, 0);
                  a = __builtin_amdgcn_mfma_f32_16x16x32_bf16(ka1, ldfrag(L + O_VT, vi * 16 + l15, RS_S, 64 + l4 * 16), a, 0, 0, 0);
                  sacc[vi] = a;
                  u32x2 o; o.x = cvt_pk_bf16(a[0], a[1]); o.y = cvt_pk_bf16(a[2], a[3]);
                  *(LAS u32x2*)(STn + (vi * 16 + l15) * RS_K + (w * 16 + l4 * 4) * 2) = o; } }
            SP_STAMP(4);
            __syncthreads();
            SP_STAMP(5);
        }
#undef SCAN_LOAD
#undef SCAN_LOAD_LF
#undef SCAN_LOAD_QK
#undef SCAN_LOAD_V
    }
}
namespace mla {
constexpr int QBLK = 32, KVBLK = 64, QB = 256;
constexpr int SHM_V = KVBLK * VD * 2  , SHM_K = KVBLK * QK * 2  ;
constexpr int O_V = 0, O_K = 2 * SHM_V, O_WS = 2 * SHM_V + 2 * SHM_K;
constexpr float SCALE = 0.07216878364870322f;
#define KSWZ192(row, colB) ((row) * 384 + ((colB) ^ (((row) & 7) << 4)))
#define SBAR() __builtin_amdgcn_sched_barrier(0)
__device__ __forceinline__ int v_st(int k, int c) { const int kk = (k & ~0xC) | ((k & 4) << 1) | ((k & 8) >> 1); return ((kk >> 3) * 4 + (c >> 5)) * 512 + ((kk & 7) * 32 + (c & 31)) * 2; }
__device__ __forceinline__ int v_rd_base(int lane) { return ((lane & 3) << 3) | (((lane >> 2) & 3) << 6) | (((lane >> 4) & 1) << 5) | (((lane >> 5) & 1) << 8); }
constexpr int v_rd_off(int d0, int ks, int half) { return d0 * 512 + ks * 4096 + half * 2048; }
__device__ __forceinline__ int crow(int r, int hi) { return (r & 3) + 8 * (r >> 2) + 4 * hi; }
__device__ __forceinline__ void mask_tile(f32x16& p0, f32x16& p1, int dq) {
    const float NEG = -__builtin_inff();
#pragma unroll
    for (int r = 0; r < 16; ++r) { const int c = (r & 3) + 8 * (r >> 2); if (dq - c < 0) p0[r] = NEG; if (dq - c - 32 < 0) p1[r] = NEG; }
}
__device__ __forceinline__ void partialSM(f32x16& p0, f32x16& p1, float& m_reg, float& mn, float& alpha) {
    float pmax = p0[0];
#pragma unroll
    for (int r = 1; r < 16; ++r) pmax = fmaxf(pmax, p0[r]);
#pragma unroll
    for (int r = 0; r < 16; ++r) pmax = fmaxf(pmax, p1[r]);
    { auto rr = __builtin_amdgcn_permlane32_swap(__float_as_uint(pmax), __float_as_uint(pmax), false, false);
      pmax = fmaxf(__uint_as_float(rr[0]), __uint_as_float(rr[1])); }
    constexpr float C2 = 1.4426950408889634f * SCALE;
    constexpr float THR = 8.f;
    if (__builtin_expect(__all((pmax - m_reg) * SCALE <= THR), 1)) { mn = m_reg; alpha = 1.f; }
    else { mn = fmaxf(m_reg, pmax); alpha = __builtin_amdgcn_exp2f((m_reg - mn) * C2); m_reg = mn; }
    const float mnL = -mn * C2;
#pragma unroll
    for (int r = 0; r < 16; ++r) p0[r] = fmaf(p0[r], C2, mnL);
#pragma unroll
    for (int r = 0; r < 16; ++r) p1[r] = fmaf(p1[r], C2, mnL);
#pragma unroll
    for (int r = 0; r < 16; ++r) p0[r] = __builtin_amdgcn_exp2f(p0[r]);
}
__device__ __forceinline__ void finishSM(f32x16& p0, f32x16& p1, float alpha, float& l_reg, bf16x8& pa0, bf16x8& pa1, bf16x8& pa2, bf16x8& pa3) {
#pragma unroll
    for (int r = 0; r < 16; ++r) p1[r] = __builtin_amdgcn_exp2f(p1[r]);
    float ps = 0;
#pragma unroll
    for (int r = 0; r < 16; ++r) ps += p0[r];
#pragma unroll
    for (int r = 0; r < 16; ++r) ps += p1[r];
    { auto rr = __builtin_amdgcn_permlane32_swap(__float_as_uint(ps), __float_as_uint(ps), false, false);
      ps = __uint_as_float(rr[0]) + __uint_as_float(rr[1]); }
    l_reg = l_reg * alpha + ps;
#define PK4(P, B_, OUT) do { unsigned a0 = cvt_pk_bf16(P[B_+0], P[B_+1]), a1 = cvt_pk_bf16(P[B_+2], P[B_+3]);                          \
        unsigned b0 = cvt_pk_bf16(P[B_+4], P[B_+5]), b1 = cvt_pk_bf16(P[B_+6], P[B_+7]);                                             \
        auto r0 = __builtin_amdgcn_permlane32_swap(a0, b0, false, false); auto r1 = __builtin_amdgcn_permlane32_swap(a1, b1, false, false); \
        u32x4 w = {r0[0], r1[0], r0[1], r1[1]}; OUT = *reinterpret_cast<bf16x8*>(&w); } while (0)
    PK4(p0, 0, pa0); PK4(p0, 8, pa1); PK4(p1, 0, pa2); PK4(p1, 8, pa3);
#undef PK4
}
template <int KB>
__device__ __forceinline__ void qkt(f32x16& p0, f32x16& p1, const LAS unsigned char* K_lds, int r32, int hi, const bf16x8* qr) {
    p0 = f32x16{}; p1 = f32x16{};
    const LAS unsigned char* kb[4];
#pragma unroll
    for (int dd = 0; dd < 4; ++dd) kb[dd] = K_lds + KB * SHM_K + KSWZ192(r32, (dd * 16 + hi * 8) * 2);
#pragma unroll
    for (int g = 0; g < 3; ++g) {
        bf16x8 b0[4], b1[4];
#pragma unroll
        for (int dd = 0; dd < 4; ++dd) { const LAS unsigned char* a = kb[dd] + g * 128;
            b0[dd] = *reinterpret_cast<const LAS bf16x8*>(a); b1[dd] = *reinterpret_cast<const LAS bf16x8*>(a + 32 * 384); }
#pragma unroll
        for (int dd = 0; dd < 4; ++dd) {
            p0 = __builtin_amdgcn_mfma_f32_32x32x16_bf16(b0[dd], qr[4 * g + dd], p0, 0, 0, 0);
            p1 = __builtin_amdgcn_mfma_f32_32x32x16_bf16(b1[dd], qr[4 * g + dd], p1, 0, 0, 0); }
        SBAR();
    }
}
template <int KB>
__device__ __forceinline__ void qkt_sm(f32x16& n0, f32x16& n1, const LAS unsigned char* K_lds, int r32, int hi, const bf16x8* qr,
                                       f32x16& p0, f32x16& p1, float& m_reg, float& alpha, float& l_reg, bf16x8& pa0, bf16x8& pa1, bf16x8& pa2, bf16x8& pa3) {
    n0 = f32x16{}; n1 = f32x16{};
    const LAS unsigned char* kb[4];
#pragma unroll
    for (int dd = 0; dd < 4; ++dd) kb[dd] = K_lds + KB * SHM_K + KSWZ192(r32, (dd * 16 + hi * 8) * 2);
    SBAR();
    float pmax = p0[0];
#pragma unroll
    for (int r = 1; r < 16; ++r) pmax = fmaxf(pmax, p0[r]);
#pragma unroll
    for (int r = 0; r < 16; ++r) pmax = fmaxf(pmax, p1[r]);
    { auto rr = __builtin_amdgcn_permlane32_swap(__float_as_uint(pmax), __float_as_uint(pmax), false, false);
      pmax = fmaxf(__uint_as_float(rr[0]), __uint_as_float(rr[1])); }
    constexpr float C2 = 1.4426950408889634f * SCALE;
    constexpr float THR = 8.f;
    const bool keep = __all((pmax - m_reg) * SCALE <= THR);
    const float mn = keep ? m_reg : fmaxf(m_reg, pmax);
    alpha = __builtin_amdgcn_exp2f((m_reg - mn) * C2);
    m_reg = mn;
    const float mnL = -mn * C2;
#pragma unroll
    for (int r = 0; r < 16; ++r) { p0[r] = __builtin_amdgcn_exp2f(fmaf(p0[r], C2, mnL)); p1[r] = __builtin_amdgcn_exp2f(fmaf(p1[r], C2, mnL)); }
    float ps = 0;
#pragma unroll
    for (int r = 0; r < 16; ++r) ps += p0[r] + p1[r];
    { auto rr = __builtin_amdgcn_permlane32_swap(__float_as_uint(ps), __float_as_uint(ps), false, false);
      ps = __uint_as_float(rr[0]) + __uint_as_float(rr[1]); }
    l_reg = l_reg * alpha + ps;
#define PK4(P, B_, OUT) do { unsigned a0 = cvt_pk_bf16(P[B_+0], P[B_+1]), a1 = cvt_pk_bf16(P[B_+2], P[B_+3]);                          \
        unsigned b0 = cvt_pk_bf16(P[B_+4], P[B_+5]), b1 = cvt_pk_bf16(P[B_+6], P[B_+7]);                                             \
        auto r0 = __builtin_amdgcn_permlane32_swap(a0, b0, false, false); auto r1 = __builtin_amdgcn_permlane32_swap(a1, b1, false, false); \
        u32x4 w = {r0[0], r1[0], r0[1], r1[1]}; OUT = *reinterpret_cast<bf16x8*>(&w); } while (0)
    PK4(p0, 0, pa0); PK4(p0, 8, pa1); PK4(p1, 0, pa2); PK4(p1, 8, pa3);
#undef PK4
#pragma unroll
    for (int g = 0; g < 3; ++g) {
#pragma unroll
        for (int hh = 0; hh < 2; ++hh) {
            bf16x8 bq[4];
#pragma unroll
            for (int dd = 0; dd < 4; ++dd) bq[dd] = *reinterpret_cast<const LAS bf16x8*>(kb[dd] + g * 128 + hh * (32 * 384));
#pragma unroll
            for (int dd = 0; dd < 4; ++dd) { if (hh == 0) n0 = __builtin_amdgcn_mfma_f32_32x32x16_bf16(bq[dd], qr[4 * g + dd], n0, 0, 0, 0);
                                             else n1 = __builtin_amdgcn_mfma_f32_32x32x16_bf16(bq[dd], qr[4 * g + dd], n1, 0, 0, 0); } } }
#pragma unroll
    for (int g = 0; g < 6; ++g) {
        __builtin_amdgcn_sched_group_barrier(0x100, 4, 0);
        __builtin_amdgcn_sched_group_barrier(0x402, 8, 0);
#pragma unroll
        for (int i = 0; i < 4; ++i) { __builtin_amdgcn_sched_group_barrier(0x008, 1, 0); __builtin_amdgcn_sched_group_barrier(0x402, 6, 0); }
    }
    SBAR();
}
template <int VB>
__device__ __forceinline__ void pv_tile(f32x16* o, int vb0, bf16x8 pa0, bf16x8 pa1, bf16x8 pa2, bf16x8 pa3) {
#define TRRD(dst, off) asm volatile("ds_read_b64_tr_b16 %0, %1 offset:%2" : "=&v"(dst) : "v"(vb0), "i"(off) : "memory")
#define PV_D0(d0) do { s16x4 l0, l1, l2, l3, h0, h1, h2, h3; constexpr int b_ = VB * SHM_V + v_rd_off(d0, 0, 0); \
        TRRD(l0, b_); TRRD(h0, b_ + 2048); TRRD(l1, b_ + 4096); TRRD(h1, b_ + 6144); TRRD(l2, b_ + 8192); TRRD(h2, b_ + 10240); TRRD(l3, b_ + 12288); TRRD(h3, b_ + 14336); \
        asm volatile("s_waitcnt lgkmcnt(0)" ::: "memory"); SBAR(); \
        o[d0] = __builtin_amdgcn_mfma_f32_32x32x16_bf16(pa0, (bf16x8){l0[0], l0[1], l0[2], l0[3], h0[0], h0[1], h0[2], h0[3]}, o[d0], 0, 0, 0);   \
        o[d0] = __builtin_amdgcn_mfma_f32_32x32x16_bf16(pa1, (bf16x8){l1[0], l1[1], l1[2], l1[3], h1[0], h1[1], h1[2], h1[3]}, o[d0], 0, 0, 0);   \
        o[d0] = __builtin_amdgcn_mfma_f32_32x32x16_bf16(pa2, (bf16x8){l2[0], l2[1], l2[2], l2[3], h2[0], h2[1], h2[2], h2[3]}, o[d0], 0, 0, 0);   \
        o[d0] = __builtin_amdgcn_mfma_f32_32x32x16_bf16(pa3, (bf16x8){l3[0], l3[1], l3[2], l3[3], h3[0], h3[1], h3[2], h3[3]}, o[d0], 0, 0, 0); } while (0)
    PV_D0(0); PV_D0(1); PV_D0(2); PV_D0(3);
#undef PV_D0
#undef TRRD
}
}

__device__ __forceinline__ void attn_block(const Ctx& F, int b, int h, int qb) {
    using namespace mla;
    PHASE_IDS;
    LAS unsigned char* L = F.lds;
    const bf16_t* Qg = (const bf16_t*)(F.ws + WS_QB); const bf16_t* Kg = (const bf16_t*)(F.ws + WS_KB); const bf16_t* Vg = (const bf16_t*)(F.ws + WS_VB); unsigned char* Og = (unsigned char*)(F.ws + WS_AO);
    const int wid = wave, r32 = lane & 31, hi = lane >> 5;
    const size_t rowb = (size_t)b * SEQ; const int P0 = qb * QB;
    const int NT = (P0 + QB) / KVBLK;
    LAS unsigned char* V_lds = L + O_V; LAS unsigned char* K_lds = L + O_K;
    LAS float* wsf = (LAS float*)(L + O_WS) + wid * 64; LAS float* li_l = wsf; LAS float* al_l = wsf + 32;
    const bf16_t* Kh = Kg + rowb * (MH * QK) + h * QK; const bf16_t* Vh = Vg + rowb * D + h * VD;
#define KOFF_(i_) ({ const int p_ = (wid + 8 * (i_)) * 64 + lane, row_ = p_ / 24, cs_ = p_ - row_ * 24, ch_ = cs_ ^ (row_ & 7); (unsigned)(row_ * (MH * QK) + ch_ * 8) * 2u; })
#define VOFF_(i_) ({ const int p_ = (wid + 8 * (i_)) * 64 + lane, sub_ = p_ >> 5, r_ = p_ & 31, kk_ = (sub_ >> 2) * 8 + (r_ >> 2), k_ = (kk_ & ~0xC) | ((kk_ & 4) << 1) | ((kk_ & 8) >> 1), c_ = (sub_ & 3) * 32 + (r_ & 3) * 8; (unsigned)(k_ * D + c_) * 2u; })
    const unsigned koff0 = KOFF_(0), koff1 = KOFF_(1), koff2 = KOFF_(2), voff0 = VOFF_(0), voff1 = VOFF_(1);
#undef KOFF_
#undef VOFF_
    const int vb0 = (int)(uintptr_t)V_lds + v_rd_base(lane);
    bf16x8 qr[12];
    { const bf16_t* qp = Qg + (rowb + P0 + wid * QBLK + r32) * (MH * QK) + h * QK + hi * 8;
#pragma unroll
      for (int d0 = 0; d0 < 12; ++d0) qr[d0] = *(const bf16x8*)(qp + d0 * 16); }
#define DMA(t, bf) do { const char* kp_ = (const char*)(Kh + (size_t)(t) * KVBLK * (MH * QK)); const char* vp_ = (const char*)(Vh + (size_t)(t) * KVBLK * D); \
        glds16s(kp_, koff0, klds0 + (bf) * SHM_K + wid * 1024); glds16s(kp_, koff1, klds0 + (bf) * SHM_K + (wid + 8) * 1024); glds16s(kp_, koff2, klds0 + (bf) * SHM_K + (wid + 16) * 1024); \
        glds16s(vp_, voff0, vlds0 + (bf) * SHM_V + wid * 1024); glds16s(vp_, voff1, vlds0 + (bf) * SHM_V + (wid + 8) * 1024); } while (0)
    const unsigned klds0 = (unsigned)(uintptr_t)K_lds, vlds0 = (unsigned)(uintptr_t)V_lds;
    { const char* kp_ = (const char*)Kh; glds16s(kp_, koff0, klds0 + wid * 1024); glds16s(kp_, koff1, klds0 + (wid + 8) * 1024); glds16s(kp_, koff2, klds0 + (wid + 16) * 1024); } VM_WAIT();
    __syncthreads();
    float m_reg = -1e30f, l_reg = 0.f, mn, alpha; f32x16 o[4] = {}; f32x16 p0, p1; bf16x8 pa0, pa1, pa2, pa3;
    const int qlo = P0 + wid * QBLK, qm = qlo + r32 - 4 * hi;
#define RESC(a) do { if (__any((a) < 1.f)) { if (hi == 0) al_l[r32] = (a); LDS_WAIT(); \
        _Pragma("unroll") for (int d_ = 0; d_ < 4; ++d_) _Pragma("unroll") for (int r = 0; r < 16; ++r) o[d_][r] *= al_l[crow(r, hi)]; } } while (0)
#ifdef MK_ATT_PROBE
#define AT_STAMP(k_) do { if (blockIdx.x == 0 && threadIdx.x == 0) { const unsigned t_ = (unsigned)__builtin_amdgcn_s_memrealtime(); if ((k_) == MK_ATT_PROBE) *(volatile LAS unsigned*)(F.lds + 147440) += t_ - at_prev; at_prev = t_; } } while (0)
    unsigned at_prev = 0;
#else
#define AT_STAMP(k_) do { } while (0)
#endif
#define DMA_K(t, bf) do { const char* kp_ = (const char*)(Kh + (size_t)(t) * KVBLK * (MH * QK)); \
        glds16s(kp_, koff0, klds0 + (bf) * SHM_K + wid * 1024); glds16s(kp_, koff1, klds0 + (bf) * SHM_K + (wid + 8) * 1024); glds16s(kp_, koff2, klds0 + (bf) * SHM_K + (wid + 16) * 1024); } while (0)
#define DMA_V(t, bf) do { const char* vp_ = (const char*)(Vh + (size_t)(t) * KVBLK * D); \
        glds16s(vp_, voff0, vlds0 + (bf) * SHM_V + wid * 1024); glds16s(vp_, voff1, vlds0 + (bf) * SHM_V + (wid + 8) * 1024); } while (0)
#define MASKT(P0_, P1_, t_) do { const int kb_ = (t_) * KVBLK; if (kb_ + KVBLK - 1 > qlo) mask_tile(P0_, P1_, qm - kb_); } while (0)
#define STEPP(s, CB, PN0, PN1, PO0, PO1) do { \
        AT_STAMP(0); \
        if ((s) + 1 < NT) DMA_K((s) + 1, 1 - (CB)); \
        DMA_V((s), (CB)); \
        qkt_sm<CB>(PN0, PN1, K_lds, r32, hi, qr, PO0, PO1, m_reg, alpha, l_reg, pa0, pa1, pa2, pa3); AT_STAMP(1); \
        MASKT(PN0, PN1, (s)); AT_STAMP(2); \
        RESC(alpha); AT_STAMP(3); \
        pv_tile<1 - (CB)>(o, vb0, pa0, pa1, pa2, pa3); AT_STAMP(4); \
        VM_WAIT(); \
        __syncthreads(); AT_STAMP(5); } while (0)
    f32x16 q0, q1;
    { DMA_K(1, 1); DMA_V(0, 0); SBAR(); qkt<0>(p0, p1, K_lds, r32, hi, qr); MASKT(p0, p1, 0); VM_WAIT(); __syncthreads(); }
    for (int s = 1; s + 1 < NT; s += 2) { STEPP(s, 1, q0, q1, p0, p1); STEPP(s + 1, 0, p0, p1, q0, q1); }
    STEPP(NT - 1, 1, q0, q1, p0, p1);
    { partialSM(q0, q1, m_reg, mn, alpha); finishSM(q0, q1, alpha, l_reg, pa0, pa1, pa2, pa3); SBAR(); RESC(alpha); pv_tile<1>(o, vb0, pa0, pa1, pa2, pa3); }
    if (hi == 0) li_l[r32] = l_reg; LDS_WAIT();
    float rli[16];
#pragma unroll
    for (int r = 0; r < 16; ++r) rli[r] = __builtin_amdgcn_rcpf(li_l[crow(r, hi)]);
    unsigned char* Ow = Og + (rowb + P0 + wid * QBLK) * D + h * VD;
#pragma unroll
    for (int r = 0; r < 16; ++r) { const int orow = crow(r, hi);
#pragma unroll
        for (int d0 = 0; d0 < 4; ++d0) { const float v = o[d0][r] * rli[r]; const float vn = __shfl_xor(v, 1);
            if ((r32 & 1) == 0) *(unsigned short*)(Ow + (size_t)orow * D + d0 * 32 + r32) = (unsigned short)__builtin_amdgcn_cvt_pk_fp8_f32(v, vn, 0, false); } }
    __syncthreads();
#undef DMA
#undef DMA_K
#undef DMA_V
#undef MASKT
#undef RESC
#undef STEPP
}
__device__ __forceinline__ void phase_attn(const Ctx& F) {
    constexpr int NQB = SEQ / 256, NITEM = NB * MH * (NQB / 2);
    for (int L = F.vcu; L < NITEM; L += F.G) {
        const int bh = L / (NQB / 2), x = L - bh * (NQB / 2);
        attn_block(F, bh / MH, bh % MH, NQB - 1 - x);
        attn_block(F, bh / MH, bh % MH, x);
    }
}
constexpr int NP = 13, NSTEPS = 2 + DEPTH * NP;
__host__ __device__ constexpr bool step_applies(int st) {
    if (st < 2) return true;
    const int l = (st - 2) / NP, p = (st - 2) % NP;
    if (p == 3) return l >= NA;
    if (p >= 10 || p == 6) return false;
    return true;
}
struct Args { const float* in[28]; float* out; unsigned char* ws; int lo, hi, final_only, pad; };

__global__ void __launch_bounds__(NTHREADS, 2) fwd_kernel(Args args) {
    extern __shared__ __attribute__((aligned(16))) unsigned char lds_raw[];
    Ctx F;
    F.lds = (LAS unsigned char*)lds_raw;
    F.G = gridDim.x; { const int bx = blockIdx.x; F.vcu = (F.G % 8 == 0) ? (bx % 8) * (F.G / 8) + bx / 8 : bx; }
    F.in.p = (KargPtr)__builtin_amdgcn_kernarg_segment_ptr();
    F.out = args.out; F.ws = args.ws;
    volatile LAS unsigned* MISC = (volatile LAS unsigned*)(F.lds + LDS_MISC);
    if (threadIdx.x < 64) MISC[threadIdx.x] = 0u;
    __syncthreads();
#if MK_ONE_LAUNCH
    (void)xcd_barrier_post(F.ctl() + CW_BAR, MISC);
#endif
    const int lo = args.lo, hi = args.hi;
    bool did = false;
#if defined(MK_SCAN_PROBE) || defined(MK_ATT_PROBE)
    if (threadIdx.x == 0) *(volatile LAS unsigned*)(F.lds + 147440) = 0u;
#endif
#ifdef MK_PROBE_MASK
    unsigned long long pr_prev = 0, pr_acc = 0; bool pr_on = false;
#define PR_STAMP(st_) do { if (blockIdx.x == 0 && threadIdx.x == 0) { const unsigned long long t_ = __builtin_amdgcn_s_memrealtime(); if (pr_on) pr_acc += t_ - pr_prev; pr_prev = t_; \
        const int s_ = (st_); int c_ = -1; if (s_ >= 0) { if (s_ < 2) c_ = 26 + s_; else { const int l_ = (s_ - 2) / NP, p_ = (s_ - 2) % NP; c_ = (p_ < 4 && l_ >= NA) ? 13 + p_ : p_; } } \
        pr_on = (c_ >= 0) && (((unsigned long long)(MK_PROBE_MASK) >> c_) & 1ull); } } while (0)
#else
#define PR_STAMP(st_) do { } while (0)
#endif
#if MK_ONE_LAUNCH
#define PHASE_LAUNDER { GAS unsigned char* w_ = (GAS unsigned char*)F.ws; GAS float* o_ = (GAS float*)F.out; int g_ = F.G, v_ = F.vcu; asm volatile("" : "+s"(w_), "+s"(o_), "+s"(g_), "+s"(v_)); F.ws = (unsigned char*)w_; F.out = (float*)o_; F.G = g_; F.vcu = v_; }
#define PHASE_BEGIN(stp) if ((stp) >= lo && (stp) < hi) { if (did) { XcdBarrier b_; b_.bar = F.ctl() + CW_BAR; b_.x = xb_xcc_id(); b_.st = (volatile LAS unsigned*)(F.lds + LDS_MISC); xcd_barrier(b_); } did = true; PR_STAMP(stp); PHASE_LAUNDER
#else
#define PHASE_BEGIN(st) if ((st) >= lo && (st) < hi) { did = true; PHASE_LAUNDER
#endif
#define PHASE_END }

    if (args.final_only) { phase_final_only(F, args.final_only == 1); return; }

    PHASE_BEGIN(0) phase_mod(F); __syncthreads(); phase_convert(F); PHASE_END
    PHASE_BEGIN(1) phase_combine<true>(F, -1); PHASE_END

    { constexpr int l = 0;
    {
        const int sb = 2 + l * NP;
        if (l < NA) {
            PHASE_BEGIN(sb + 0) {
                { pg8::PlainSched S; S.init(T, 3072, F.G, (int)blockIdx.x); S.Bt = (const char*)(F.ws + WS_WIN) + (size_t)l * 3072 * 1024; S.K = 1024;
                  pg8::EpiHgrnIn E{(bf16_t*)(F.ws + WS_QH), (float*)(F.ws + WS_LF), (const float*)(F.ws + WS_LB) + (size_t)l * D, 0x320, 0.015625f};
                  pg8::gemm_phase<true>(F.lds, (const char*)(F.ws + WS_H8), 1024, S, E); }
                { pg8::PlainSched S; S.init(T, 1024, F.G, (int)blockIdx.x); S.Bt = (const char*)(F.ws + WS_WINF) + (size_t)l * 1024 * 1024 * 2; S.K = 2048;
                  pg8::EpiHgrnIn E{(bf16_t*)(F.ws + WS_QH), (float*)(F.ws + WS_LF), (const float*)(F.ws + WS_LB) + (size_t)l * D, 0x1, 1.0f};
                  pg8::gemm_phase<false>(F.lds, (const char*)(F.ws + WS_H), 2048, S, E); } }
            PHASE_END
            PHASE_BEGIN(sb + 1) phase_hgrn_scan(F); PHASE_END
            PHASE_BEGIN(sb + 2) phase_hgrn_gate(F, l); PHASE_END
        } else {
            const int j = l - NA;
            PHASE_BEGIN(sb + 0) {
                if (l == NA) { pg8::PlainSched S; S.init(T, 512, F.G, (int)blockIdx.x); S.Bt = (const char*)(F.ws + WS_WDKV); S.K = 1024;
                    pg8::EpiPlainBf16 E{(bf16_t*)(F.ws + WS_CKR), 512, 0.015625f};
                    pg8::gemm_phase<true>(F.lds, (const char*)(F.ws + WS_HK), 1024, S, E); }
                pg8::PlainSched S; S.init(T, 512, F.G, (int)blockIdx.x); S.Bt = (const char*)(F.ws + WS_WDQ) + (size_t)j * 512 * 1024; S.K = 1024;
                pg8::EpiPlainBf16 E{(bf16_t*)(F.ws + WS_CQ), 512, 0.015625f};
                pg8::gemm_phase<true>(F.lds, (const char*)(F.ws + WS_H8), 1024, S, E); }
            PHASE_END
            PHASE_BEGIN(sb + 1) if (l == NA) phase_kv_rows(F); phase_cq_rows(F, j); PHASE_END
            PHASE_BEGIN(sb + 2) {
                if (l == NA) { pg8::PlainSched S; S.init(T, 2048, F.G, (int)blockIdx.x); S.Bt = (const char*)(F.ws + WS_WUKV); S.K = 512;
                    pg8::EpiKvUp E{(bf16_t*)(F.ws + WS_KB), (bf16_t*)(F.ws + WS_VB)};
                    pg8::gemm_phase<false>(F.lds, (const char*)(F.ws + WS_CKV), 512, S, E); }
                pg8::PlainSched S; S.init(T, 1536, F.G, (int)blockIdx.x); S.Bt = (const char*)(F.ws + WS_WUQ) + (size_t)j * 1536 * 384 * 2; S.K = 768;
                pg8::EpiQUp E{(bf16_t*)(F.ws + WS_QB), (const float*)(F.ws + WS_ROPE)};
                pg8::gemm_phase<false>(F.lds, (const char*)(F.ws + WS_CQN), 768, S, E); }
            PHASE_END
            PHASE_BEGIN(sb + 3) phase_attn(F); PHASE_END
        }
        PHASE_BEGIN(sb + 4) {
            pg8::PlainSched S; S.init(T, 1024, F.G, (int)blockIdx.x); S.K = 1024;
            S.Bt = (l < NA) ? (const char*)(F.ws + WS_WOUT) + (size_t)l * 1024 * 1024 : (const char*)(F.ws + WS_WO) + (size_t)(l - NA) * 1024 * 1024;
            const char* A = (l < NA) ? (const char*)(F.ws + WS_OG) : (const char*)(F.ws + WS_AO);
            pg8::EpiResid E{l == 0 ? F.in[0] : nullptr, (bf16_t*)(F.ws + WS_XB), modp(F, l, 0, 2), 0.015625f, 6 * D};
            pg8::gemm_phase<true>(F.lds, A, 1024, S, E); }
        PHASE_END
        PHASE_BEGIN(sb + 5) phase_router(F, l, args.pad != 0); PHASE_END
        PHASE_BEGIN(sb + 7) {
            moe_table(F, l);
            pg8::MoeSched<true> S{(const LAS int*)(F.lds + LDS_TAB), (const LAS int*)(F.lds + LDS_BLKE), 8, F.G, F.vcu, (const char*)(F.ws + WS_WGU) + (size_t)l * NE * 2048 * 1024, (size_t)2048 * 1024, 1024, (const int*)(F.ws + WS_RINFO)};
            pg8::EpiMoeGU E{(unsigned char*)(F.ws + WS_ACT), F.in[24] + (size_t)l * NE * 2048};
            pg8::gemm_phase<true>(F.lds, (const char*)(F.ws + WS_H), 1024, S, E);
#ifdef MK_GU_EXTRA
            __syncthreads();
#if MK_GU_EXTRA == 3
            { pg8::MoeSchedHot S2{{(const LAS int*)(F.lds + LDS_TAB), (const LAS int*)(F.lds + LDS_BLKE), 8, F.G, F.vcu, (const char*)(F.ws + WS_WGU) + (size_t)l * NE * 2048 * 1024, (size_t)2048 * 1024, 1024, (const int*)(F.ws + WS_RINFO)}};
#else
            { pg8::MoeSched<true> S2{(const LAS int*)(F.lds + LDS_TAB), (const LAS int*)(F.lds + LDS_BLKE), 8, F.G, F.vcu, (const char*)(F.ws + WS_WGU) + (size_t)l * NE * 2048 * 1024, (size_t)2048 * 1024, 1024, (const int*)(F.ws + WS_RINFO)};
#endif
#if MK_GU_EXTRA == 1
              pg8::EpiMoeGU E2{(unsigned char*)(F.ws + WS_YS), F.in[24] + (size_t)l * NE * 2048};
#else
              pg8::EpiNull E2;
#endif
              pg8::gemm_phase<true>(F.lds, (const char*)(F.ws + WS_H), 1024, S2, E2); }
#endif
            }
        PHASE_END
        PHASE_BEGIN(sb + 8) {
            moe_table(F, l);
            pg8::MoeSched<false> S{(const LAS int*)(F.lds + LDS_TAB), (const LAS int*)(F.lds + LDS_BLKE), 4, F.G, F.vcu, (const char*)(F.ws + WS_WDN) + (size_t)l * NE * 1024 * 1024, (size_t)1024 * 1024, 1024, nullptr};
            pg8::EpiMoeDN E{(unsigned char*)(F.ws + WS_YS), F.in[26] + (size_t)l * NE * 1024, (const LAS int*)(F.lds + LDS_TAB), (const float*)(F.ws + WS_RW)};
            pg8::gemm_phase<true>(F.lds, (const char*)(F.ws + WS_ACT), 1024, S, E); }
        PHASE_END
        PHASE_BEGIN(sb + 9) moe_table(F, l); phase_combine<false>(F, l, args.pad != 0); PHASE_END
    }
    }
    { constexpr int l = 1;
    {
        const int sb = 2 + l * NP;
        if (l < NA) {
            PHASE_BEGIN(sb + 0) {
                { pg8::PlainSched S; S.init(T, 3072, F.G, (int)blockIdx.x); S.Bt = (const char*)(F.ws + WS_WIN) + (size_t)l * 3072 * 1024; S.K = 1024;
                  pg8::EpiHgrnIn E{(bf16_t*)(F.ws + WS_QH), (float*)(F.ws + WS_LF), (const float*)(F.ws + WS_LB) + (size_t)l * D, 0x320, 0.015625f};
                  pg8::gemm_phase<true>(F.lds, (const char*)(F.ws + WS_H8), 1024, S, E); }
                { pg8::PlainSched S; S.init(T, 1024, F.G, (int)blockIdx.x); S.Bt = (const char*)(F.ws + WS_WINF) + (size_t)l * 1024 * 1024 * 2; S.K = 2048;
                  pg8::EpiHgrnIn E{(bf16_t*)(F.ws + WS_QH), (float*)(F.ws + WS_LF), (const float*)(F.ws + WS_LB) + (size_t)l * D, 0x1, 1.0f};
                  pg8::gemm_phase<false>(F.lds, (const char*)(F.ws + WS_H), 2048, S, E); } }
            PHASE_END
            PHASE_BEGIN(sb + 1) phase_hgrn_scan(F); PHASE_END
            PHASE_BEGIN(sb + 2) phase_hgrn_gate(F, l); PHASE_END
        } else {
            const int j = l - NA;
            PHASE_BEGIN(sb + 0) {
                if (l == NA) { pg8::PlainSched S; S.init(T, 512, F.G, (int)blockIdx.x); S.Bt = (const char*)(F.ws + WS_WDKV); S.K = 1024;
                    pg8::EpiPlainBf16 E{(bf16_t*)(F.ws + WS_CKR), 512, 0.015625f};
                    pg8::gemm_phase<true>(F.lds, (const char*)(F.ws + WS_HK), 1024, S, E); }
                pg8::PlainSched S; S.init(T, 512, F.G, (int)blockIdx.x); S.Bt = (const char*)(F.ws + WS_WDQ) + (size_t)j * 512 * 1024; S.K = 1024;
                pg8::EpiPlainBf16 E{(bf16_t*)(F.ws + WS_CQ), 512, 0.015625f};
                pg8::gemm_phase<true>(F.lds, (const char*)(F.ws + WS_H8), 1024, S, E); }
            PHASE_END
            PHASE_BEGIN(sb + 1) if (l == NA) phase_kv_rows(F); phase_cq_rows(F, j); PHASE_END
            PHASE_BEGIN(sb + 2) {
                if (l == NA) { pg8::PlainSched S; S.init(T, 2048, F.G, (int)blockIdx.x); S.Bt = (const char*)(F.ws + WS_WUKV); S.K = 512;
                    pg8::EpiKvUp E{(bf16_t*)(F.ws + WS_KB), (bf16_t*)(F.ws + WS_VB)};
                    pg8::gemm_phase<false>(F.lds, (const char*)(F.ws + WS_CKV), 512, S, E); }
                pg8::PlainSched S; S.init(T, 1536, F.G, (int)blockIdx.x); S.Bt = (const char*)(F.ws + WS_WUQ) + (size_t)j * 1536 * 384 * 2; S.K = 768;
                pg8::EpiQUp E{(bf16_t*)(F.ws + WS_QB), (const float*)(F.ws + WS_ROPE)};
                pg8::gemm_phase<false>(F.lds, (const char*)(F.ws + WS_CQN), 768, S, E); }
            PHASE_END
            PHASE_BEGIN(sb + 3) phase_attn(F); PHASE_END
        }
        PHASE_BEGIN(sb + 4) {
            pg8::PlainSched S; S.init(T, 1024, F.G, (int)blockIdx.x); S.K = 1024;
            S.Bt = (l < NA) ? (const char*)(F.ws + WS_WOUT) + (size_t)l * 1024 * 1024 : (const char*)(F.ws + WS_WO) + (size_t)(l - NA) * 1024 * 1024;
            const char* A = (l < NA) ? (const char*)(F.ws + WS_OG) : (const char*)(F.ws + WS_AO);
            pg8::EpiResid E{l == 0 ? F.in[0] : nullptr, (bf16_t*)(F.ws + WS_XB), modp(F, l, 0, 2), 0.015625f, 6 * D};
            pg8::gemm_phase<true>(F.lds, A, 1024, S, E); }
        PHASE_END
        PHASE_BEGIN(sb + 5) phase_router(F, l, args.pad != 0); PHASE_END
        PHASE_BEGIN(sb + 7) {
            moe_table(F, l);
            pg8::MoeSched<true> S{(const LAS int*)(F.lds + LDS_TAB), (const LAS int*)(F.lds + LDS_BLKE), 8, F.G, F.vcu, (const char*)(F.ws + WS_WGU) + (size_t)l * NE * 2048 * 1024, (size_t)2048 * 1024, 1024, (const int*)(F.ws + WS_RINFO)};
            pg8::EpiMoeGU E{(unsigned char*)(F.ws + WS_ACT), F.in[24] + (size_t)l * NE * 2048};
            pg8::gemm_phase<true>(F.lds, (const char*)(F.ws + WS_H), 1024, S, E);
#ifdef MK_GU_EXTRA
            __syncthreads();
#if MK_GU_EXTRA == 3
            { pg8::MoeSchedHot S2{{(const LAS int*)(F.lds + LDS_TAB), (const LAS int*)(F.lds + LDS_BLKE), 8, F.G, F.vcu, (const char*)(F.ws + WS_WGU) + (size_t)l * NE * 2048 * 1024, (size_t)2048 * 1024, 1024, (const int*)(F.ws + WS_RINFO)}};
#else
            { pg8::MoeSched<true> S2{(const LAS int*)(F.lds + LDS_TAB), (const LAS int*)(F.lds + LDS_BLKE), 8, F.G, F.vcu, (const char*)(F.ws + WS_WGU) + (size_t)l * NE * 2048 * 1024, (size_t)2048 * 1024, 1024, (const int*)(F.ws + WS_RINFO)};
#endif
#if MK_GU_EXTRA == 1
              pg8::EpiMoeGU E2{(unsigned char*)(F.ws + WS_YS), F.in[24] + (size_t)l * NE * 2048};
#else
              pg8::EpiNull E2;
#endif
              pg8::gemm_phase<true>(F.lds, (const char*)(F.ws + WS_H), 1024, S2, E2); }
#endif
            }
        PHASE_END
        PHASE_BEGIN(sb + 8) {
            moe_table(F, l);
            pg8::MoeSched<false> S{(const LAS int*)(F.lds + LDS_TAB), (const LAS int*)(F.lds + LDS_BLKE), 4, F.G, F.vcu, (const char*)(F.ws + WS_WDN) + (size_t)l * NE * 1024 * 1024, (size_t)1024 * 1024, 1024, nullptr};
            pg8::EpiMoeDN E{(unsigned char*)(F.ws + WS_YS), F.in[26] + (size_t)l * NE * 1024, (const LAS int*)(F.lds + LDS_TAB), (const float*)(F.ws + WS_RW)};
            pg8::gemm_phase<true>(F.lds, (const char*)(F.ws + WS_ACT), 1024, S, E); }
        PHASE_END
        PHASE_BEGIN(sb + 9) moe_table(F, l); phase_combine<false>(F, l, args.pad != 0); PHASE_END
    }
    }
    { constexpr int l = 2;
    {
        const int sb = 2 + l * NP;
        if (l < NA) {
            PHASE_BEGIN(sb + 0) {
                { pg8::PlainSched S; S.init(T, 3072, F.G, (int)blockIdx.x); S.Bt = (const char*)(F.ws + WS_WIN) + (size_t)l * 3072 * 1024; S.K = 1024;
                  pg8::EpiHgrnIn E{(bf16_t*)(F.ws + WS_QH), (float*)(F.ws + WS_LF), (const float*)(F.ws + WS_LB) + (size_t)l * D, 0x320, 0.015625f};
                  pg8::gemm_phase<true>(F.lds, (const char*)(F.ws + WS_H8), 1024, S, E); }
                { pg8::PlainSched S; S.init(T, 1024, F.G, (int)blockIdx.x); S.Bt = (const char*)(F.ws + WS_WINF) + (size_t)l * 1024 * 1024 * 2; S.K = 2048;
                  pg8::EpiHgrnIn E{(bf16_t*)(F.ws + WS_QH), (float*)(F.ws + WS_LF), (const float*)(F.ws + WS_LB) + (size_t)l * D, 0x1, 1.0f};
                  pg8::gemm_phase<false>(F.lds, (const char*)(F.ws + WS_H), 2048, S, E); } }
            PHASE_END
            PHASE_BEGIN(sb + 1) phase_hgrn_scan(F); PHASE_END
            PHASE_BEGIN(sb + 2) phase_hgrn_gate(F, l); PHASE_END
        } else {
            const int j = l - NA;
            PHASE_BEGIN(sb + 0) {
                if (l == NA) { pg8::PlainSched S; S.init(T, 512, F.G, (int)blockIdx.x); S.Bt = (const char*)(F.ws + WS_WDKV); S.K = 1024;
                    pg8::EpiPlainBf16 E{(bf16_t*)(F.ws + WS_CKR), 512, 0.015625f};
                    pg8::gemm_phase<true>(F.lds, (const char*)(F.ws + WS_HK), 1024, S, E); }
                pg8::PlainSched S; S.init(T, 512, F.G, (int)blockIdx.x); S.Bt = (const char*)(F.ws + WS_WDQ) + (size_t)j * 512 * 1024; S.K = 1024;
                pg8::EpiPlainBf16 E{(bf16_t*)(F.ws + WS_CQ), 512, 0.015625f};
                pg8::gemm_phase<true>(F.lds, (const char*)(F.ws + WS_H8), 1024, S, E); }
            PHASE_END
            PHASE_BEGIN(sb + 1) if (l == NA) phase_kv_rows(F); phase_cq_rows(F, j); PHASE_END
            PHASE_BEGIN(sb + 2) {
                if (l == NA) { pg8::PlainSched S; S.init(T, 2048, F.G, (int)blockIdx.x); S.Bt = (const char*)(F.ws + WS_WUKV); S.K = 512;
                    pg8::EpiKvUp E{(bf16_t*)(F.ws + WS_KB), (bf16_t*)(F.ws + WS_VB)};
                    pg8::gemm_phase<false>(F.lds, (const char*)(F.ws + WS_CKV), 512, S, E); }
                pg8::PlainSched S; S.init(T, 1536, F.G, (int)blockIdx.x); S.Bt = (const char*)(F.ws + WS_WUQ) + (size_t)j * 1536 * 384 * 2; S.K = 768;
                pg8::EpiQUp E{(bf16_t*)(F.ws + WS_QB), (const float*)(F.ws + WS_ROPE)};
                pg8::gemm_phase<false>(F.lds, (const char*)(F.ws + WS_CQN), 768, S, E); }
            PHASE_END
            PHASE_BEGIN(sb + 3) phase_attn(F); PHASE_END
        }
        PHASE_BEGIN(sb + 4) {
            pg8::PlainSched S; S.init(T, 1024, F.G, (int)blockIdx.x); S.K = 1024;
            S.Bt = (l < NA) ? (const char*)(F.ws + WS_WOUT) + (size_t)l * 1024 * 1024 : (const char*)(F.ws + WS_WO) + (size_t)(l - NA) * 1024 * 1024;
            const char* A = (l < NA) ? (const char*)(F.ws + WS_OG) : (const char*)(F.ws + WS_AO);
            pg8::EpiResid E{l == 0 ? F.in[0] : nullptr, (bf16_t*)(F.ws + WS_XB), modp(F, l, 0, 2), 0.015625f, 6 * D};
            pg8::gemm_phase<true>(F.lds, A, 1024, S, E); }
        PHASE_END
        PHASE_BEGIN(sb + 5) phase_router(F, l, args.pad != 0); PHASE_END
        PHASE_BEGIN(sb + 7) {
            moe_table(F, l);
            pg8::MoeSched<true> S{(const LAS int*)(F.lds + LDS_TAB), (const LAS int*)(F.lds + LDS_BLKE), 8, F.G, F.vcu, (const char*)(F.ws + WS_WGU) + (size_t)l * NE * 2048 * 1024, (size_t)2048 * 1024, 1024, (const int*)(F.ws + WS_RINFO)};
            pg8::EpiMoeGU E{(unsigned char*)(F.ws + WS_ACT), F.in[24] + (size_t)l * NE * 2048};
            pg8::gemm_phase<true>(F.lds, (const char*)(F.ws + WS_H), 1024, S, E);
#ifdef MK_GU_EXTRA
            __syncthreads();
#if MK_GU_EXTRA == 3
            { pg8::MoeSchedHot S2{{(const LAS int*)(F.lds + LDS_TAB), (const LAS int*)(F.lds + LDS_BLKE), 8, F.G, F.vcu, (const char*)(F.ws + WS_WGU) + (size_t)l * NE * 2048 * 1024, (size_t)2048 * 1024, 1024, (const int*)(F.ws + WS_RINFO)}};
#else
            { pg8::MoeSched<true> S2{(const LAS int*)(F.lds + LDS_TAB), (const LAS int*)(F.lds + LDS_BLKE), 8, F.G, F.vcu, (const char*)(F.ws + WS_WGU) + (size_t)l * NE * 2048 * 1024, (size_t)2048 * 1024, 1024, (const int*)(F.ws + WS_RINFO)};
#endif
#if MK_GU_EXTRA == 1
              pg8::EpiMoeGU E2{(unsigned char*)(F.ws + WS_YS), F.in[24] + (size_t)l * NE * 2048};
#else
              pg8::EpiNull E2;
#endif
              pg8::gemm_phase<true>(F.lds, (const char*)(F.ws + WS_H), 1024, S2, E2); }
#endif
            }
        PHASE_END
        PHASE_BEGIN(sb + 8) {
            moe_table(F, l);
            pg8::MoeSched<false> S{(const LAS int*)(F.lds + LDS_TAB), (const LAS int*)(F.lds + LDS_BLKE), 4, F.G, F.vcu, (const char*)(F.ws + WS_WDN) + (size_t)l * NE * 1024 * 1024, (size_t)1024 * 1024, 1024, nullptr};
            pg8::EpiMoeDN E{(unsigned char*)(F.ws + WS_YS), F.in[26] + (size_t)l * NE * 1024, (const LAS int*)(F.lds + LDS_TAB), (const float*)(F.ws + WS_RW)};
            pg8::gemm_phase<true>(F.lds, (const char*)(F.ws + WS_ACT), 1024, S, E); }
        PHASE_END
        PHASE_BEGIN(sb + 9) moe_table(F, l); phase_combine<false>(F, l, args.pad != 0); PHASE_END
    }
    }
    { constexpr int l = 3;
    {
        const int sb = 2 + l * NP;
        if (l < NA) {
            PHASE_BEGIN(sb + 0) {
                { pg8::PlainSched S; S.init(T, 3072, F.G, (int)blockIdx.x); S.Bt = (const char*)(F.ws + WS_WIN) + (size_t)l * 3072 * 1024; S.K = 1024;
                  pg8::EpiHgrnIn E{(bf16_t*)(F.ws + WS_QH), (float*)(F.ws + WS_LF), (const float*)(F.ws + WS_LB) + (size_t)l * D, 0x320, 0.015625f};
                  pg8::gemm_phase<true>(F.lds, (const char*)(F.ws + WS_H8), 1024, S, E); }
                { pg8::PlainSched S; S.init(T, 1024, F.G, (int)blockIdx.x); S.Bt = (const char*)(F.ws + WS_WINF) + (size_t)l * 1024 * 1024 * 2; S.K = 2048;
                  pg8::EpiHgrnIn E{(bf16_t*)(F.ws + WS_QH), (float*)(F.ws + WS_LF), (const float*)(F.ws + WS_LB) + (size_t)l * D, 0x1, 1.0f};
                  pg8::gemm_phase<false>(F.lds, (const char*)(F.ws + WS_H), 2048, S, E); } }
            PHASE_END
            PHASE_BEGIN(sb + 1) phase_hgrn_scan(F); PHASE_END
            PHASE_BEGIN(sb + 2) phase_hgrn_gate(F, l); PHASE_END
        } else {
            const int j = l - NA;
            PHASE_BEGIN(sb + 0) {
                if (l == NA) { pg8::PlainSched S; S.init(T, 512, F.G, (int)blockIdx.x); S.Bt = (const char*)(F.ws + WS_WDKV); S.K = 1024;
                    pg8::EpiPlainBf16 E{(bf16_t*)(F.ws + WS_CKR), 512, 0.015625f};
                    pg8::gemm_phase<true>(F.lds, (const char*)(F.ws + WS_HK), 1024, S, E); }
                pg8::PlainSched S; S.init(T, 512, F.G, (int)blockIdx.x); S.Bt = (const char*)(F.ws + WS_WDQ) + (size_t)j * 512 * 1024; S.K = 1024;
                pg8::EpiPlainBf16 E{(bf16_t*)(F.ws + WS_CQ), 512, 0.015625f};
                pg8::gemm_phase<true>(F.lds, (const char*)(F.ws + WS_H8), 1024, S, E); }
            PHASE_END
            PHASE_BEGIN(sb + 1) if (l == NA) phase_kv_rows(F); phase_cq_rows(F, j); PHASE_END
            PHASE_BEGIN(sb + 2) {
                if (l == NA) { pg8::PlainSched S; S.init(T, 2048, F.G, (int)blockIdx.x); S.Bt = (const char*)(F.ws + WS_WUKV); S.K = 512;
                    pg8::EpiKvUp E{(bf16_t*)(F.ws + WS_KB), (bf16_t*)(F.ws + WS_VB)};
                    pg8::gemm_phase<false>(F.lds, (const char*)(F.ws + WS_CKV), 512, S, E); }
                pg8::PlainSched S; S.init(T, 1536, F.G, (int)blockIdx.x); S.Bt = (const char*)(F.ws + WS_WUQ) + (size_t)j * 1536 * 384 * 2; S.K = 768;
                pg8::EpiQUp E{(bf16_t*)(F.ws + WS_QB), (const float*)(F.ws + WS_ROPE)};
                pg8::gemm_phase<false>(F.lds, (const char*)(F.ws + WS_CQN), 768, S, E); }
            PHASE_END
            PHASE_BEGIN(sb + 3) phase_attn(F); PHASE_END
        }
        PHASE_BEGIN(sb + 4) {
            pg8::PlainSched S; S.init(T, 1024, F.G, (int)blockIdx.x); S.K = 1024;
            S.Bt = (l < NA) ? (const char*)(F.ws + WS_WOUT) + (size_t)l * 1024 * 1024 : (const char*)(F.ws + WS_WO) + (size_t)(l - NA) * 1024 * 1024;
            const char* A = (l < NA) ? (const char*)(F.ws + WS_OG) : (const char*)(F.ws + WS_AO);
            pg8::EpiResid E{l == 0 ? F.in[0] : nullptr, (bf16_t*)(F.ws + WS_XB), modp(F, l, 0, 2), 0.015625f, 6 * D};
            pg8::gemm_phase<true>(F.lds, A, 1024, S, E); }
        PHASE_END
        PHASE_BEGIN(sb + 5) phase_router(F, l, args.pad != 0); PHASE_END
        PHASE_BEGIN(sb + 7) {
            moe_table(F, l);
            pg8::MoeSched<true> S{(const LAS int*)(F.lds + LDS_TAB), (const LAS int*)(F.lds + LDS_BLKE), 8, F.G, F.vcu, (const char*)(F.ws + WS_WGU) + (size_t)l * NE * 2048 * 1024, (size_t)2048 * 1024, 1024, (const int*)(F.ws + WS_RINFO)};
            pg8::EpiMoeGU E{(unsigned char*)(F.ws + WS_ACT), F.in[24] + (size_t)l * NE * 2048};
            pg8::gemm_phase<true>(F.lds, (const char*)(F.ws + WS_H), 1024, S, E);
#ifdef MK_GU_EXTRA
            __syncthreads();
#if MK_GU_EXTRA == 3
            { pg8::MoeSchedHot S2{{(const LAS int*)(F.lds + LDS_TAB), (const LAS int*)(F.lds + LDS_BLKE), 8, F.G, F.vcu, (const char*)(F.ws + WS_WGU) + (size_t)l * NE * 2048 * 1024, (size_t)2048 * 1024, 1024, (const int*)(F.ws + WS_RINFO)}};
#else
            { pg8::MoeSched<true> S2{(const LAS int*)(F.lds + LDS_TAB), (const LAS int*)(F.lds + LDS_BLKE), 8, F.G, F.vcu, (const char*)(F.ws + WS_WGU) + (size_t)l * NE * 2048 * 1024, (size_t)2048 * 1024, 1024, (const int*)(F.ws + WS_RINFO)};
#endif
#if MK_GU_EXTRA == 1
              pg8::EpiMoeGU E2{(unsigned char*)(F.ws + WS_YS), F.in[24] + (size_t)l * NE * 2048};
#else
              pg8::EpiNull E2;
#endif
              pg8::gemm_phase<true>(F.lds, (const char*)(F.ws + WS_H), 1024, S2, E2); }
#endif
            }
        PHASE_END
        PHASE_BEGIN(sb + 8) {
            moe_table(F, l);
            pg8::MoeSched<false> S{(const LAS int*)(F.lds + LDS_TAB), (const LAS int*)(F.lds + LDS_BLKE), 4, F.G, F.vcu, (const char*)(F.ws + WS_WDN) + (size_t)l * NE * 1024 * 1024, (size_t)1024 * 1024, 1024, nullptr};
            pg8::EpiMoeDN E{(unsigned char*)(F.ws + WS_YS), F.in[26] + (size_t)l * NE * 1024, (const LAS int*)(F.lds + LDS_TAB), (const float*)(F.ws + WS_RW)};
            pg8::gemm_phase<true>(F.lds, (const char*)(F.ws + WS_ACT), 1024, S, E); }
        PHASE_END
        PHASE_BEGIN(sb + 9) moe_table(F, l); phase_combine<false>(F, l, args.pad != 0); PHASE_END
    }
    }
#ifdef MK_PROBE_MASK
    PR_STAMP(-1);
    if (blockIdx.x == 0 && threadIdx.x == 0) { const unsigned long long t0 = __builtin_amdgcn_s_memrealtime(); while (__builtin_amdgcn_s_memrealtime() - t0 < 4ull * pr_acc) __builtin_amdgcn_s_sleep(8); }
#endif
#if defined(MK_SCAN_PROBE) || defined(MK_ATT_PROBE)
    if (blockIdx.x == 0 && threadIdx.x == 0) { const unsigned long long acc_ = *(volatile LAS unsigned*)(F.lds + 147440); const unsigned long long t0 = __builtin_amdgcn_s_memrealtime(); while (__builtin_amdgcn_s_memrealtime() - t0 < 4ull * acc_) __builtin_amdgcn_s_sleep(8); }
#endif
#undef PHASE_BEGIN
#undef PHASE_END
}

extern "C" void kernel_launch(void* const* d_in, const int* in_sizes, int n_in, void* d_out, int out_size, void* d_ws, size_t ws_size, hipStream_t stream) {
    static int grid = 0;
    if (grid == 0) {
        if (n_in != 28 || in_sizes[0] != T * D || out_size != T * D || ws_size < WS_END) {
            fprintf(stderr, "kernel_launch: shape mismatch: n_in %d in0 %d out %d ws %zu (need %zu)\n", n_in, n_in > 0 ? in_sizes[0] : -1, out_size, ws_size, (size_t)WS_END); grid = -1; return; }
        int dev = 0, cus = 0, per_cu = 0;
        if (hipGetDevice(&dev) != hipSuccess || hipDeviceGetAttribute(&cus, hipDeviceAttributeMultiprocessorCount, dev) != hipSuccess) { fprintf(stderr, "kernel_launch: device query failed\n"); grid = -1; return; }
        if (hipFuncSetAttribute((const void*)fwd_kernel, hipFuncAttributeMaxDynamicSharedMemorySize, LDS_BYTES) != hipSuccess) { fprintf(stderr, "kernel_launch: hipFuncSetAttribute failed\n"); grid = -1; return; }
        if (hipOccupancyMaxActiveBlocksPerMultiprocessor(&per_cu, (const void*)fwd_kernel, NTHREADS, LDS_BYTES) != hipSuccess || per_cu < 1)
            fprintf(stderr, "kernel_launch: note: occupancy query reports %d workgroups per CU\n", per_cu);
        (void)hipGetLastError();
        grid = cus;
    }
    if (grid < 0) return;
    if (hipMemsetAsync((char*)d_ws + WS_CTL, 0, CTL_ZERO_BYTES, stream) != hipSuccess) { fprintf(stderr, "kernel_launch: memset failed\n"); return; }
    Args a{};
    for (int i = 0; i < 28; ++i) a.in[i] = (const float*)d_in[i];
    a.out = (float*)d_out; a.ws = (unsigned char*)d_ws; a.final_only = 0; a.pad = 0;
    constexpr int LAST = (MK_LAST_STEP < NSTEPS) ? MK_LAST_STEP : NSTEPS;
#if MK_ONE_LAUNCH
    a.lo = 0; a.hi = LAST;
    hipLaunchKernelGGL(fwd_kernel, dim3(grid), dim3(NTHREADS), LDS_BYTES, stream, a);
#else
    for (int st = 0; st < LAST; ++st) { if (!step_applies(st)) continue;
#ifdef MK_SKIP_LO
        if (st >= MK_SKIP_LO && st < MK_SKIP_HI) continue;
#endif
        a.lo = st; a.hi = st + 1;
        hipLaunchKernelGGL(fwd_kernel, dim3(grid), dim3(NTHREADS), LDS_BYTES, stream, a);
#ifdef MK_REPEAT_LO
        if (st >= MK_REPEAT_LO && st < MK_REPEAT_HI) { a.pad = 1; hipLaunchKernelGGL(fwd_kernel, dim3(grid), dim3(NTHREADS), LDS_BYTES, stream, a); a.pad = 0; }
#endif
    }
#endif
    if (LAST < NSTEPS) {
        a.lo = 0; a.hi = 0; a.final_only = (LAST <= 2 + 4) ? 1 : 2;
        hipLaunchKernelGGL(fwd_kernel, dim3(grid), dim3(NTHREADS), LDS_BYTES, stream, a);
    }
    const hipError_t le = hipPeekAtLastError();
    if (le != hipSuccess) fprintf(stderr, "kernel_launch: launch failed: %s\n", hipGetErrorName(le));
}
```
